# Optimizing an MI355X kernel written in HIP

```python
import jax
import jax.numpy as jnp
from jax import lax
import numpy as np

D_MODEL = 1024
BATCH = 8
SEQ = 4096
DEPTH = 2

N_BRANCH = 3
BRANCH_W = D_MODEL // 2
LRU_W = BRANCH_W
LRU_BLOCKS = 8
LRU_BW = LRU_W // LRU_BLOCKS
CONV_W = 4
LRU_C = 8.0
DA_HEADS = 4
DA_HD = BRANCH_W // (2 * DA_HEADS)
DA_VD = 2 * DA_HD
Q_BLOCK = 128
ROPE_THETA = 10000.0
GLA_HEADS = 4
GLA_DK = BRANCH_W // (2 * GLA_HEADS)
GLA_DV = BRANCH_W // GLA_HEADS
GLA_RANK = 16
GLA_NORMALIZER = 16.0
GLA_CHUNK = 64
D_FF = 7 * D_MODEL // 2
N_EXPERTS = 8
TOP_K = 2
MOE_BLOCK = 512
N_DENSE = (DEPTH + 1) // 2
N_MOE = DEPTH // 2
EPS = 1e-6
IN_SIZES = (LRU_W, LRU_W, 2 * DA_HEADS * DA_HD, 2 * DA_HEADS * DA_HD, DA_HEADS * DA_VD,
            GLA_HEADS * GLA_DK, GLA_HEADS * GLA_DK, GLA_HEADS * GLA_DV, GLA_HEADS * GLA_DV,
            GLA_RANK, N_BRANCH * D_MODEL)
W_IN_COLS = sum(IN_SIZES)

kernel_name = 'hybrid_rglru_diffattn_gla_moe_block'


def rms_norm(x, g):
    xf = x.astype(jnp.float32)
    y = xf * lax.rsqrt(jnp.mean(xf * xf, axis=-1, keepdims=True) + EPS)
    return (y * g.astype(jnp.float32)).astype(x.dtype)


def rotary(x, positions):
    half = x.shape[-1] // 2
    inv_freq = ROPE_THETA ** (-jnp.arange(half, dtype=jnp.float32) / half)
    ang = positions.astype(jnp.float32)[..., None] * inv_freq
    ang = ang.reshape(ang.shape[:2] + (1,) * (x.ndim - 3) + (half,))
    cos, sin = jnp.cos(ang), jnp.sin(ang)
    xf = x.astype(jnp.float32)
    x1, x2 = xf[..., :half], xf[..., half:]
    return jnp.concatenate([x1 * cos - x2 * sin, x2 * cos + x1 * sin], axis=-1).astype(x.dtype)


def rglru_branch(xb, gate_in, conv_w, conv_b, wa, ba, wx, bx, lam):
    B_, S_, C = xb.shape
    u = lax.conv_general_dilated(xb, conv_w[:, None, :], window_strides=(1,),
                                 padding=((CONV_W - 1, 0),),
                                 dimension_numbers=('NWC', 'WIO', 'NWC'),
                                 feature_group_count=C) + conv_b
    ub = u.reshape(B_, S_, LRU_BLOCKS, LRU_BW)
    r = jax.nn.sigmoid(jnp.einsum('bsgi,gij->bsgj', ub, wa).reshape(B_, S_, C) + ba)
    i = jax.nn.sigmoid(jnp.einsum('bsgi,gij->bsgj', ub, wx).reshape(B_, S_, C) + bx)
    log_a = -LRU_C * r.astype(jnp.float32) * jax.nn.softplus(-lam.astype(jnp.float32))
    a = jnp.exp(log_a)
    mult = jnp.sqrt(-jnp.expm1(2.0 * log_a))
    b = mult * (i * u).astype(jnp.float32)

    def combine(c1, c2):
        a1, b1 = c1
        a2, b2 = c2
        return a1 * a2, a2 * b1 + b2

    _, h = lax.associative_scan(combine, (a, b), axis=1)
    return h.astype(xb.dtype) * jax.nn.gelu(gate_in)


def diff_attention(q, k, v, positions, lq1, lk1, lq2, lk2, subln, lambda_init):
    B_, S_, _ = q.shape
    q = rotary(q.reshape(B_, S_, DA_HEADS, 2, DA_HD), positions)
    k = rotary(k.reshape(B_, S_, DA_HEADS, 2, DA_HD), positions)
    q = q.transpose(0, 2, 3, 1, 4) * (DA_HD ** -0.5)
    k = k.transpose(0, 2, 3, 1, 4)
    v = v.reshape(B_, S_, DA_HEADS, DA_VD).transpose(0, 2, 1, 3)
    f32 = jnp.float32
    lam = (jnp.exp(jnp.sum(lq1.astype(f32) * lk1.astype(f32)))
           - jnp.exp(jnp.sum(lq2.astype(f32) * lk2.astype(f32))) + lambda_init)
    nb = S_ // Q_BLOCK
    qb = q.reshape(B_, DA_HEADS, 2, nb, Q_BLOCK, DA_HD).transpose(3, 0, 1, 2, 4, 5)
    k_idx = jnp.arange(S_)

    def block(args):
        q_blk, start = args
        s = jnp.einsum('bhcqd,bhckd->bhcqk', q_blk, k).astype(f32)
        q_idx = start + jnp.arange(Q_BLOCK)
        mask = k_idx[None, :] <= q_idx[:, None]
        p = jax.nn.softmax(jnp.where(mask, s, -jnp.inf), axis=-1)
        p = p[:, :, 0] - lam * p[:, :, 1]
        return jnp.einsum('bhqk,bhkd->bhqd', p.astype(v.dtype), v)

    starts = jnp.arange(nb, dtype=jnp.int32) * Q_BLOCK
    o = lax.map(block, (qb, starts))
    o = o.transpose(1, 0, 3, 2, 4).reshape(B_, S_, DA_HEADS, DA_VD)
    o = rms_norm(o, subln) * (1.0 - lambda_init)
    return o.reshape(B_, S_, DA_HEADS * DA_VD)


def gla_branch(q, k, v, r, a_low, wa2, ba, gnorm):
    B_, S_, _ = q.shape
    f32 = jnp.float32
    nc = S_ // GLA_CHUNK
    g = jax.nn.log_sigmoid((jnp.matmul(a_low, wa2) + ba).astype(f32)) / GLA_NORMALIZER

    def chunked(t, d):
        return t.astype(f32).reshape(B_, nc, GLA_CHUNK, GLA_HEADS, d).transpose(0, 3, 1, 2, 4)

    qc = chunked(q, GLA_DK) * (GLA_DK ** -0.5)
    kc = chunked(k, GLA_DK)
    vc = chunked(v, GLA_DV)
    gc = chunked(g, GLA_DK)
    bcum = jnp.cumsum(gc, axis=3)
    b_last = bcum[:, :, :, -1:, :]
    ref = bcum[:, :, :, GLA_CHUNK // 2 - 1:GLA_CHUNK // 2, :]
    att = jnp.einsum('bhnid,bhnjd->bhnij', qc * jnp.exp(bcum - ref), kc * jnp.exp(ref - bcum))
    causal = jnp.tril(jnp.ones((GLA_CHUNK, GLA_CHUNK), dtype=bool))
    att = jnp.where(causal, att, 0.0)
    o_intra = jnp.einsum('bhnij,bhnjv->bhniv', att, vc)
    kv = jnp.einsum('bhnjd,bhnjv->bhndv', kc * jnp.exp(b_last - bcum), vc)
    decay = jnp.exp(b_last[:, :, :, 0, :])

    def step(state, inp):
        dec_n, kv_n = inp
        return dec_n[..., None] * state + kv_n, state

    state0 = jnp.zeros((B_, GLA_HEADS, GLA_DK, GLA_DV), f32)
    _, s_before = lax.scan(step, state0, (decay.transpose(2, 0, 1, 3), kv.transpose(2, 0, 1, 3, 4)))
    s_before = s_before.transpose(1, 2, 0, 3, 4)
    o_inter = jnp.einsum('bhnid,bhndv->bhniv', qc * jnp.exp(bcum), s_before)
    o = (o_intra + o_inter).transpose(0, 2, 3, 1, 4).reshape(B_, S_, GLA_HEADS, GLA_DV)
    o = rms_norm(o, gnorm).reshape(B_, S_, GLA_HEADS * GLA_DV)
    return (o * jax.nn.silu(r.astype(f32))).astype(v.dtype)


def hybrid_mixer(hn, positions, layer, w_in, conv_w, conv_b, lru_wa, lru_ba, lru_wx, lru_bx,
                 lru_lambda, da_lq1, da_lk1, da_lq2, da_lk2, da_subln, gla_wa2, gla_ba,
                 gla_norm, w_branch, w_out):
    B_, S_, _ = hn.shape
    proj = jnp.matmul(hn, w_in)
    split_idx = np.cumsum(IN_SIZES)[:-1].tolist()
    (lru_x, lru_g, da_q, da_k, da_v, gla_q, gla_k, gla_v, gla_r, gla_a,
     gates) = jnp.split(proj, split_idx, axis=-1)
    lambda_init = 0.8 - 0.6 * float(np.exp(-0.3 * layer))
    y_lru = rglru_branch(lru_x, lru_g, conv_w, conv_b, lru_wa, lru_ba, lru_wx, lru_bx, lru_lambda)
    y_da = diff_attention(da_q, da_k, da_v, positions, da_lq1, da_lk1, da_lq2, da_lk2,
                          da_subln, lambda_init)
    y_gla = gla_branch(gla_q, gla_k, gla_v, gla_r, gla_a, gla_wa2, gla_ba, gla_norm)
    ys = jnp.stack([y_lru, y_da, y_gla], axis=2)
    up = jnp.einsum('bsnw,nwd->bsnd', ys, w_branch)
    gate = jax.nn.sigmoid(gates.reshape(B_, S_, N_BRANCH, D_MODEL))
    merged = jnp.sum(gate * up, axis=2)
    return jnp.matmul(merged, w_out)


def swiglu(h, w1, w3, w2):
    return jnp.matmul(jax.nn.silu(jnp.matmul(h, w1)) * jnp.matmul(h, w3), w2)


def moe_swiglu(h, router, w1, w3, w2):
    B_, S_, D = h.shape
    n_tok = B_ * S_
    xt = h.reshape(n_tok, D)
    logits = jnp.matmul(xt, router).astype(jnp.float32)
    top_val, top_idx = lax.top_k(logits, TOP_K)
    top_w = jax.nn.softmax(top_val, axis=-1)
    n_assign = n_tok * TOP_K
    e_flat = top_idx.reshape(n_assign).astype(jnp.int32)
    tok_flat = jnp.repeat(jnp.arange(n_tok, dtype=jnp.int32), TOP_K)
    w_flat = top_w.reshape(n_assign)
    order = jnp.argsort(e_flat)
    e_sorted = e_flat[order]
    counts = jnp.bincount(e_flat, length=N_EXPERTS)
    padded = (counts + MOE_BLOCK - 1) // MOE_BLOCK * MOE_BLOCK
    cum_padded = jnp.cumsum(padded)
    start_padded = cum_padded - padded
    start = jnp.cumsum(counts) - counts
    dest = start_padded[e_sorted] + jnp.arange(n_assign, dtype=jnp.int32) - start[e_sorted]
    n_blocks = -(-n_assign // MOE_BLOCK) + N_EXPERTS
    n_slots = n_blocks * MOE_BLOCK
    slot_tok = jnp.full((n_slots,), n_tok, jnp.int32).at[dest].set(tok_flat[order])
    slot_w = jnp.zeros((n_slots,), jnp.float32).at[dest].set(w_flat[order])
    block_start = jnp.arange(n_blocks, dtype=jnp.int32) * MOE_BLOCK
    block_expert = jnp.minimum(jnp.sum(block_start[:, None] >= cum_padded[None, :], axis=1),
                               N_EXPERTS - 1)
    x_pad = jnp.concatenate([xt, jnp.zeros((1, D), xt.dtype)], axis=0)
    xs = x_pad[slot_tok].reshape(n_blocks, MOE_BLOCK, D)

    def expert_block(args):
        xb, e = args
        return swiglu(xb, w1[e], w3[e], w2[e])

    ys = lax.map(expert_block, (xs, block_expert)).reshape(n_slots, D)
    out = jax.ops.segment_sum(ys.astype(jnp.float32) * slot_w[:, None], slot_tok,
                              num_segments=n_tok + 1)[:n_tok]
    return out.astype(h.dtype).reshape(B_, S_, D)


def setup_inputs(seed: int = 0) -> dict:
    key = jax.random.key(seed)
    ks = jax.random.split(key, 32)
    f32 = jnp.float32

    def nrm(k, shape, scale):
        return jax.random.normal(k, shape, f32) * scale

    u = jax.random.uniform(ks[9], (DEPTH, LRU_W), f32, 0.9, 0.999)
    a0 = u ** (1.0 / LRU_C)
    lru_lambda = jnp.log(a0) - jnp.log1p(-a0)
    positions = (jnp.arange(SEQ, dtype=jnp.int32)[None, :]
                 + jax.random.randint(ks[1], (BATCH, 1), 0, SEQ, dtype=jnp.int32))
    return {
        'x': nrm(ks[0], (BATCH, SEQ, D_MODEL), 1.0),
        'positions': positions,
        'mix_norm': 1.0 + nrm(ks[2], (DEPTH, D_MODEL), 0.02),
        'w_in': nrm(ks[3], (DEPTH, D_MODEL, W_IN_COLS), D_MODEL ** -0.5),
        'conv_w': nrm(ks[4], (DEPTH, CONV_W, LRU_W), CONV_W ** -0.5),
        'conv_b': nrm(ks[5], (DEPTH, LRU_W), 0.02),
        'lru_wa': nrm(ks[6], (DEPTH, LRU_BLOCKS, LRU_BW, LRU_BW), LRU_BW ** -0.5),
        'lru_ba': nrm(ks[7], (DEPTH, LRU_W), 0.02),
        'lru_wx': nrm(ks[8], (DEPTH, LRU_BLOCKS, LRU_BW, LRU_BW), LRU_BW ** -0.5),
        'lru_bx': nrm(ks[10], (DEPTH, LRU_W), 0.02),
        'lru_lambda': lru_lambda,
        'da_lq1': nrm(ks[11], (DEPTH, DA_HD), 0.1),
        'da_lk1': nrm(ks[12], (DEPTH, DA_HD), 0.1),
        'da_lq2': nrm(ks[13], (DEPTH, DA_HD), 0.1),
        'da_lk2': nrm(ks[14], (DEPTH, DA_HD), 0.1),
        'da_subln': 1.0 + nrm(ks[15], (DEPTH, DA_VD), 0.02),
        'gla_wa2': nrm(ks[16], (DEPTH, GLA_RANK, GLA_HEADS * GLA_DK), GLA_RANK ** -0.5),
        'gla_ba': nrm(ks[17], (DEPTH, GLA_HEADS * GLA_DK), 0.02),
        'gla_norm': 1.0 + nrm(ks[18], (DEPTH, GLA_DV), 0.02),
        'w_branch': nrm(ks[19], (DEPTH, N_BRANCH, BRANCH_W, D_MODEL), BRANCH_W ** -0.5),
        'w_out': nrm(ks[20], (DEPTH, D_MODEL, D_MODEL), D_MODEL ** -0.5),
        'ffn_norm': 1.0 + nrm(ks[21], (DEPTH, D_MODEL), 0.02),
        'dense_w1': nrm(ks[22], (N_DENSE, D_MODEL, D_FF), D_MODEL ** -0.5),
        'dense_w3': nrm(ks[23], (N_DENSE, D_MODEL, D_FF), D_MODEL ** -0.5),
        'dense_w2': nrm(ks[24], (N_DENSE, D_FF, D_MODEL), D_FF ** -0.5),
        'router': nrm(ks[25], (N_MOE, D_MODEL, N_EXPERTS), D_MODEL ** -0.5),
        'moe_w1': nrm(ks[26], (N_MOE, N_EXPERTS, D_MODEL, D_FF), D_MODEL ** -0.5),
        'moe_w3': nrm(ks[27], (N_MOE, N_EXPERTS, D_MODEL, D_FF), D_MODEL ** -0.5),
        'moe_w2': nrm(ks[28], (N_MOE, N_EXPERTS, D_FF, D_MODEL), D_FF ** -0.5),
        'final_norm': 1.0 + nrm(ks[29], (D_MODEL,), 0.02),
    }


def reference(x, positions, mix_norm, w_in, conv_w, conv_b, lru_wa, lru_ba, lru_wx, lru_bx,
              lru_lambda, da_lq1, da_lk1, da_lq2, da_lk2, da_subln, gla_wa2, gla_ba, gla_norm,
              w_branch, w_out, ffn_norm, dense_w1, dense_w3, dense_w2, router, moe_w1, moe_w3,
              moe_w2, final_norm):
    h = x
    for layer in range(DEPTH):
        hn = rms_norm(h, mix_norm[layer])
        h = h + hybrid_mixer(hn, positions, layer, w_in[layer], conv_w[layer], conv_b[layer],
                             lru_wa[layer], lru_ba[layer], lru_wx[layer], lru_bx[layer],
                             lru_lambda[layer], da_lq1[layer], da_lk1[layer], da_lq2[layer],
                             da_lk2[layer], da_subln[layer], gla_wa2[layer], gla_ba[layer],
                             gla_norm[layer], w_branch[layer], w_out[layer])
        hn = rms_norm(h, ffn_norm[layer])
        j = layer // 2
        if layer % 2 == 0:
            h = h + swiglu(hn, dense_w1[j], dense_w3[j], dense_w2[j])
        else:
            h = h + moe_swiglu(hn, router[j], moe_w1[j], moe_w3[j], moe_w2[j])
    return rms_norm(h, final_norm)
```

```cpp
#include <hip/hip_runtime.h>
#include <hip/hip_bf16.h>
#include <cstdio>
#include <cstdint>
#include <cmath>

#define GAS __attribute__((address_space(1)))
#define LAS __attribute__((address_space(3)))
typedef unsigned short bf16;
typedef unsigned v4u __attribute__((ext_vector_type(4)));
typedef unsigned v2u __attribute__((ext_vector_type(2)));
typedef float f32x4 __attribute__((ext_vector_type(4)));
typedef float f32x2 __attribute__((ext_vector_type(2)));
typedef float f32x16 __attribute__((ext_vector_type(16)));
typedef short bf16x8 __attribute__((ext_vector_type(8)));
typedef GAS unsigned gu32;
#define RLX_AGENT __ATOMIC_RELAXED, __HIP_MEMORY_SCOPE_AGENT
#define LDS_WAIT() asm volatile("s_waitcnt lgkmcnt(0)" ::: "memory")
#define VM_WAIT() asm volatile("s_waitcnt vmcnt(0)" ::: "memory")

constexpr int BATCH = 8, SEQ = 4096, DM = 1024, NTOK = BATCH * SEQ, DEPTH = 2;
constexpr int BW = 512;
constexpr int W_IN_COLS = 7184;
constexpr int DFF = 3584, NEXP = 8;
constexpr int NA_COLS = 4352;
constexpr int NG_COLS = 3072;
constexpr int WIN_ROWS = NA_COLS + NG_COLS;
constexpr float EPS = 1e-6f;
constexpr float C2 = 0.125f * 1.4426950408889634f;
constexpr int MAX_TILES = 264;
constexpr int MAX_SLOTS = MAX_TILES * 256 + 2048;
constexpr int CH0_TILES = 128;

typedef float cvt_f32x2 __attribute__((ext_vector_type(2))); typedef __bf16 cvt_bf16x2 __attribute__((ext_vector_type(2)));
__device__ __forceinline__ unsigned pk2(float lo, float hi) { const cvt_f32x2 v = {lo, hi}; return __builtin_bit_cast(unsigned, __builtin_convertvector(v, cvt_bf16x2)); }
__device__ __forceinline__ unsigned f2bf(float f) { return pk2(f, 0.f) & 0xffffu; }
__device__ __forceinline__ float bf2f(unsigned short h) { return __builtin_bit_cast(float, (unsigned)h << 16); }
__device__ __forceinline__ float bflo(unsigned w) { return __builtin_bit_cast(float, w << 16); }
__device__ __forceinline__ float bfhi(unsigned w) { return __builtin_bit_cast(float, w & 0xffff0000u); }
template <int CTRL> __device__ __forceinline__ float dpp_mov(float v) { return __builtin_bit_cast(float, __builtin_amdgcn_update_dpp(0, __builtin_bit_cast(int, v), CTRL, 0xf, 0xf, true)); }
__device__ __forceinline__ float wave_sum(float v) {
    v += dpp_mov<0xB1>(v); v += dpp_mov<0x4E>(v); v += dpp_mov<0x141>(v); v += dpp_mov<0x140>(v);
    const int vi = __builtin_bit_cast(int, v);
    return (__builtin_bit_cast(float, __builtin_amdgcn_readlane(vi, 0)) + __builtin_bit_cast(float, __builtin_amdgcn_readlane(vi, 16))) + (__builtin_bit_cast(float, __builtin_amdgcn_readlane(vi, 32)) + __builtin_bit_cast(float, __builtin_amdgcn_readlane(vi, 48)));
}
__device__ __forceinline__ float fast_sigmoid(float x) { return __builtin_amdgcn_rcpf(1.f + __expf(-x)); }

namespace pg8 {
#define PG8_LAS __attribute__((address_space(3)))
typedef unsigned short bf16_t;
typedef unsigned u32x4 __attribute__((ext_vector_type(4)));
constexpr int BM = 256, BK = 64, HALF = 128, HTB = HALF * BK * 2  , STAGE_BYTES = 8 * HTB, NXCD = 8, WGM = 8;

__host__ __device__ __forceinline__ int lds_byte(int r, int c) { const int st = (r >> 4) * 2 + (c >> 5), rr = r & 15, cc = c & 31, ob = rr * 64 + cc * 2; return st * 1024 + (ob ^ (((ob >> 9) & 1) << 5)); }
__host__ __device__ __forceinline__ void stage_rc(int b, int& R, int& C) { const int st = b / 1024, sb = b % 1024, swz = sb ^ (((sb >> 9) & 1) << 5); R = (st >> 1) * 16 + swz / 64; C = (st & 1) * 32 + (swz % 64) / 2; }
__host__ __device__ __forceinline__ int perm32(int rho) { const int n = rho >> 4, i = rho & 15; return 8 * (i >> 2) + 4 * n + (i & 3); }

struct Unit { int pm, pn, x, gs, keep; const char* a; const char* b; };

__device__ __forceinline__ void tile_of(int L, int nM, int nN, int& pm, int& pn) {
    const int nwg = nM * nN; int wgid = L; { const int q = nwg / NXCD, r = nwg % NXCD, xcd = wgid % NXCD, off = wgid / NXCD; wgid = (xcd < r ? xcd * (q + 1) : r * (q + 1) + (xcd - r) * q) + off; }
    const int nig = WGM * nN, gid = wgid / nig, fm = gid * WGM, gsz = (nM - fm) < WGM ? (nM - fm) : WGM;
    pm = fm + ((wgid % nig) % gsz); pn = (wgid % nig) / gsz;
}
__device__ __forceinline__ unsigned cvt_pk_bf16(float lo, float hi) { unsigned r; asm volatile("v_cvt_pk_bf16_f32 %0, %1, %2" : "=v"(r) : "v"(lo), "v"(hi)); return r; }

template <class Epi, class Sched, bool ALIGN_EPI, bool SP2, bool GATHER, bool FP8 = false>
__device__ __forceinline__ void gemm_phase(PG8_LAS unsigned char* lds, const int KB, const Sched& S, const Epi& E, const int PA_ = 0) {
    int tid_ = threadIdx.x; asm volatile("" : "+v"(tid_));
    const int tid = tid_, wid = __builtin_amdgcn_readfirstlane(tid >> 6), lane = tid & 63, wr = wid >> 2, wc = wid & 3, fr = lane & 15, fq = lane >> 4;
    const int nt = KB / (BK * 2);
    unsigned voffA, voffB; int RA0, CA;
    { int R, C; stage_rc(tid * 16, R, C); const int Rb = (R & ~31) + perm32(R & 31); voffA = (unsigned)(R * (PA_ ? PA_ : KB) + C * 2); voffB = (unsigned)(Rb * KB + C * 2); RA0 = R; CA = C; }
    const size_t qstep = (size_t)64 * KB, qstepA = (size_t)64 * (PA_ ? PA_ : KB), hstepA = (size_t)HALF * (PA_ ? PA_ : KB);
    const size_t kstep = (size_t)(BK * 2);
    const size_t hstep = (size_t)HALF * KB;
    const unsigned ldsw = (unsigned)wid * 1024u;
    const int aoff = lds_byte(wr * 64 + fr, fq * 8), boff = lds_byte(wc * 32 + fr, fq * 8);
#define PG8_SA(b, h) (((b) * 2 + (h)) * HTB)
#define PG8_SB(b, h) ((4 + (b) * 2 + (h)) * HTB)
#define PG8_STAGE(bufoff, gbase, voff) do { _Pragma("unroll") for (int _i = 0; _i < 2; ++_i) \
        __builtin_amdgcn_global_load_lds((const unsigned*)((const char*)(gbase) + _i * qstep + (voff)), (PG8_LAS unsigned*)(lds + (bufoff) + ldsw + _i * 8192), 16, 0, 0); } while (0)
#define PG8_STAGE_PA(bufoff, gbase, voff) do { _Pragma("unroll") for (int _i = 0; _i < 2; ++_i) \
        __builtin_amdgcn_global_load_lds((const unsigned*)((const char*)(gbase) + _i * qstepA + (voff)), (PG8_LAS unsigned*)(lds + (bufoff) + ldsw + _i * 8192), 16, 0, 0); } while (0)
#define PG8_STAGE_G(bufoff, gbase, voff) do { _Pragma("unroll") for (int _i = 0; _i < 2; ++_i) \
        __builtin_amdgcn_global_load_lds((const unsigned*)((const char*)(gbase) + (voff)[_i]), (PG8_LAS unsigned*)(lds + (bufoff) + ldsw + _i * 8192), 16, 0, 0); } while (0)
#define PG8_LDA(dst, b, h) do { _Pragma("unroll") for (int m = 0; m < 4; ++m) _Pragma("unroll") for (int k = 0; k < 2; ++k) dst[m][k] = *(const PG8_LAS bf16x8*)(lds + PG8_SA(b, h) + aoff + m * 2048 + k * 1024); } while (0)
#define PG8_LDB(dst, b, h) do { _Pragma("unroll") for (int n = 0; n < 2; ++n) _Pragma("unroll") for (int k = 0; k < 2; ++k) dst[n][k] = *(const PG8_LAS bf16x8*)(lds + PG8_SB(b, h) + boff + n * 2048 + k * 1024); } while (0)
#define PG8_MMA(ai, bj, At, Bt) do { __builtin_amdgcn_s_setprio(1); _Pragma("unroll") for (int m = 0; m < 4; ++m) _Pragma("unroll") for (int n = 0; n < 2; ++n) { \
        if constexpr (FP8) { typedef int v8i_ __attribute__((ext_vector_type(8))); typedef int v4i_ __attribute__((ext_vector_type(4))); \
            const v4i_ b0_ = __builtin_bit_cast(v4i_, Bt[n][0]), b1_ = __builtin_bit_cast(v4i_, Bt[n][1]), a0_ = __builtin_bit_cast(v4i_, At[m][0]), a1_ = __builtin_bit_cast(v4i_, At[m][1]); \
            const v8i_ bb_ = {b0_[0], b0_[1], b0_[2], b0_[3], b1_[0], b1_[1], b1_[2], b1_[3]}, aa_ = {a0_[0], a0_[1], a0_[2], a0_[3], a1_[0], a1_[1], a1_[2], a1_[3]}; \
            acc[ai][bj][m][n] = __builtin_amdgcn_mfma_scale_f32_16x16x128_f8f6f4(bb_, aa_, acc[ai][bj][m][n], 0, 0, 0, 0x7f7f7f7f, 0, 0x7f7f7f7f); } \
        else { _Pragma("unroll") for (int k = 0; k < 2; ++k) acc[ai][bj][m][n] = __builtin_amdgcn_mfma_f32_16x16x32_bf16(Bt[n][k], At[m][k], acc[ai][bj][m][n], 0, 0, 0); } } \
        if constexpr (FP8) { _Pragma("unroll") for (int m = 0; m < 4; ++m) asm volatile("" : "+v"(acc[ai][bj][m][0]), "+v"(acc[ai][bj][m][1])); }     \
        __builtin_amdgcn_s_setprio(0); } while (0)
#define PG8_WAIT_V(n) asm volatile("s_waitcnt vmcnt(" #n ")" ::: "memory")
#define PG8_WAIT_L(n) asm volatile("s_waitcnt lgkmcnt(" #n ")" ::: "memory")
#define PG8_BAR __builtin_amdgcn_s_barrier()
#define PG8_SCHED __builtin_amdgcn_sched_barrier(0)
    Unit cur, nxt; int ui = 0;
    if (!S.next(0, cur)) return;
    f32x4 acc[2][2][4][2];
#pragma unroll
    for (int a = 0; a < 2; ++a)
#pragma unroll
        for (int b = 0; b < 2; ++b)
#pragma unroll
            for (int m = 0; m < 4; ++m)
#pragma unroll
                for (int n = 0; n < 2; ++n) acc[a][b][m][n] = (f32x4){0.f, 0.f, 0.f, 0.f};
    bf16x8 At[4][2], B0[2][2], B1[2][2];
    unsigned crw[2], nrw[2]; const unsigned cc = (unsigned)(CA * 2);
#pragma unroll
    for (int i = 0; i < 2; ++i) {
        if constexpr (GATHER) { crw[i] = (unsigned)S.row(cur.gs + RA0 + 64 * i) | ((unsigned)S.row(cur.gs + HALF + RA0 + 64 * i) << 16); }
        else { crw[i] = 0u; }
        nrw[i] = crw[i]; }
    asm volatile("" : "+v"(crw[0]), "+v"(crw[1]));
#define PG8_STAGE_A(bufoff, gbase, rws, h) do { if constexpr (GATHER) { unsigned vo_[2]; _Pragma("unroll") for (int _j = 0; _j < 2; ++_j) vo_[_j] = (((rws)[_j] >> (16 * (h))) & 0xffffu) * (unsigned)KB + cc; PG8_STAGE_G(bufoff, gbase, vo_); } \
        else { PG8_STAGE_PA(bufoff, (gbase) + (h) * hstepA, voffA); } } while (0)
    const char* cA = cur.a; const char* cB = cur.b;
    S.a_ready(cur);
    if constexpr (SP2) {
        PG8_STAGE(PG8_SB(0, 0), cB, voffB); PG8_STAGE(PG8_SB(0, 1), cB + hstep, voffB); PG8_STAGE_A(PG8_SA(0, 0), cA, crw, 0); PG8_STAGE_A(PG8_SA(0, 1), cA, crw, 1);
        if (wr == 1) PG8_BAR;
        PG8_WAIT_V(2); PG8_BAR;
        PG8_STAGE(PG8_SB(1, 0), cB + kstep, voffB); PG8_STAGE_A(PG8_SA(1, 0), cA + kstep, crw, 0); PG8_STAGE(PG8_SB(1, 1), cB + hstep + kstep, voffB);
        PG8_WAIT_V(6); PG8_BAR;
    } else {
        PG8_STAGE(PG8_SB(0, 0), cB, voffB); PG8_STAGE_A(PG8_SA(0, 0), cA, crw, 0); PG8_STAGE(PG8_SB(0, 1), cB + hstep, voffB); PG8_STAGE_A(PG8_SA(0, 1), cA, crw, 1);
        if (wr == 1) PG8_BAR;
        PG8_WAIT_V(4); PG8_BAR;
        PG8_STAGE(PG8_SB(1, 0), cB + kstep, voffB); PG8_STAGE_A(PG8_SA(1, 0), cA + kstep, crw, 0); PG8_STAGE(PG8_SB(1, 1), cB + hstep + kstep, voffB);
        PG8_WAIT_V(6); PG8_BAR;
    }
    for (;;) {
        const bool has_next = S.next(ui + 1, nxt);
        const char* nA = has_next ? nxt.a : cA; const char* nB = has_next ? nxt.b : cB;
        if constexpr (GATHER) {
            if (has_next) {
#pragma unroll
                for (int i = 0; i < 2; ++i) { nrw[i] = (unsigned)S.row(nxt.gs + RA0 + 64 * i) | ((unsigned)S.row(nxt.gs + HALF + RA0 + 64 * i) << 16); }
                asm volatile("" : "+v"(nrw[0]), "+v"(nrw[1]));
            } else {
#pragma unroll
                for (int i = 0; i < 2; ++i) nrw[i] = crw[i];
            }
        }
        for (int t = 0; t < nt; t += 2) {
            const bool last = (t == nt - 2);
            const char* a1 = cA + (size_t)(t + 1) * kstep;
            const char* a2 = last ? nA : cA + (size_t)(t + 2) * kstep; const char* b2 = last ? nB : cB + (size_t)(t + 2) * kstep;
            const char* a3 = a2 + kstep; const char* b3 = b2 + kstep;
            unsigned srw[2];
#pragma unroll
            for (int i = 0; i < 2; ++i) srw[i] = last ? nrw[i] : crw[i];
            if (last && has_next) S.a_ready(nxt);
            if constexpr (SP2) {
            PG8_LDB(B0, 0, 0); PG8_LDB(B1, 0, 1); PG8_SCHED; PG8_LDA(At, 0, 0); PG8_STAGE_A(PG8_SA(1, 1), a1, crw, 1);
            PG8_WAIT_V(8); PG8_WAIT_L(0); PG8_BAR; PG8_MMA(0, 0, At, B0); PG8_MMA(0, 1, At, B1); PG8_BAR; PG8_SCHED;
            PG8_LDA(At, 0, 1); PG8_STAGE(PG8_SB(0, 0), b2, voffB); PG8_STAGE(PG8_SB(0, 1), b2 + hstep, voffB); PG8_STAGE_A(PG8_SA(0, 0), a2, srw, 0);
            PG8_WAIT_V(8); PG8_WAIT_L(0); PG8_BAR; PG8_MMA(1, 0, At, B0); PG8_MMA(1, 1, At, B1); PG8_BAR; PG8_SCHED;
            PG8_LDB(B0, 1, 0); PG8_LDB(B1, 1, 1); PG8_SCHED; PG8_LDA(At, 1, 0); PG8_STAGE_A(PG8_SA(0, 1), a2, srw, 1);
            PG8_WAIT_V(8); PG8_WAIT_L(0); PG8_BAR; PG8_MMA(0, 0, At, B0); PG8_MMA(0, 1, At, B1); PG8_BAR; PG8_SCHED;
            PG8_LDA(At, 1, 1); PG8_STAGE(PG8_SB(1, 0), b3, voffB); PG8_STAGE(PG8_SB(1, 1), b3 + hstep, voffB); PG8_STAGE_A(PG8_SA(1, 0), a3, srw, 0);
            PG8_WAIT_V(8); PG8_WAIT_L(0); PG8_BAR; PG8_MMA(1, 0, At, B0); PG8_MMA(1, 1, At, B1); PG8_BAR; PG8_SCHED;
            } else {
            PG8_LDB(B0, 0, 0); PG8_SCHED; PG8_LDA(At, 0, 0); PG8_STAGE_A(PG8_SA(1, 1), a1, crw, 1);
            PG8_WAIT_L(8); PG8_BAR; PG8_WAIT_L(0); PG8_MMA(0, 0, At, B0); PG8_BAR; PG8_SCHED;
            PG8_LDB(B1, 0, 1); PG8_STAGE(PG8_SB(0, 0), b2, voffB);
            PG8_BAR; PG8_WAIT_L(0); PG8_MMA(0, 1, At, B1); PG8_BAR;
            PG8_LDA(At, 0, 1); PG8_STAGE_A(PG8_SA(0, 0), a2, srw, 0);
            PG8_BAR; PG8_WAIT_L(0); PG8_MMA(1, 0, At, B0); PG8_BAR; PG8_SCHED;
            PG8_STAGE(PG8_SB(0, 1), b2 + hstep, voffB);
            PG8_WAIT_V(6); PG8_BAR; PG8_MMA(1, 1, At, B1); PG8_BAR;
            PG8_LDB(B0, 1, 0); PG8_SCHED; PG8_LDA(At, 1, 0); PG8_STAGE_A(PG8_SA(0, 1), a2, srw, 1);
            PG8_WAIT_L(8); PG8_BAR; PG8_WAIT_L(0); PG8_MMA(0, 0, At, B0); PG8_BAR; PG8_SCHED;
            PG8_LDB(B1, 1, 1); PG8_STAGE(PG8_SB(1, 0), b3, voffB);
            PG8_BAR; PG8_WAIT_L(0); PG8_MMA(0, 1, At, B1); PG8_BAR;
            PG8_LDA(At, 1, 1); PG8_STAGE_A(PG8_SA(1, 0), a3, srw, 0);
            PG8_BAR; PG8_WAIT_L(0); PG8_MMA(1, 0, At, B0); PG8_BAR; PG8_SCHED;
            PG8_STAGE(PG8_SB(1, 1), b3 + hstep, voffB);
            PG8_WAIT_V(6); PG8_BAR; PG8_MMA(1, 1, At, B1); PG8_BAR;
            }
        }
        if constexpr (ALIGN_EPI) { if (wr == 0) PG8_BAR; }
        E(acc, cur, wr, wc, fr, fq); S.done(cur);
        if (!has_next) break;
        if (!cur.keep) {
#pragma unroll
        for (int a = 0; a < 2; ++a)
#pragma unroll
            for (int b = 0; b < 2; ++b)
#pragma unroll
                for (int m = 0; m < 4; ++m)
#pragma unroll
                    for (int n = 0; n < 2; ++n) acc[a][b][m][n] = (f32x4){0.f, 0.f, 0.f, 0.f};
        }
        cur = nxt; cA = nA; cB = nB; ++ui;
#pragma unroll
        for (int i = 0; i < 2; ++i) crw[i] = nrw[i];
        if constexpr (ALIGN_EPI) { if (wr == 1) PG8_BAR; }
    }
    PG8_WAIT_V(0);
    if constexpr (!ALIGN_EPI) { if (wr == 0) PG8_BAR; }
    PG8_BAR;
#undef PG8_SA
#undef PG8_SB
#undef PG8_STAGE
#undef PG8_STAGE_A
#undef PG8_STAGE_G
#undef PG8_STAGE_PA
#undef PG8_LDA
#undef PG8_LDB
#undef PG8_MMA
#undef PG8_WAIT_V
#undef PG8_WAIT_L
#undef PG8_BAR
#undef PG8_SCHED
}
}
namespace attn_body {
using bf16=__hip_bfloat16;
using bf16x8=__attribute__((ext_vector_type(8)))short;
using s16x4=__attribute__((ext_vector_type(4)))short;
using f32x16=__attribute__((ext_vector_type(16)))float;
using u32x4=__attribute__((ext_vector_type(4)))unsigned;
constexpr int SEQ=4096,D=64,DM=512;
constexpr int NW=8,QBLK=32,QB=QBLK*NW,KVBLK=64,NQB=SEQ/QB;
constexpr int ATTN_PITCH=DM, ATTN_UNIT_ROWS=QB;
__device__ __forceinline__ int crow(int r,int hi){return (r&3)+8*(r>>2)+4*hi;}
#define SBAR() __builtin_amdgcn_sched_barrier(0)
__device__ __forceinline__ void cmask(f32x16&p0,f32x16&p1,int jb,int qrel,int hi){
  const float NEG=-INFINITY; int kb=64*jb+4*hi;
  #pragma unroll
  for(int r=0;r<16;++r){int kv=kb+(r&3)+8*(r>>2); if(kv>qrel)p0[r]=NEG; if(kv+32>qrel)p1[r]=NEG;}
}

constexpr int NSLOT=3, SLOTB=8192;
constexpr int LDS_K=0, LDS_V=NSLOT*SLOTB, LDS_WS=3*NSLOT*SLOTB, LDS_OST=LDS_WS+NW*64*4, LDS_BYTES=LDS_OST+NW*4096;
__device__ __forceinline__ void glds16(const void*sbase,unsigned voff,unsigned lds_dst){unsigned keep;
  asm volatile("s_mov_b32 %0, m0\n\ts_mov_b32 m0, %3\n\ts_nop 0\n\tglobal_load_lds_dwordx4 %1, %2\n\ts_mov_b32 m0, %0":"=&s"(keep):"v"(voff),"s"(sbase),"s"(lds_dst):"memory");}
__device__ __forceinline__ float max3f(float a,float b,float c){float r;asm("v_max3_f32 %0, %1, %2, %3":"=v"(r):"v"(a),"v"(b),"v"(c));return r;}
__device__ __forceinline__ float max2f(float a,float b){float r;asm("v_max_f32_e32 %0, %1, %2":"=v"(r):"v"(a),"v"(b));return r;}
__device__ __forceinline__ float fadd_s(float a,float b){float r;asm("v_add_f32_e32 %0, %1, %2":"=v"(r):"v"(a),"v"(b));return r;}
__device__ __forceinline__ float fsub_s(float a,float b){float r;asm("v_sub_f32_e32 %0, %1, %2":"=v"(r):"v"(a),"v"(b));return r;}
typedef float f32x2_t __attribute__((ext_vector_type(2))); typedef __bf16 bf16x2_t __attribute__((ext_vector_type(2)));
__device__ __forceinline__ unsigned cvtpk_s(float lo,float hi){f32x2_t v={lo,hi};bf16x2_t b=__builtin_convertvector(v,bf16x2_t);return __builtin_bit_cast(unsigned,b);}
#define WAIT_BAR(N) asm volatile("s_waitcnt vmcnt(" #N ") lgkmcnt(0)\n\ts_barrier":::"memory")

__device__ __forceinline__ void qkt(f32x16&p0,f32x16&p1,const char*Kslot,const bf16x8*qr,const f32x16&negm,int r32,int hi){
  const char*kb=Kslot+hi*1024+r32*16;
  #pragma unroll
  for(int d0=0;d0<4;++d0){
    const bf16x8 b0=*reinterpret_cast<const bf16x8*>(kb+d0*2048);
    const bf16x8 b1=*reinterpret_cast<const bf16x8*>(kb+d0*2048+512);
    if(d0==0){p0=__builtin_amdgcn_mfma_f32_32x32x16_bf16(b0,qr[0],negm,0,0,0);p1=__builtin_amdgcn_mfma_f32_32x32x16_bf16(b1,qr[0],negm,0,0,0);}
    else{p0=__builtin_amdgcn_mfma_f32_32x32x16_bf16(b0,qr[d0],p0,0,0,0);p1=__builtin_amdgcn_mfma_f32_32x32x16_bf16(b1,qr[d0],p1,0,0,0);}}
}
typedef __attribute__((address_space(3))) const char* lds_cptr;
typedef short v4i16_t __attribute__((ext_vector_type(4)));
__device__ __forceinline__ void kload8(bf16x8*kf,lds_cptr kp){
  kf[0]=*(const __attribute__((address_space(3))) bf16x8*)(kp);      kf[1]=*(const __attribute__((address_space(3))) bf16x8*)(kp+512);
  kf[2]=*(const __attribute__((address_space(3))) bf16x8*)(kp+2048); kf[3]=*(const __attribute__((address_space(3))) bf16x8*)(kp+2560);
  kf[4]=*(const __attribute__((address_space(3))) bf16x8*)(kp+4096); kf[5]=*(const __attribute__((address_space(3))) bf16x8*)(kp+4608);
  kf[6]=*(const __attribute__((address_space(3))) bf16x8*)(kp+6144); kf[7]=*(const __attribute__((address_space(3))) bf16x8*)(kp+6656);
}
__device__ __forceinline__ void kload2(bf16x8*kf,lds_cptr kp,int j){ kf[2*j]=*(const __attribute__((address_space(3))) bf16x8*)(kp+j*2048); kf[2*j+1]=*(const __attribute__((address_space(3))) bf16x8*)(kp+j*2048+512); }
__device__ __forceinline__ s16x4 vtr(lds_cptr p){ return __builtin_bit_cast(s16x4,__builtin_amdgcn_ds_read_tr16_b64_v4i16((__attribute__((address_space(3))) v4i16_t*)p)); }
__device__ __forceinline__ float rowmax(const f32x16&p0,const f32x16&p1){
  float a=max3f(p0[0],p0[1],p1[0]),b=max3f(p0[2],p0[3],p1[1]);a=max3f(a,p1[2],p1[3]);
  #pragma unroll
  for(int r=4;r<16;r+=4){a=max3f(a,p0[r],p0[r+1]);b=max3f(b,p0[r+2],p0[r+3]);a=max3f(a,p1[r],p1[r+1]);b=max3f(b,p1[r+2],p1[r+3]);}
  const float m=max2f(a,b);
  auto rr=__builtin_amdgcn_permlane32_swap(__float_as_uint(m),__float_as_uint(m),false,false);
  return max2f(__uint_as_float(rr[0]),__uint_as_float(rr[1]));
}
__device__ __forceinline__ void pv(f32x16*o,int vb,bf16x8 pa0,bf16x8 pa1,bf16x8 pa2,bf16x8 pa3){
  #pragma unroll
  for(int d0=0;d0<4;++d0){s16x4 lo[4],hi[4];
    #pragma unroll
    for(int ks=0;ks<4;++ks){
      asm volatile("ds_read_b64_tr_b16 %0,%1 offset:%c2":"=&v"(lo[ks]):"v"(vb),"i"(d0*4096+ks*1024):"memory");
      asm volatile("ds_read_b64_tr_b16 %0,%1 offset:%c2":"=&v"(hi[ks]):"v"(vb),"i"(d0*4096+ks*1024+512):"memory");}
    asm volatile("s_waitcnt lgkmcnt(0)":::"memory");SBAR();
    #define PK(k) (bf16x8){lo[k][0],lo[k][1],lo[k][2],lo[k][3],hi[k][0],hi[k][1],hi[k][2],hi[k][3]}
    o[d0]=__builtin_amdgcn_mfma_f32_32x32x16_bf16(pa0,PK(0),o[d0],0,0,0);
    o[d0]=__builtin_amdgcn_mfma_f32_32x32x16_bf16(pa1,PK(1),o[d0],0,0,0);
    o[d0]=__builtin_amdgcn_mfma_f32_32x32x16_bf16(pa2,PK(2),o[d0],0,0,0);
    o[d0]=__builtin_amdgcn_mfma_f32_32x32x16_bf16(pa3,PK(3),o[d0],0,0,0);
    #undef PK
  }
}

#ifndef ATTN_STORE16
#define ATTN_STORE16(p,v) (*(u32x4*)(p)=(v))
#endif
template<int THRL> __device__ __forceinline__ void attn_unit(int b,int h,int hv,int qb,const bf16*Q,const bf16*__restrict__ K,const bf16*__restrict__ V,bf16*O,char*shm){
  int tid_=threadIdx.x; asm volatile("":"+v"(tid_)); const int tid=tid_,lane=tid&63,r32=lane&31,hi=lane>>5; const int wid=__builtin_amdgcn_readfirstlane(tid>>6);
  const long rowbase=(long)b*SEQ; const int q0=qb*QB;
  const bf16*Qw=Q+(rowbase+q0+wid*QBLK)*DM+h*D;
  const bf16*Kh=K+rowbase*DM+h*D,*Vh=V+rowbase*DM+hv*2*D;
  const unsigned lds0=(unsigned)(uintptr_t)shm;
  float*wsf=(float*)(shm+LDS_WS)+wid*64;
  const unsigned koff=(unsigned)((lane*DM+wid*8)*2);
  const unsigned voff=(unsigned)(((16*(wid&3)+(lane>>2))*DM+(wid>>2)*32+(lane&3)*8)*2);
  const unsigned kdst=lds0+LDS_K+wid*1024, vdst=lds0+LDS_V+wid*1024;
  #define DMA_K(t,slot) glds16(Kh+(long)(t)*KVBLK*DM,koff,(unsigned)__builtin_amdgcn_readfirstlane(kdst+(slot)))
  #define DMA_V(t,slot) do{ glds16(Vh+(long)(t)*KVBLK*DM,voff,(unsigned)__builtin_amdgcn_readfirstlane(vdst+2*(slot))); glds16(Vh+(long)(t)*KVBLK*DM+64,voff,(unsigned)__builtin_amdgcn_readfirstlane(vdst+2*(slot)+8192)); }while(0)
  const int vb0=(int)(lds0+LDS_V)+((lane>>4)&1)*32+(lane&3)*8+(4*hi+((lane&15)>>2))*64;
  const char*Kbase=shm+LDS_K; bf16x8 kf[8];
  const lds_cptr shm3=(lds_cptr)shm; const lds_cptr kp0=shm3+LDS_K+hi*1024+r32*16; const lds_cptr vp0=shm3+LDS_V+((lane>>4)&1)*32+(lane&3)*8+(4*hi+((lane&15)>>2))*64;
  const int NT=(q0+QB)/KVBLK;
  DMA_K(0,0);DMA_V(0,0);DMA_K(1,SLOTB);
  bf16x8 qr[4];
  #pragma unroll
  for(int d0=0;d0<4;++d0)qr[d0]=*reinterpret_cast<const bf16x8*>(&Qw[(long)r32*DM+d0*16+hi*8]);
  float mhat=0.f,l_reg=0.f;f32x16 o[4];o[0]=f32x16{};o[1]=f32x16{};o[2]=f32x16{};o[3]=f32x16{};f32x16 negm=f32x16{};asm volatile("":"+v"(negm));
  const int qrel=wid*QBLK+r32;
  #define CMASK(P0,P1,t) do{int jb_=(t)-(NT-4); if(jb_>=0)cmask(P0,P1,jb_,qrel,hi);}while(0)
  bool resc=false;
  #define START(P0,P1) do{ const float rm=rowmax(P0,P1); resc=false; \
    { const float dl=rm; mhat=fadd_s(mhat,dl); \
      _Pragma("unroll") for(int r=0;r<16;++r){P0[r]=fsub_s(P0[r],dl);P1[r]=fsub_s(P1[r],dl);} \
      _Pragma("unroll") for(int r=0;r<16;++r)negm[r]=-mhat; asm volatile("":"+v"(negm)); } \
    _Pragma("unroll") for(int r=0;r<16;++r)P0[r]=__builtin_amdgcn_exp2f(P0[r]); }while(0)
  #define RESC() do{ if(resc){ asm volatile("s_waitcnt lgkmcnt(0)":::"memory"); \
      _Pragma("unroll") for(int d_=0;d_<4;++d_) _Pragma("unroll") for(int r=0;r<16;++r)o[d_][r]*=wsf[crow(r,hi)]; } }while(0)
  f32x16 pA0,pA1,pB0,pB1;
  int sl_prev=0,sl_cur=0,sl_next=SLOTB;
  #define ROT() do{sl_prev=sl_cur;sl_cur=sl_next;sl_next=(sl_next==(NSLOT-1)*SLOTB)?0:sl_next+SLOTB;}while(0)
  DMA_K(2,2*SLOTB);
  WAIT_BAR(3);
  qkt(pA0,pA1,Kbase,qr,negm,r32,hi);asm volatile("s_nop 15\n\ts_nop 7":"+v"(pA0),"+v"(pA1));CMASK(pA0,pA1,0);
  START(pA0,pA1);
  _Pragma("unroll") for(int r=0;r<16;++r)pA1[r]=__builtin_amdgcn_exp2f(pA1[r]);
  WAIT_BAR(0);
  DMA_K(3,0);DMA_V(1,SLOTB);
  ROT();
  kload8(kf,kp0+sl_cur);
  WAIT_BAR(3);
  s16x4 vlo[8],vhi[8]; u32x4 pw0,pw1,pw2,pw3;
  #define PKW(P,B) cvtpk_s(P[B],P[B+1])
  #define PAF(k) __builtin_bit_cast(bf16x8,pw##k)
  #define VFR(i) (bf16x8){vlo[i][0],vlo[i][1],vlo[i][2],vlo[i][3],vhi[i][0],vhi[i][1],vhi[i][2],vhi[i][3]}
  #define PIN(x) asm volatile("":"+v"(x))
  #define MX3(a,b,c) __builtin_fmaxf(__builtin_fmaxf((a),(b)),(c))
  #define GAPA(MF,A0,A1,A2,A3,W0,W1,PW) do{ MF; sacc+=A0; sacc+=A1; sacc+=A2; sacc+=A3; PIN(sacc); W0; W1; PIN(PW); SBAR(); }while(0)
  #define EX(v) __builtin_amdgcn_exp2f(v)
  #define GAPB(MF,X,B,RD) do{ MF; RD; X[B]=EX(X[B]); X[B+1]=EX(X[B+1]); PIN(X); SBAR(); }while(0)
  #define VRDS(f,sl) do{ vlo[sl]=vtr(vp_+(((f)>>2)*4096+((f)&3)*1024)); vhi[sl]=vtr(vp_+(((f)>>2)*4096+((f)&3)*1024+512)); }while(0)
  #define NORD do{}while(0)
  #define KRD(G,j) do{ if(G){ kload2(kf,kp0+sl_next,j); SBAR(); } }while(0)
  #define STEP(C0,C1,P0,P1,t,GK,GV,GL) do{ SBAR(); \
    const lds_cptr vp_=vp0+2*sl_prev; \
    float sacc=(P0[0]+P0[1]); \
    GAPA(C0=__builtin_amdgcn_mfma_f32_32x32x16_bf16(kf[0],qr[0],negm,0,0,0), P0[2],P0[3],P0[4],P0[5],     pw0[0]=PKW(P0,0), pw0[1]=PKW(P0,2), pw0); \
    GAPA(C1=__builtin_amdgcn_mfma_f32_32x32x16_bf16(kf[1],qr[0],negm,0,0,0), P0[6],P0[7],P0[8],P0[9],     pw0[2]=PKW(P0,4), pw0[3]=PKW(P0,6), pw0); \
    GAPA(C0=__builtin_amdgcn_mfma_f32_32x32x16_bf16(kf[2],qr[1],C0,0,0,0),   P0[10],P0[11],P0[12],P0[13], pw1[0]=PKW(P0,8), pw1[1]=PKW(P0,10), pw1); \
    GAPA(C1=__builtin_amdgcn_mfma_f32_32x32x16_bf16(kf[3],qr[1],C1,0,0,0),   P0[14],P0[15],P1[0],P1[1],   pw1[2]=PKW(P0,12),pw1[3]=PKW(P0,14), pw1); \
    VRDS(0,0);  SBAR(); GAPA(C0=__builtin_amdgcn_mfma_f32_32x32x16_bf16(kf[4],qr[2],C0,0,0,0),   P1[2],P1[3],P1[4],P1[5],     pw2[0]=PKW(P1,0), pw2[1]=PKW(P1,2), pw2); \
    VRDS(4,1);  SBAR(); GAPA(C1=__builtin_amdgcn_mfma_f32_32x32x16_bf16(kf[5],qr[2],C1,0,0,0),   P1[6],P1[7],P1[8],P1[9],     pw2[2]=PKW(P1,4), pw2[3]=PKW(P1,6), pw2); \
    VRDS(8,2);  SBAR(); GAPA(C0=__builtin_amdgcn_mfma_f32_32x32x16_bf16(kf[6],qr[3],C0,0,0,0),   P1[10],P1[11],P1[12],P1[13], pw3[0]=PKW(P1,8), pw3[1]=PKW(P1,10), pw3); \
    VRDS(12,3); SBAR(); GAPA(C1=__builtin_amdgcn_mfma_f32_32x32x16_bf16(kf[7],qr[3],C1,0,0,0),   P1[14],P1[15],0.f,0.f,       pw3[2]=PKW(P1,12),pw3[3]=PKW(P1,14), pw3); \
    l_reg+=sacc; \
    if(GK){DMA_K((t)+3,sl_cur);} if(GV){DMA_V((t)+1,sl_next);} \
    CMASK(C0,C1,t); \
    { float a=MX3(C0[0],C0[1],C1[0]),b=MX3(C0[2],C0[3],C1[1]); a=MX3(a,C1[2],C1[3]); \
      _Pragma("unroll") for(int r=4;r<16;r+=4){a=MX3(a,C0[r],C0[r+1]);b=MX3(b,C0[r+2],C0[r+3]);a=MX3(a,C1[r],C1[r+1]);b=MX3(b,C1[r+2],C1[r+3]);} \
      float rm=__builtin_fmaxf(a,b); { auto rr=__builtin_amdgcn_permlane32_swap(__float_as_uint(rm),__float_as_uint(rm),false,false); rm=__builtin_fmaxf(__uint_as_float(rr[0]),__uint_as_float(rr[1])); } \
      resc=false; \
      if(__builtin_expect(__any(rm>(float)THRL),0)){ const float dl=__builtin_fmaxf(rm,0.f); mhat+=dl; \
        _Pragma("unroll") for(int r=0;r<16;++r){C0[r]-=dl;C1[r]-=dl;} \
        _Pragma("unroll") for(int r=0;r<16;++r)negm[r]=-mhat; asm volatile("":"+v"(negm)); \
        const float f=__builtin_amdgcn_exp2f(-dl); l_reg*=f; if(hi==0)wsf[r32]=f; resc=true; } } \
    SBAR(); \
    GAPB(o[0]=__builtin_amdgcn_mfma_f32_32x32x16_bf16(PAF(0),VFR(0),o[0],0,0,0), C0,0,  VRDS(1,4)); \
    GAPB(o[1]=__builtin_amdgcn_mfma_f32_32x32x16_bf16(PAF(0),VFR(1),o[1],0,0,0), C0,2,  VRDS(5,5)); \
    GAPB(o[2]=__builtin_amdgcn_mfma_f32_32x32x16_bf16(PAF(0),VFR(2),o[2],0,0,0), C0,4,  VRDS(9,6)); \
    GAPB(o[3]=__builtin_amdgcn_mfma_f32_32x32x16_bf16(PAF(0),VFR(3),o[3],0,0,0), C0,6,  VRDS(13,7)); \
    KRD(GL,0); GAPB(o[0]=__builtin_amdgcn_mfma_f32_32x32x16_bf16(PAF(1),VFR(4),o[0],0,0,0), C0,8,  VRDS(2,0)); \
    GAPB(o[1]=__builtin_amdgcn_mfma_f32_32x32x16_bf16(PAF(1),VFR(5),o[1],0,0,0), C0,10, VRDS(6,1)); \
    KRD(GL,1); GAPB(o[2]=__builtin_amdgcn_mfma_f32_32x32x16_bf16(PAF(1),VFR(6),o[2],0,0,0), C0,12, VRDS(10,2)); \
    GAPB(o[3]=__builtin_amdgcn_mfma_f32_32x32x16_bf16(PAF(1),VFR(7),o[3],0,0,0), C0,14, VRDS(14,3)); \
    KRD(GL,2); GAPB(o[0]=__builtin_amdgcn_mfma_f32_32x32x16_bf16(PAF(2),VFR(0),o[0],0,0,0), C1,0,  VRDS(3,4)); \
    GAPB(o[1]=__builtin_amdgcn_mfma_f32_32x32x16_bf16(PAF(2),VFR(1),o[1],0,0,0), C1,2,  VRDS(7,5)); \
    KRD(GL,3); GAPB(o[2]=__builtin_amdgcn_mfma_f32_32x32x16_bf16(PAF(2),VFR(2),o[2],0,0,0), C1,4,  VRDS(11,6)); \
    GAPB(o[3]=__builtin_amdgcn_mfma_f32_32x32x16_bf16(PAF(2),VFR(3),o[3],0,0,0), C1,6,  VRDS(15,7)); \
    GAPB(o[0]=__builtin_amdgcn_mfma_f32_32x32x16_bf16(PAF(3),VFR(4),o[0],0,0,0), C1,8,  NORD); \
    GAPB(o[1]=__builtin_amdgcn_mfma_f32_32x32x16_bf16(PAF(3),VFR(5),o[1],0,0,0), C1,10, NORD); \
    GAPB(o[2]=__builtin_amdgcn_mfma_f32_32x32x16_bf16(PAF(3),VFR(6),o[2],0,0,0), C1,12, NORD); \
    GAPB(o[3]=__builtin_amdgcn_mfma_f32_32x32x16_bf16(PAF(3),VFR(7),o[3],0,0,0), C1,14, NORD); \
    }while(0)
  int t=1;
  #undef CMASK
  #define CMASK(P0,P1,t) do{}while(0)
  for(;t+5<NT;t+=2){
    STEP(pB0,pB1,pA0,pA1,t,true,true,true);     WAIT_BAR(3); RESC(); ROT();
    STEP(pA0,pA1,pB0,pB1,t+1,true,true,true);   WAIT_BAR(3); RESC(); ROT();
  }
  #undef CMASK
  #define CMASK(P0,P1,t) do{int jb_=(t)-(NT-4); if(jb_>=0)cmask(P0,P1,jb_,qrel,hi);}while(0)
  #define ENDW(tt) do{ if((tt)+3<NT){WAIT_BAR(3);} else if((tt)+2<NT){WAIT_BAR(2);} else {WAIT_BAR(0);} }while(0)
  for(;t+1<NT;t+=2){
    STEP(pB0,pB1,pA0,pA1,t,(t+3<NT),(t+1<NT),(t+1<NT));       ENDW(t);   RESC(); ROT();
    STEP(pA0,pA1,pB0,pB1,t+1,(t+4<NT),(t+2<NT),(t+2<NT));     ENDW(t+1); RESC(); ROT();
  }
  STEP(pB0,pB1,pA0,pA1,NT-1,false,false,false); RESC();
  { float sacc=pB0[0]+pB0[1]; _Pragma("unroll") for(int r=2;r<16;++r)sacc+=pB0[r]; _Pragma("unroll") for(int r=0;r<16;++r)sacc+=pB1[r]; l_reg+=sacc;
    pw0=(u32x4){PKW(pB0,0),PKW(pB0,2),PKW(pB0,4),PKW(pB0,6)};pw1=(u32x4){PKW(pB0,8),PKW(pB0,10),PKW(pB0,12),PKW(pB0,14)};pw2=(u32x4){PKW(pB1,0),PKW(pB1,2),PKW(pB1,4),PKW(pB1,6)};pw3=(u32x4){PKW(pB1,8),PKW(pB1,10),PKW(pB1,12),PKW(pB1,14)};
    SBAR(); pv(o,vb0+2*sl_cur,PAF(0),PAF(1),PAF(2),PAF(3)); }
  #undef PKW
  #undef PAF
  #undef VFR
  #undef PIN
  #undef MX3
  #undef GAPA
  #undef GAPB
  #undef EX
  #undef VRDS
  #undef NORD
  #undef KRD
  #undef STEP
  #undef ENDW
  {auto rr=__builtin_amdgcn_permlane32_swap(__float_as_uint(l_reg),__float_as_uint(l_reg),false,false);l_reg=__uint_as_float(rr[0])+__uint_as_float(rr[1]);}
  if(hi==0)wsf[32+r32]=l_reg;asm volatile("s_waitcnt lgkmcnt(0)":::"memory");
  float rli[16];
  #pragma unroll
  for(int r=0;r<16;++r)rli[r]=__builtin_amdgcn_rcpf(wsf[32+crow(r,hi)]);
  bf16*Ow=O+(rowbase+q0+wid*QBLK)*DM+hv*2*D;
  { bf16*stg=(bf16*)(shm+LDS_OST)+wid*2048;
    #pragma unroll
    for(int vh=0;vh<2;++vh){
    #pragma unroll
    for(int r=0;r<16;++r){const int orow=crow(r,hi);
      #pragma unroll
      for(int d0=0;d0<2;++d0)stg[orow*64+d0*32+r32]=__float2bfloat16(o[2*vh+d0][r]*rli[r]);}
    asm volatile("s_waitcnt lgkmcnt(0)":::"memory");
    #pragma unroll
    for(int i=0;i<4;++i){const int row=i*8+(lane>>3),ch=lane&7; const u32x4 v=*(const u32x4*)(stg+row*64+ch*8); ATTN_STORE16(Ow+(long)row*DM+vh*64+ch*8,v);}
    asm volatile("s_waitcnt lgkmcnt(0)":::"memory"); } }
  asm volatile("s_waitcnt lgkmcnt(0)\n\ts_barrier":::"memory");
  #undef DMA_K
  #undef DMA_V
  #undef CMASK
  #undef START
  #undef RESC
  #undef ROT
}
constexpr int ATTN_LDS_BYTES=LDS_BYTES;
#undef SBAR
#undef WAIT_BAR
}

constexpr size_t MiB = 1u << 20;
constexpr size_t WS_CTL = 0, CTL_ZERO_BYTES = 1 * MiB;
constexpr size_t WS_LRUS = 1 * MiB;
constexpr size_t WS_TOKE = 2 * MiB;
constexpr size_t WS_TOKW = 2 * MiB + 512 * 1024;
constexpr size_t WS_SLOTT = 3 * MiB;
constexpr size_t WS_SLOTW = 3 * MiB + 512 * 1024;
constexpr size_t WS_ROPE = 6 * MiB;
constexpr size_t WS_WIN = 14 * MiB;
constexpr size_t WS_WBR = 29 * MiB;
constexpr size_t WS_WOUT = 32 * MiB;
constexpr size_t WS_XN = 34 * MiB;
constexpr size_t WS_A = 98 * MiB;
constexpr size_t WS_LRUX = WS_A, WS_LRUG = WS_A + 32 * MiB, WS_Q = WS_A + 64 * MiB, WS_K = WS_A + 96 * MiB, WS_V = WS_A + 128 * MiB;
constexpr size_t WS_GQ = WS_A + 160 * MiB, WS_GK = WS_A + 176 * MiB, WS_GV = WS_A + 192 * MiB, WS_GR = WS_A + 224 * MiB, WS_GG = WS_A + 256 * MiB;
constexpr size_t WS_GATES = WS_A;
constexpr size_t WS_O0 = 386 * MiB, WS_O1 = 418 * MiB;
constexpr size_t WS_YLRU = 450 * MiB, WS_YDA = 482 * MiB, WS_YGLA = 514 * MiB;
constexpr size_t WS_WFFN = 98 * MiB;
constexpr size_t WS_H = 266 * MiB;
constexpr size_t WS_Y2 = 504 * MiB;
constexpr size_t WS_PG = 546 * MiB;
constexpr size_t WS_XN8 = 290 * MiB;
constexpr size_t WS_Y1 = 186 * MiB;
constexpr size_t WS_END = 578 * MiB;
constexpr size_t W13_ELEMS = (size_t)2 * DFF * DM, W2_ELEMS = (size_t)DM * DFF, WEXP_ELEMS = W13_ELEMS + W2_ELEMS;
constexpr int CW_TMO = 0, CW_CODE = 1;
constexpr int CW_BAR = 4096;
constexpr int CW_GCNT = 8192;
constexpr int CW_QHEAD = 12288;
constexpr int RING_BYTES = 131072;
constexpr int LDSCTL_OFF = RING_BYTES;
constexpr int LDS_BYTES = 147456;
constexpr int MW_DEQ = 0, MW_BAR = 8, MW_TS = 16  , MW_HIST = 32, MW_BASE = 40, MW_ROWINFO = 64  ;
constexpr int NWAVES = 8;
#ifndef MK_ONE_LAUNCH
#define MK_ONE_LAUNCH 1
#endif
constexpr int PH_PER_LAYER = 11, N_PHASES = 2 * PH_PER_LAYER + 1;

#define XB_TMO      128
#define XB_XCNT(j)  (256  + 64 * (j))
#define XB_XSUB(j)  (1280 + 64 * (j))
#define XB_XGEN(j)  (2304 + 64 * (j))
#define XB_TOP      3328
#define XB_TOPGEN   3392
#define XCD_BAR_WORDS 3456
#define XB_SPIN_CAP (1u << 22)

__device__ __forceinline__ unsigned xb_ld(unsigned* p)              { return __hip_atomic_load(p, __ATOMIC_RELAXED, __HIP_MEMORY_SCOPE_AGENT); }
__device__ __forceinline__ unsigned xb_add(unsigned* p, unsigned v) { return __hip_atomic_fetch_add(p, v, __ATOMIC_RELAXED, __HIP_MEMORY_SCOPE_AGENT); }
__device__ __forceinline__ unsigned xb_xcc_id() { return (unsigned)__builtin_amdgcn_s_getreg((3 << 11) | 20) & 0xFu; }
#define XB_SPIN(cond, bar) do { unsigned _sp = 0; while (cond) { __builtin_amdgcn_s_sleep(1); \
    if ((++_sp & 255u) == 0u) { if (xb_ld(&(bar)[XB_TMO])) break; if (_sp > XB_SPIN_CAP) { atomicAdd(&(bar)[XB_TMO], 1u); break; } } } } while (0)

struct XcdBarrier { unsigned* bar; unsigned x; volatile LAS unsigned* st; };

__device__ __forceinline__ XcdBarrier xcd_barrier_post(unsigned* bar, volatile LAS unsigned* st) {
    XcdBarrier b; b.bar = bar; b.x = xb_xcc_id(); b.st = st;
    if (threadIdx.x == 0) (void)xb_add(&bar[XB_XCNT(b.x)], 1u);
    return b;
}
__device__ __forceinline__ void xcd_barrier_complete(unsigned* bar, unsigned x, unsigned& nloc, unsigned& nx) {
    const unsigned G = gridDim.x * gridDim.y * gridDim.z;
    unsigned sum, cnt, mine, sp = 0u;
    for (;;) {
        sum = 0u; cnt = 0u; mine = 0u;
#pragma unroll
        for (unsigned j = 0; j < 16; ++j) { const unsigned c = xb_ld(&bar[XB_XCNT(j)]); sum += c; cnt += (c > 0u) ? 1u : 0u; mine = (j == x) ? c : mine; }
        if (sum == G) break;
        __builtin_amdgcn_s_sleep(1);
        if ((++sp & 255u) == 0u) { if (xb_ld(&bar[XB_TMO])) break; if (sp > XB_SPIN_CAP) { atomicAdd(&bar[XB_TMO], 1u); break; } }
    }
    nloc = mine > 0u ? mine : 1u; nx = cnt > 0u ? cnt : 1u;
}
__device__ __forceinline__ void xcd_barrier(const XcdBarrier& b0) {
    XcdBarrier b = b0; { unsigned long long p_ = (unsigned long long)b.bar; asm volatile("" : "+s"(p_)); b.bar = (unsigned*)p_; }
    asm volatile("s_waitcnt vmcnt(0)" ::: "memory");
    __syncthreads();
    if (threadIdx.x == 0) {
        unsigned* bar = b.bar;
        __builtin_amdgcn_s_waitcnt(0);
        unsigned nloc = b.st[0], nx = b.st[1];
        if (nloc == 0u) { xcd_barrier_complete(bar, b.x, nloc, nx); b.st[0] = nloc; b.st[1] = nx; }
        const unsigned old = xb_add(&bar[XB_XSUB(b.x)], 1u);
        const unsigned gen = old / nloc;
        if (old + 1u == (gen + 1u) * nloc) {
            __builtin_amdgcn_fence(__ATOMIC_RELEASE, "agent");
            asm volatile("s_waitcnt vmcnt(0)" ::: "memory");
            const unsigned og = xb_add(&bar[XB_TOP], 1u);
            const unsigned tg = og / nx;
            if (og + 1u == (tg + 1u) * nx) xb_add(&bar[XB_TOPGEN], 1u);
            else XB_SPIN(xb_ld(&bar[XB_TOPGEN]) == tg, bar);
            __builtin_amdgcn_fence(__ATOMIC_ACQUIRE, "agent");
            xb_add(&bar[XB_XGEN(b.x)], 1u);
            asm volatile("s_waitcnt vmcnt(0)" ::: "memory");
        } else {
            XB_SPIN(xb_ld(&bar[XB_XGEN(b.x)]) == gen, bar);
            __builtin_amdgcn_fence(__ATOMIC_ACQUIRE, "agent");
            asm volatile("s_waitcnt vmcnt(0)" ::: "memory");
        }
    }
    __syncthreads();
}

struct Args { const void* in[30]; float* out; unsigned char* ws; int ph_lo, ph_hi; };
struct Frame {
    LAS unsigned char* lds;
    volatile LAS unsigned* MISC;
    gu32* ctl;
    GAS unsigned char* ws;
    const char __attribute__((address_space(4)))* karg;
    int tid, lane, wave, vcu, G;
    float* out;
};
#define FIN(T, k) ((const T*)(const GAS T*)(*(const unsigned long long __attribute__((address_space(4)))*)(F.karg + 8 * (k))))
#define IN_x FIN(float, 0)
#define IN_positions FIN(int, 1)
#define IN_mix_norm FIN(float, 2)
#define IN_w_in FIN(float, 3)
#define IN_conv_w FIN(float, 4)
#define IN_conv_b FIN(float, 5)
#define IN_lru_wa FIN(float, 6)
#define IN_lru_ba FIN(float, 7)
#define IN_lru_wx FIN(float, 8)
#define IN_lru_bx FIN(float, 9)
#define IN_lru_lambda FIN(float, 10)
#define IN_da_lq1 FIN(float, 11)
#define IN_da_lk1 FIN(float, 12)
#define IN_da_lq2 FIN(float, 13)
#define IN_da_lk2 FIN(float, 14)
#define IN_da_subln FIN(float, 15)
#define IN_gla_wa2 FIN(float, 16)
#define IN_gla_ba FIN(float, 17)
#define IN_gla_norm FIN(float, 18)
#define IN_w_branch FIN(float, 19)
#define IN_w_out FIN(float, 20)
#define IN_ffn_norm FIN(float, 21)
#define IN_dense_w1 FIN(float, 22)
#define IN_dense_w3 FIN(float, 23)
#define IN_dense_w2 FIN(float, 24)
#define IN_router FIN(float, 25)
#define IN_moe_w1 FIN(float, 26)
#define IN_moe_w3 FIN(float, 27)
#define IN_moe_w2 FIN(float, 28)
#define IN_final_norm FIN(float, 29)
#define WSP(T, off) ((T*)(GAS T*)(F.ws + (off)))
#define WSL(T, off) ((T*)(GAS T*)(FL.ws + (off)))
__device__ __forceinline__ void relaunder(Frame& F) { int t = threadIdx.x; asm volatile("" : "+v"(t)); F.tid = t; F.lane = t & 63; F.wave = __builtin_amdgcn_readfirstlane(t >> 6);
    unsigned long long w = (unsigned long long)F.ws; asm volatile("" : "+s"(w)); F.ws = (GAS unsigned char*)w;
    int gg_ = F.G; asm volatile("" : "+s"(gg_)); F.G = gg_; int vc_ = F.vcu; asm volatile("" : "+s"(vc_)); F.vcu = vc_;
    unsigned long long ka = (unsigned long long)F.karg; asm volatile("" : "+s"(ka)); F.karg = (const char __attribute__((address_space(4)))*)ka; }

#define EPI_ROWLOOP(ai, m) _Pragma("unroll") for (int ai = 0; ai < 2; ++ai) _Pragma("unroll") for (int m = 0; m < 4; ++m)
__device__ __forceinline__ v4u pack8(const f32x4& a, const f32x4& b) { v4u w; w.x = pk2(a[0], a[1]); w.y = pk2(a[2], a[3]); w.z = pk2(b[0], b[1]); w.w = pk2(b[2], b[3]); return w; }
__device__ __forceinline__ float gelu_tanh(float x) { const float t = 1.5957691216057308f * (x + 0.044715f * x * x * x); return x * __builtin_amdgcn_rcpf(1.f + __expf(-t)); }
__device__ __forceinline__ float silu_f(float x) { return x * __builtin_amdgcn_rcpf(1.f + __expf(-x)); }
__device__ __forceinline__ f32x4 sigmoid4(const f32x4& x, float sc) { f32x4 t = x * (-1.4426950408889634f * sc);
#pragma unroll
    for (int q = 0; q < 4; ++q) t[q] = __builtin_amdgcn_exp2f(t[q]);
    t = t + 1.f;
#pragma unroll
    for (int q = 0; q < 4; ++q) t[q] = __builtin_amdgcn_rcpf(t[q]);
    return t; }
__device__ __forceinline__ f32x4 silu4(const f32x4& x) { return x * sigmoid4(x, 1.f); }
__device__ __forceinline__ f32x4 gelu_tanh4(const f32x4& x) { const f32x4 w = (x * x) * (0.044715f * 1.5957691216057308f) + 1.5957691216057308f; return x * sigmoid4(x * w, 1.f); }
__device__ __forceinline__ float log1p_fast(float e) { return e < 0.03125f ? e * (1.f + e * (-0.5f + e * (0.33333334f - 0.25f * e))) : __logf(1.f + e); }
__device__ __forceinline__ float logsig(float z) { return fminf(z, 0.f) - log1p_fast(__expf(-fabsf(z))); }

struct EpiInProj {
    bf16 *LRUX, *LRUG, *Q, *K, *V, *GQ, *GK, *GV, *GR; float* GG; const f32x2* rope; const float* gla_ba;
    __device__ __forceinline__ void operator()(f32x4 (&acc)[2][2][4][2], const pg8::Unit& u, int wr, int wc, int fr, int fq) const {
        const int row0 = u.pm * 256 + wr * 64 + fr, cw = wc * 32 + 8 * fq, pn = u.pn;
        if (pn == 4 || pn == 5 || pn == 6 || pn == 7) {
            bf16* dst = (pn < 6) ? Q : K; const float sc = (pn < 6) ? C2 : 1.f;
#pragma unroll
            for (int ai = 0; ai < 2; ++ai) {
                f32x4 c0[4][2], c1[4][2];
#pragma unroll
                for (int m = 0; m < 4; ++m)
#pragma unroll
                    for (int bj = 0; bj < 2; ++bj) { const int row = row0 + ai * 128 + m * 16, lcq = (pn & 1) * 256 + 128 * bj + cw, i0 = (lcq & 63) >> 1;
                        c0[m][bj] = *(const f32x4*)(rope + (size_t)row * 32 + i0); c1[m][bj] = *(const f32x4*)(rope + (size_t)row * 32 + i0 + 2); }
                asm volatile("" ::: "memory");
#pragma unroll
                for (int m = 0; m < 4; ++m)
#pragma unroll
                    for (int bj = 0; bj < 2; ++bj) { const int row = row0 + ai * 128 + m * 16, lcq = (pn & 1) * 256 + 128 * bj + cw, hc = lcq >> 6, i0 = (lcq & 63) >> 1;
                        const f32x4 v0 = acc[ai][bj][m][0], v1 = acc[ai][bj][m][1], cs0 = c0[m][bj], cs1 = c1[m][bj];
                        float o1[4], o2[4];
                        o1[0] = (v0[0] * cs0[0] - v0[1] * cs0[1]) * sc; o2[0] = (v0[1] * cs0[0] + v0[0] * cs0[1]) * sc;
                        o1[1] = (v0[2] * cs0[2] - v0[3] * cs0[3]) * sc; o2[1] = (v0[3] * cs0[2] + v0[2] * cs0[3]) * sc;
                        o1[2] = (v1[0] * cs1[0] - v1[1] * cs1[1]) * sc; o2[2] = (v1[1] * cs1[0] + v1[0] * cs1[1]) * sc;
                        o1[3] = (v1[2] * cs1[2] - v1[3] * cs1[3]) * sc; o2[3] = (v1[3] * cs1[2] + v1[2] * cs1[3]) * sc;
                        v2u a, b; a.x = pg8::cvt_pk_bf16(o1[0], o1[1]); a.y = pg8::cvt_pk_bf16(o1[2], o1[3]); b.x = pg8::cvt_pk_bf16(o2[0], o2[1]); b.y = pg8::cvt_pk_bf16(o2[2], o2[3]);
                        bf16* p = dst + (size_t)row * 512 + hc * 64 + i0;
                        *(v2u*)p = a; *(v2u*)(p + 32) = b; }
                asm volatile("" ::: "memory");
            }
        } else if (pn == 16) {
            f32x4 bb0[2], bb1[2];
#pragma unroll
            for (int bj = 0; bj < 2; ++bj) { bb0[bj] = *(const f32x4*)(gla_ba + 128 * bj + cw); bb1[bj] = *(const f32x4*)(gla_ba + 128 * bj + cw + 4); }
            asm volatile("" ::: "memory");
            EPI_ROWLOOP(ai, m) { const int row = row0 + ai * 128 + m * 16;
#pragma unroll
                for (int bj = 0; bj < 2; ++bj) { const int lc = 128 * bj + cw;
                    f32x4 v0 = acc[ai][bj][m][0] + bb0[bj], v1 = acc[ai][bj][m][1] + bb1[bj];
#pragma unroll
                    for (int q = 0; q < 4; ++q) { v0[q] = logsig(v0[q]) * 0.0625f; v1[q] = logsig(v1[q]) * 0.0625f; }
                    float* p = GG + (size_t)row * 256 + lc; *(f32x4*)p = v0; *(f32x4*)(p + 4) = v1; } }
        } else {
            bf16* dst; int pitch, c0, op;
            if (pn < 2) { dst = LRUX; pitch = 512; c0 = pn * 256; op = 0; }
            else if (pn < 4) { dst = LRUG; pitch = 512; c0 = (pn - 2) * 256; op = 1; }
            else if (pn < 10) { dst = V; pitch = 512; c0 = (pn - 8) * 256; op = 0; }
            else if (pn == 10) { dst = GQ; pitch = 256; c0 = 0; op = 3; }
            else if (pn == 11) { dst = GK; pitch = 256; c0 = 0; op = 0; }
            else if (pn < 14) { dst = GV; pitch = 512; c0 = (pn - 12) * 256; op = 0; }
            else { dst = GR; pitch = 512; c0 = (pn - 14) * 256; op = 2; }
            EPI_ROWLOOP(ai, m) { const int row = row0 + ai * 128 + m * 16;
#pragma unroll
                for (int bj = 0; bj < 2; ++bj) { f32x4 v0 = acc[ai][bj][m][0], v1 = acc[ai][bj][m][1];
                    if (op == 1) { v0 = gelu_tanh4(v0); v1 = gelu_tanh4(v1); }
                    else if (op == 2) { v0 = silu4(v0); v1 = silu4(v1); }
                    else if (op == 3) { v0 = v0 * 0.125f; v1 = v1 * 0.125f; }
                    *(v4u*)(dst + (size_t)row * pitch + c0 + 128 * bj + cw) = pack8(v0, v1); } }
        }
    }
};
struct EpiGG {
    float* GG; const float* gla_ba; float sc;
    __device__ __forceinline__ void operator()(f32x4 (&acc)[2][2][4][2], const pg8::Unit& u, int wr, int wc, int fr, int fq) const {
        const int row0 = u.pm * 256 + wr * 64 + fr, cw = wc * 32 + 8 * fq;
        f32x4 bb0[2], bb1[2];
#pragma unroll
        for (int bj = 0; bj < 2; ++bj) { bb0[bj] = *(const f32x4*)(gla_ba + 128 * bj + cw); bb1[bj] = *(const f32x4*)(gla_ba + 128 * bj + cw + 4); }
        asm volatile("" ::: "memory");
        EPI_ROWLOOP(ai, m) { const int row = row0 + ai * 128 + m * 16;
#pragma unroll
            for (int bj = 0; bj < 2; ++bj) { const int lc = 128 * bj + cw;
                f32x4 v0 = acc[ai][bj][m][0] * sc + bb0[bj], v1 = acc[ai][bj][m][1] * sc + bb1[bj];
#pragma unroll
                for (int q = 0; q < 4; ++q) { v0[q] = logsig(v0[q]) * 0.0625f; v1[q] = logsig(v1[q]) * 0.0625f; }
                float* p = GG + (size_t)row * 256 + lc; *(f32x4*)p = v0; *(f32x4*)(p + 4) = v1; } }
    }
};
struct EpiNull { __device__ __forceinline__ void operator()(f32x4 (&acc)[2][2][4][2], const pg8::Unit& u, int wr, int wc, int fr, int fq) const {
    EPI_ROWLOOP(ai, m) { asm volatile("" :: "v"(acc[ai][0][m][0]), "v"(acc[ai][0][m][1]), "v"(acc[ai][1][m][0]), "v"(acc[ai][1][m][1])); } } };
struct EpiStoreOnly { bf16* G;
    __device__ __forceinline__ void operator()(f32x4 (&acc)[2][2][4][2], const pg8::Unit& u, int wr, int wc, int fr, int fq) const {
        const int row0 = u.pm * 256 + wr * 64 + fr, cw = wc * 32 + 8 * fq;
        EPI_ROWLOOP(ai, m) { const int row = row0 + ai * 128 + m * 16;
#pragma unroll
            for (int bj = 0; bj < 2; ++bj) *(v4u*)(G + (size_t)row * NG_COLS + u.pn * 256 + 128 * bj + cw) = pack8(acc[ai][bj][m][0], acc[ai][bj][m][1]); } } };
struct EpiMathOnly {
    __device__ __forceinline__ void operator()(f32x4 (&acc)[2][2][4][2], const pg8::Unit& u, int wr, int wc, int fr, int fq) const {
        EPI_ROWLOOP(ai, m) {
#pragma unroll
            for (int bj = 0; bj < 2; ++bj) { f32x4 v0 = acc[ai][bj][m][0], v1 = acc[ai][bj][m][1];
#pragma unroll
                for (int q = 0; q < 4; ++q) { v0[q] = fast_sigmoid(v0[q]); v1[q] = fast_sigmoid(v1[q]); }
                v4u w = pack8(v0, v1); asm volatile("" :: "v"(w)); } } } };
__device__ __forceinline__ size_t gate_off(int pm, int gt, int ai, int m, int bj, int wr, int wc, int fr, int fq) {
    const int ri = wr * 64 + fr + ai * 128 + m * 16, ci = 128 * bj + 32 * wc + 8 * fq;
    const int sub = (ri >> 7) * 8 + ((ri >> 4) & 3) * 2 + (ci >> 7), th = ((((ri >> 6) & 1) * 4 + ((ci >> 5) & 3)) * 64) + ((ci >> 3) & 3) * 16 + (ri & 15);
    return ((((size_t)(pm * 12 + gt) * 16 + (size_t)sub) * 512) + (size_t)th) * 8; }
struct EpiGates {
    bf16* G; float sc;
    __device__ __forceinline__ void operator()(f32x4 (&acc)[2][2][4][2], const pg8::Unit& u, int wr, int wc, int fr, int fq) const {
        EPI_ROWLOOP(ai, m) {
#pragma unroll
            for (int bj = 0; bj < 2; ++bj) { f32x4 v0 = acc[ai][bj][m][0], v1 = acc[ai][bj][m][1];
                v0 = sigmoid4(v0, sc) * 255.f; v1 = sigmoid4(v1, sc) * 255.f;
                unsigned w0 = 0u, w1 = 0u;
#pragma unroll
                for (int q = 0; q < 4; ++q) { w0 = __builtin_amdgcn_cvt_pk_u8_f32(fmaxf(v0[q], 1.f), q, w0); w1 = __builtin_amdgcn_cvt_pk_u8_f32(fmaxf(v1[q], 1.f), q, w1); }
                *(v2u*)((unsigned char*)G + gate_off(u.pm, u.pn, ai, m, bj, wr, wc, fr, fq)) = (v2u){w0, w1}; } }
    }
};
struct EpiUp {
    const bf16* G; bf16* M;
    __device__ __forceinline__ void operator()(f32x4 (&acc)[2][2][4][2], const pg8::Unit& u, int wr, int wc, int fr, int fq) const {
        const int row0 = u.pm * 256 + wr * 64 + fr, cw = wc * 32 + 8 * fq, n = u.x;
        const unsigned char* G8 = (const unsigned char*)G;
        v2u g[2][4][2], h[2][4][2];
#pragma unroll
        for (int ai = 0; ai < 2; ++ai)
#pragma unroll
            for (int m = 0; m < 4; ++m)
#pragma unroll
                for (int bj = 0; bj < 2; ++bj) {
                    g[ai][m][bj] = *(const v2u*)(G8 + gate_off(u.pm, n * 4 + u.pn, ai, m, bj, wr, wc, fr, fq));
                    h[ai][m][bj] = g[ai][m][bj]; if (n < 2) h[ai][m][bj] = *(const v2u*)(G8 + gate_off(u.pm, (n + 1) * 4 + u.pn, ai, m, bj, wr, wc, fr, fq)); }
        asm volatile("" ::: "memory");
#pragma unroll
        for (int ai = 0; ai < 2; ++ai) {
#pragma unroll
            for (int m = 0; m < 4; ++m)
#pragma unroll
                for (int bj = 0; bj < 2; ++bj) { const int row = row0 + ai * 128 + m * 16, col = u.pn * 256 + 128 * bj + cw;
                    const v2u gg = g[ai][m][bj], hh = h[ai][m][bj];
                    float f[8];
#pragma unroll
                    for (int q = 0; q < 4; ++q) { const float g0 = (float)((gg.x >> (8 * q)) & 0xffu), g1 = (float)((gg.y >> (8 * q)) & 0xffu);
                        if (n < 2) { f[q] = g0 * __builtin_amdgcn_rcpf((float)((hh.x >> (8 * q)) & 0xffu)); f[4 + q] = g1 * __builtin_amdgcn_rcpf((float)((hh.y >> (8 * q)) & 0xffu)); }
                        else { f[q] = g0 * (1.f / 255.f); f[4 + q] = g1 * (1.f / 255.f); } }
                    f32x4 v0 = acc[ai][bj][m][0], v1 = acc[ai][bj][m][1];
                    v0[0] *= f[0]; v0[1] *= f[1]; v0[2] *= f[2]; v0[3] *= f[3]; v1[0] *= f[4]; v1[1] *= f[5]; v1[2] *= f[6]; v1[3] *= f[7];
                    if (n < 2) { acc[ai][bj][m][0] = v0; acc[ai][bj][m][1] = v1; asm volatile("" : "+v"(acc[ai][bj][m][0]), "+v"(acc[ai][bj][m][1])); }
                    else *(v4u*)(M + (size_t)row * DM + col) = pack8(v0, v1); }
        }
        asm volatile("" ::: "memory");
    }
};
struct EpiBf {
    bf16* O;
    __device__ __forceinline__ void operator()(f32x4 (&acc)[2][2][4][2], const pg8::Unit& u, int wr, int wc, int fr, int fq) const {
        const int row0 = u.pm * 256 + wr * 64 + fr, cw = wc * 32 + 8 * fq;
        EPI_ROWLOOP(ai, m) { const int row = row0 + ai * 128 + m * 16;
#pragma unroll
            for (int bj = 0; bj < 2; ++bj) *(v4u*)(O + (size_t)row * DM + u.pn * 256 + 128 * bj + cw) = pack8(acc[ai][bj][m][0], acc[ai][bj][m][1]); }
    }
};
__device__ __forceinline__ unsigned pk4_fp8(float a, float b, float c, float d) {
    a = fminf(fmaxf(a, -448.f), 448.f); b = fminf(fmaxf(b, -448.f), 448.f); c = fminf(fmaxf(c, -448.f), 448.f); d = fminf(fmaxf(d, -448.f), 448.f);
    int p = __builtin_amdgcn_cvt_pk_fp8_f32(a, b, 0, false); p = __builtin_amdgcn_cvt_pk_fp8_f32(c, d, p, true); return (unsigned)p; }
constexpr float F8_SA = 16.f, F8_SW13 = 256.f, F8_SH = 16.f, F8_SW2 = 512.f;
struct EpiH {
    bf16* H; int fp8; int fp8in;
    __device__ __forceinline__ void operator()(f32x4 (&acc)[2][2][4][2], const pg8::Unit& u, int wr, int wc, int fr, int fq) const {
        const int row0 = u.pm * 256 + wr * 64 + fr, cw = wc * 32 + 8 * fq;
        const float si = fp8in ? 1.f / (F8_SA * F8_SW13) : 1.f;
        const float c1 = -1.4426950408889634f * si, K = si * si * (fp8 ? F8_SH : 1.f);
        EPI_ROWLOOP(ai, m) { const int row = row0 + ai * 128 + m * 16;
            f32x4 o[2];
#pragma unroll
            for (int j = 0; j < 2; ++j) { const f32x4 a = acc[ai][0][m][j], b = acc[ai][1][m][j];
                f32x4 t = a * c1;
#pragma unroll
                for (int q = 0; q < 4; ++q) t[q] = __builtin_amdgcn_exp2f(t[q]);
                t = t + 1.f;
#pragma unroll
                for (int q = 0; q < 4; ++q) t[q] = __builtin_amdgcn_rcpf(t[q]);
                o[j] = (a * b) * (t * K); }
            if (fp8) { v2u w;
#pragma unroll
                for (int j = 0; j < 2; ++j) { f32x4 c;
#pragma unroll
                    for (int q = 0; q < 4; ++q) c[q] = __builtin_amdgcn_fmed3f(o[j][q], -448.f, 448.f);
                    int pk = __builtin_amdgcn_cvt_pk_fp8_f32(c[0], c[1], 0, false); pk = __builtin_amdgcn_cvt_pk_fp8_f32(c[2], c[3], pk, true); if (j == 0) w.x = (unsigned)pk; else w.y = (unsigned)pk; }
                *(v2u*)((unsigned char*)H + (size_t)row * DFF + u.pn * 128 + cw) = w; }
            else *(v4u*)(H + (size_t)row * DFF + u.pn * 128 + cw) = pack8(o[0], o[1]); }
    }
};
struct EpiW2 {
    const int* slot_tok; const float* slot_w; bf16* Y1; bf16* Y2; int dense; float oscale;
    __device__ __forceinline__ void operator()(f32x4 (&acc)[2][2][4][2], const pg8::Unit& u, int wr, int wc, int fr, int fq) const {
        const int s0 = u.x + wr * 64 + fr, cw = wc * 32 + 8 * fq;
        int st[2][4]; float wv[2][4];
#pragma unroll
        for (int ai = 0; ai < 2; ++ai)
#pragma unroll
            for (int m = 0; m < 4; ++m) { st[ai][m] = slot_tok[s0 + ai * 128 + m * 16]; wv[ai][m] = slot_w[s0 + ai * 128 + m * 16] * oscale; }
        asm volatile("" ::: "memory");
#pragma unroll
        for (int ai = 0; ai < 2; ++ai)
#pragma unroll
            for (int m = 0; m < 4; ++m) { const int s = st[ai][m];
                if (s >= 0) { const int tok = s & 0xffff; bf16* Y = (dense || (s >> 20)) ? Y2 : Y1; const float w = wv[ai][m];
#pragma unroll
                    for (int bj = 0; bj < 2; ++bj) { const size_t o = (size_t)tok * DM + u.pn * 256 + 128 * bj + cw;
                        *(v4u*)(Y + o) = pack8(acc[ai][bj][m][0] * w, acc[ai][bj][m][1] * w); } } }
        asm volatile("" ::: "memory");
    }
};

struct SchedPlain {
    const char* A; const char* Bt; int nM, nN, KB, G, c;
    __device__ __forceinline__ bool next(int i, pg8::Unit& u) const {
        const long L = (long)i * G + c; if (L >= (long)nM * nN) return false;
        int pm, pn; pg8::tile_of((int)L, nM, nN, pm, pn); u.pm = pm; u.pn = pn; u.x = 0; u.gs = 0; u.keep = 0;
        u.a = A + (size_t)pm * 256 * KB; u.b = Bt + (size_t)pn * 256 * KB; return true; }
    __device__ __forceinline__ void a_ready(const pg8::Unit&) const {}
    __device__ __forceinline__ void done(const pg8::Unit&) const {}
    __device__ __forceinline__ int row(int) const { return 0; }
};
struct SchedUp {
    const char* Y; const char* W; int G, c;
    __device__ __forceinline__ bool next(int i, pg8::Unit& u) const {
        const int j = i / 3, n = i - 3 * j; const long L = (long)j * G + c; if (L >= 128 * 4) return false;
        int pm, pn; pg8::tile_of((int)L, 128, 4, pm, pn); u.pm = pm; u.pn = pn; u.x = n; u.gs = 0; u.keep = (n < 2) ? 1 : 0;
        u.a = Y + (size_t)n * (32 * MiB) + (size_t)pm * 256 * BW * 2; u.b = W + (size_t)n * (DM * BW * 2) + (size_t)pn * 256 * BW * 2; return true; }
    __device__ __forceinline__ void a_ready(const pg8::Unit&) const {}
    __device__ __forceinline__ void done(const pg8::Unit&) const {}
    __device__ __forceinline__ int row(int) const { return 0; }
};
struct SchedPitchA {
    const char* A; const char* Bt; int nM, nN, KB, PA, G, c;
    __device__ __forceinline__ bool next(int i, pg8::Unit& u) const {
        const long L = (long)i * G + c; if (L >= (long)nM * nN) return false;
        int pm, pn; pg8::tile_of((int)L, nM, nN, pm, pn); u.pm = pm; u.pn = pn; u.x = 0; u.gs = 0; u.keep = 0;
        u.a = A + (size_t)pm * 256 * PA; u.b = Bt + (size_t)pn * 256 * KB; return true; }
    __device__ __forceinline__ void a_ready(const pg8::Unit&) const {}
    __device__ __forceinline__ void done(const pg8::Unit&) const {}
    __device__ __forceinline__ int row(int) const { return 0; }
};
struct SchedMoE {
    const char* A; const char* W; const int* slot_tok; volatile LAS unsigned* ts; int t0, nM, nN, KB, G, c, w2; size_t WEB, W2O;
    __device__ __forceinline__ bool next(int i, pg8::Unit& u) const {
        const long L = (long)i * G + c; if (L >= (long)nM * nN) return false;
        int pm, pn; pg8::tile_of((int)L, nM, nN, pm, pn); const int tile = t0 + pm;
        int e = 0;
#pragma unroll
        for (int j = 1; j < 8; ++j) e += (tile >= (int)ts[j]) ? 1 : 0;
        u.pm = pm; u.pn = pn; u.x = tile * 256; u.gs = tile * 256; u.keep = 0;
        if (w2) { u.a = A + (size_t)pm * 256 * KB; u.b = W + (size_t)e * WEB + W2O + (size_t)pn * 256 * KB; }
        else { u.a = A; u.b = W + (size_t)e * WEB + (size_t)pn * 256 * KB; }
        return true; }
    __device__ __forceinline__ void a_ready(const pg8::Unit&) const {}
    __device__ __forceinline__ void done(const pg8::Unit&) const {}
    __device__ __forceinline__ int row(int slot) const { const int st = slot_tok[slot]; return st < 0 ? 0 : (st & 0xffff); }
};

#ifndef FOLD_FP8
#define FOLD_FP8 1
#endif
#ifndef XN8_SLOT
#define XN8_SLOT 1
#endif
#ifndef MOE_CHECK
#define MOE_CHECK 0
#endif
#ifndef GATES_FP8
#define GATES_FP8 1
#endif
#ifndef DENSE_FP8
#define DENSE_FP8 0
#endif
#ifndef MOE_FP8
#define MOE_FP8 1
#endif
#define LBAR() asm volatile("s_waitcnt lgkmcnt(0)\n\ts_barrier" ::: "memory")
__device__ __forceinline__ int crow16(int r, int hi) { return (r & 3) + 8 * (r >> 2) + 4 * hi; }
__device__ __forceinline__ void mma32(f32x16& acc, const LAS bf16* A, int lda, const LAS bf16* Bt, int ldb, int K, int lane) {
    const int r = lane & 31, h = lane >> 5;
    for (int k0 = 0; k0 < K; k0 += 16) {
        const bf16x8 a = *(const LAS bf16x8*)(A + r * lda + k0 + 8 * h);
        const bf16x8 b = *(const LAS bf16x8*)(Bt + r * ldb + k0 + 8 * h);
        acc = __builtin_amdgcn_mfma_f32_32x32x16_bf16(a, b, acc, 0, 0, 0);
    }
}

__device__ __forceinline__ int maprow(int kind, int c, int off) {
    if (kind == 1) { if (c >= 1024 && c < 2048) { const int rel = c - 1024, blk = rel >> 6, w = rel & 63; return 1024 + blk * 64 + 2 * (w & 31) + (w >> 5); } return c; }
    if (kind == 2) return 256 * (c >> 7) + (c & 127);
    if (kind == 3) return 256 * (c >> 7) + 128 + (c & 127);
    return c + off;
}
__device__ __forceinline__ void cvt_item(const float* W, int K, int Nsrc, int c0, int nblk, bf16* WT, int kind, int off, LAS float* scr, int item, int lane) {
    const int kb = item / nblk, nb = item - kb * nblk, k0 = 64 * kb, n0 = c0 + 32 * nb;
    { f32x4 t[8];
#pragma unroll
        for (int i = 0; i < 8; ++i) t[i] = *(const GAS f32x4*)(W + (size_t)(k0 + 8 * i + (lane >> 3)) * Nsrc + n0 + 4 * (lane & 7));
#pragma unroll
        for (int i = 0; i < 8; ++i) { LAS float* d = scr + (8 * i + (lane >> 3)) * 33 + 4 * (lane & 7); d[0] = t[i][0]; d[1] = t[i][1]; d[2] = t[i][2]; d[3] = t[i][3]; } }
    LDS_WAIT(); asm volatile("" ::: "memory");
    const int c = lane & 7;
#pragma unroll
    for (int j = 0; j < 4; ++j) { const int n = (lane >> 3) + 8 * j; const LAS float* s = scr + (8 * c) * 33 + n;
        v4u o; o.x = pk2(s[0 * 33], s[1 * 33]); o.y = pk2(s[2 * 33], s[3 * 33]); o.z = pk2(s[4 * 33], s[5 * 33]); o.w = pk2(s[6 * 33], s[7 * 33]);
        *(GAS v4u*)(WT + (size_t)maprow(kind, n0 + n, off) * K + k0 + 8 * c) = o; }
    LDS_WAIT(); asm volatile("" ::: "memory");
}
__device__ __forceinline__ void cvt_item_fp8(const float* W, int K, int Nsrc, int c0, int nblk, unsigned char* WT, int kind, int off, float scale, LAS float* scr, int item, int lane) {
    const int kb = item / nblk, nb = item - kb * nblk, k0 = 64 * kb, n0 = c0 + 32 * nb;
    { f32x4 t[8];
#pragma unroll
        for (int i = 0; i < 8; ++i) t[i] = *(const GAS f32x4*)(W + (size_t)(k0 + 8 * i + (lane >> 3)) * Nsrc + n0 + 4 * (lane & 7));
#pragma unroll
        for (int i = 0; i < 8; ++i) { LAS float* d = scr + (8 * i + (lane >> 3)) * 33 + 4 * (lane & 7); d[0] = t[i][0] * scale; d[1] = t[i][1] * scale; d[2] = t[i][2] * scale; d[3] = t[i][3] * scale; } }
    LDS_WAIT(); asm volatile("" ::: "memory");
    const int c = lane & 7;
#pragma unroll
    for (int j = 0; j < 4; ++j) { const int n = (lane >> 3) + 8 * j; const LAS float* s = scr + (8 * c) * 33 + n;
        v2u o; o.x = pk4_fp8(s[0 * 33], s[1 * 33], s[2 * 33], s[3 * 33]); o.y = pk4_fp8(s[4 * 33], s[5 * 33], s[6 * 33], s[7 * 33]);
        *(GAS v2u*)(WT + (size_t)maprow(kind, n0 + n, off) * K + k0 + 8 * c) = o; }
    LDS_WAIT(); asm volatile("" ::: "memory");
}
__device__ __forceinline__ void fold_item(const float* W, const float* wa2, bf16* WT, LAS float* scr, int item, int lane) {
    const int kb = item >> 3, jb = item & 7, k0 = 64 * kb, j0 = 32 * jb, jj = lane & 31;
    float w2[16];
#pragma unroll
    for (int r = 0; r < 16; ++r) w2[r] = wa2[r * 256 + j0 + jj];
    for (int i = 0; i < 32; ++i) { const int kk = 2 * i + (lane >> 5); const float* wr = W + (size_t)(k0 + kk) * W_IN_COLS + 4096; float s = 0.f;
#pragma unroll
        for (int r = 0; r < 16; ++r) s += wr[r] * w2[r];
        scr[kk * 33 + jj] = s; }
    LDS_WAIT(); asm volatile("" ::: "memory");
    const int c = lane & 7;
#pragma unroll
    for (int j = 0; j < 4; ++j) { const int n = (lane >> 3) + 8 * j; const LAS float* s = scr + (8 * c) * 33 + n;
        if (FOLD_FP8 && GATES_FP8 && XN8_SLOT) { v2u o; o.x = pk4_fp8(s[0 * 33] * F8_SW13, s[1 * 33] * F8_SW13, s[2 * 33] * F8_SW13, s[3 * 33] * F8_SW13); o.y = pk4_fp8(s[4 * 33] * F8_SW13, s[5 * 33] * F8_SW13, s[6 * 33] * F8_SW13, s[7 * 33] * F8_SW13);
            *(GAS v2u*)((unsigned char*)(WT + (size_t)4096 * DM) + (size_t)(j0 + n) * DM + k0 + 8 * c) = o; }
        else { v4u o; o.x = pk2(s[0 * 33], s[1 * 33]); o.y = pk2(s[2 * 33], s[3 * 33]); o.z = pk2(s[4 * 33], s[5 * 33]); o.w = pk2(s[6 * 33], s[7 * 33]);
        *(GAS v4u*)(WT + (size_t)(4096 + j0 + n) * DM + k0 + 8 * c) = o; } }
    LDS_WAIT(); asm volatile("" ::: "memory");
}
__device__ __forceinline__ void rms_row(const float* xrow, const bf16* addrow, float* hout, const f32x4 (&g)[4], f32x4 (&v)[4], int lane) {
    const GAS f32x4* xr = (const GAS f32x4*)xrow + lane; float s = 0.f;
#pragma unroll
    for (int j = 0; j < 4; ++j) { v[j] = xr[64 * j];
        if (addrow) { const v2u a = *((const GAS v2u*)addrow + lane + 64 * j); v[j][0] += bflo(a.x); v[j][1] += bfhi(a.x); v[j][2] += bflo(a.y); v[j][3] += bfhi(a.y); }
        if (hout) ((GAS f32x4*)hout + lane)[64 * j] = v[j];
        s += (v[j][0] * v[j][0] + v[j][1] * v[j][1]) + (v[j][2] * v[j][2] + v[j][3] * v[j][3]); }
    const float rstd = __builtin_amdgcn_rsqf(wave_sum(s) * (1.f / DM) + EPS);
#pragma unroll
    for (int j = 0; j < 4; ++j) v[j] = v[j] * rstd * g[j];
}
__device__ __forceinline__ void store_row_bf16(bf16* orow, const f32x4 (&v)[4], int lane) {
    GAS v2u* o8 = (GAS v2u*)orow + lane;
#pragma unroll
    for (int j = 0; j < 4; ++j) { v2u w; w.x = pk2(v[j][0], v[j][1]); w.y = pk2(v[j][2], v[j][3]); o8[64 * j] = w; }
}

struct RowLd { f32x4 x[4]; v2u xb[4]; v2u a[4]; };
__device__ __forceinline__ void row_load(RowLd& r, const float* xrow, const bf16* addrow, int lane, bool xs) {
    if (xs) {
#pragma unroll
        for (int j = 0; j < 4; ++j) r.xb[j] = *((const GAS v2u*)xrow + lane + 64 * j);
    } else { const GAS f32x4* xr = (const GAS f32x4*)xrow + lane;
#pragma unroll
        for (int j = 0; j < 4; ++j) r.x[j] = xr[64 * j]; }
    if (addrow) {
#pragma unroll
        for (int j = 0; j < 4; ++j) r.a[j] = *((const GAS v2u*)addrow + lane + 64 * j); }
    asm volatile("" ::: "memory");
}
__device__ __forceinline__ void row_finish(const RowLd& r, bool hasadd, float* hout, const f32x4 (&g)[4], f32x4 (&v)[4], int lane, bool xs) {
    float s = 0.f;
#pragma unroll
    for (int j = 0; j < 4; ++j) {
        if (xs) { v[j][0] = bflo(r.xb[j].x); v[j][1] = bfhi(r.xb[j].x); v[j][2] = bflo(r.xb[j].y); v[j][3] = bfhi(r.xb[j].y); } else v[j] = r.x[j];
        if (hasadd) { const v2u a = r.a[j]; v[j][0] += bflo(a.x); v[j][1] += bfhi(a.x); v[j][2] += bflo(a.y); v[j][3] += bfhi(a.y); }
        if (hout) { v2u w; w.x = pk2(v[j][0], v[j][1]); w.y = pk2(v[j][2], v[j][3]); ((GAS v2u*)hout + lane)[64 * j] = w; }
        s += (v[j][0] * v[j][0] + v[j][1] * v[j][1]) + (v[j][2] * v[j][2] + v[j][3] * v[j][3]); }
    const float rstd = __builtin_amdgcn_rsqf(wave_sum(s) * (1.f / DM) + EPS);
#pragma unroll
    for (int j = 0; j < 4; ++j) v[j] = v[j] * rstd * g[j];
}

__device__ __forceinline__ void phase_prep(const Frame& F0, int layer) {
    Frame F = F0; relaunder(F);
    LAS float* scr = (LAS float*)(F.lds + F.wave * 16384);
    const int gw = F.vcu * NWAVES + F.wave, NGW = F.G * NWAVES;
    const float* win = IN_w_in + (size_t)layer * DM * W_IN_COLS;
    bf16* WIN = WSP(bf16, WS_WIN); bf16* WBR = WSP(bf16, WS_WBR); bf16* WOUT = WSP(bf16, WS_WOUT);
    constexpr int I0 = 16 * 128, I1 = 16 * 96, I2 = 8 * 32, I5 = 16 * 32, IF = 128;
    constexpr int NITEMS = I0 + I1 + 3 * I2 + I5 + IF;
    for (int it = gw; it < NITEMS; it += NGW) {
        int r = it;
        if (r < I0) { cvt_item(win, DM, W_IN_COLS, 0, 128, WIN, 1, 0, scr, r, F.lane); continue; } r -= I0;
        if (r < I1) { if (GATES_FP8) cvt_item_fp8(win, DM, W_IN_COLS, 4112, 96, (unsigned char*)(WIN + (size_t)NA_COLS * DM), 0, -4112, F8_SW13, scr, r, F.lane);
                      else cvt_item(win, DM, W_IN_COLS, 4112, 96, WIN, 0, NA_COLS - 4112, scr, r, F.lane); continue; } r -= I1;
        if (r < 3 * I2) { const int n = r / I2; cvt_item(IN_w_branch + ((size_t)layer * 3 + n) * BW * DM, BW, DM, 0, 32, WBR + (size_t)n * DM * BW, 0, 0, scr, r - n * I2, F.lane); continue; } r -= 3 * I2;
        if (r < I5) { cvt_item(IN_w_out + (size_t)layer * DM * DM, DM, DM, 0, 32, WOUT, 0, 0, scr, r, F.lane); continue; } r -= I5;
        fold_item(win, IN_gla_wa2 + (size_t)layer * 16 * 256, WIN, scr, r, F.lane);
    }
    const float* src = layer == 0 ? IN_x : F.out;
    f32x4 g[4];
#pragma unroll
    for (int j = 0; j < 4; ++j) g[j] = *((const f32x4*)(IN_mix_norm + (size_t)layer * DM) + F.lane + 64 * j);
    bf16* XN = WSP(bf16, WS_XN);
    const bf16* FO = WSP(bf16, WS_Y2);
    { RowLd cur; if (gw < NTOK) row_load(cur, src + (size_t)gw * DM, layer == 0 ? nullptr : FO + (size_t)gw * DM, F.lane, layer != 0);
      for (int m = gw; m < NTOK; m += NGW) { RowLd nxt; const int mn = m + NGW;
        if (mn < NTOK) row_load(nxt, src + (size_t)mn * DM, layer == 0 ? nullptr : FO + (size_t)mn * DM, F.lane, layer != 0);
        f32x4 v[4]; row_finish(cur, layer != 0, layer == 0 ? nullptr : F.out + (size_t)m * DM, g, v, F.lane, layer != 0); store_row_bf16(XN + (size_t)m * DM, v, F.lane);
        if (GATES_FP8 && XN8_SLOT) { GAS unsigned* o4 = (GAS unsigned*)((unsigned char*)F.out + (size_t)m * (DM * 4) + 2048) + F.lane;
#pragma unroll
            for (int j = 0; j < 4; ++j) o4[64 * j] = pk4_fp8(v[j][0] * F8_SA, v[j][1] * F8_SA, v[j][2] * F8_SA, v[j][3] * F8_SA); }
        cur = nxt; } }
    if (layer == 0) {
        f32x2* rope = WSP(f32x2, WS_ROPE);
        const int i = F.lane & 31;
        const float inv = exp2f(-(float)i * (13.287712379549449f / 32.0f));
        for (int m = gw * 2 + (F.lane >> 5); m < NTOK; m += NGW * 2) {
            const float ang = (float)IN_positions[m] * inv;
            const double rev = (double)ang * 0.15915494309189535; const float fr = (float)(rev - floor(rev));
            f32x2 cs; cs.x = __builtin_amdgcn_cosf(fr); cs.y = __builtin_amdgcn_sinf(fr);
            rope[(size_t)m * 32 + i] = cs; }
    }
}

__device__ __forceinline__ void lru_pass1(const Frame& F0, int layer, int unit) {
    Frame F = F0; relaunder(F);
    const int c = unit & 31, b = unit >> 5, tid = F.tid, lane = F.lane, wave = F.wave;
    LAS bf16* XS = (LAS bf16*)(F.lds);
    LAS bf16* UB = (LAS bf16*)(F.lds + 16896);
    LAS bf16* WAT = (LAS bf16*)(F.lds + 35328);
    LAS bf16* WXT = (LAS bf16*)(F.lds + 44544);
    LAS float* AF = (LAS float*)(F.lds + 53760);
    LAS bf16* BFh = (LAS bf16*)(F.lds + 86528);
    LAS float* WS = (LAS float*)(F.lds + 102912);
    LAS float* CW = (LAS float*)(F.lds + 107008);
    LAS float* GB = (LAS float*)(F.lds + 117248);
    const bf16* LRUX = WSP(bf16, WS_LRUX); const bf16* LG = WSP(bf16, WS_LRUG); bf16* PG = WSP(bf16, WS_PG); bf16* Y = WSP(bf16, WS_YLRU);
    const int s0 = c * 128;
    { const float* cwp = IN_conv_w + (size_t)layer * 4 * BW;
#pragma unroll
        for (int j = 0; j < 4; ++j) CW[j * 512 + tid] = cwp[j * BW + tid];
        CW[4 * 512 + tid] = IN_conv_b[(size_t)layer * BW + tid];
        GB[tid] = IN_lru_ba[(size_t)layer * BW + tid]; GB[512 + tid] = IN_lru_bx[(size_t)layer * BW + tid];
        const float lam = IN_lru_lambda[(size_t)layer * BW + tid]; GB[1024 + tid] = fmaxf(-lam, 0.f) + log1p_fast(__expf(-fabsf(lam))); }
    v4u xr[3]; float wa[8], wx[8];
    const int wj = tid & 63, wi0 = (tid >> 6) * 8;
#define LRU_PREFETCH(g) do { \
        _Pragma("unroll") for (int p = 0; p < 3; ++p) { const int rr = (tid >> 3) + 64 * p, sp = s0 - 3 + rr; xr[p] = (v4u){0u, 0u, 0u, 0u}; \
            if (rr < 131 && sp >= 0) xr[p] = *(const v4u*)(LRUX + ((size_t)(b * SEQ + sp)) * 512 + (g) * 64 + (tid & 7) * 8); } \
        const float* wa_ = IN_lru_wa + (((size_t)layer * 8 + (g)) * 64 + wi0) * 64 + wj; const float* wx_ = IN_lru_wx + (((size_t)layer * 8 + (g)) * 64 + wi0) * 64 + wj; \
        _Pragma("unroll") for (int q = 0; q < 8; ++q) { wa[q] = wa_[q * 64]; wx[q] = wx_[q * 64]; } } while (0)
    LRU_PREFETCH(0);
#pragma unroll 1
    for (int g = 0; g < 8; ++g) {
#pragma unroll
        for (int p = 0; p < 3; ++p) { const int rr = (tid >> 3) + 64 * p; if (rr < 131) *(LAS v4u*)(XS + rr * 64 + (tid & 7) * 8) = xr[p]; }
        { v4u o; o.x = pk2(wa[0], wa[1]); o.y = pk2(wa[2], wa[3]); o.z = pk2(wa[4], wa[5]); o.w = pk2(wa[6], wa[7]); *(LAS v4u*)(WAT + wj * 72 + wi0) = o;
          o.x = pk2(wx[0], wx[1]); o.y = pk2(wx[2], wx[3]); o.z = pk2(wx[4], wx[5]); o.w = pk2(wx[6], wx[7]); *(LAS v4u*)(WXT + wj * 72 + wi0) = o; }
        const size_t obase = ((size_t)(b * SEQ + s0 + 16 * wave)) * 512 + g * 64 + lane;
        bf16 gt[16];
#pragma unroll
        for (int j = 0; j < 16; ++j) gt[j] = LG[obase + (size_t)j * 512];
        LBAR();
        if (g + 1 < 8) LRU_PREFETCH(g + 1);
        { const int tok = tid >> 2, ch0 = (tid & 3) * 16; const LAS float* cwl = CW + g * 64 + ch0;
            float u[16];
#pragma unroll
            for (int q = 0; q < 16; ++q) u[q] = cwl[4 * 512 + q];
#pragma unroll
            for (int j = 0; j < 4; ++j) { const v4u x0 = *(const LAS v4u*)(XS + (tok + j) * 64 + ch0), x1 = *(const LAS v4u*)(XS + (tok + j) * 64 + ch0 + 8); const LAS float* w = cwl + j * 512;
                u[0] += w[0] * bflo(x0.x); u[1] += w[1] * bfhi(x0.x); u[2] += w[2] * bflo(x0.y); u[3] += w[3] * bfhi(x0.y); u[4] += w[4] * bflo(x0.z); u[5] += w[5] * bfhi(x0.z); u[6] += w[6] * bflo(x0.w); u[7] += w[7] * bfhi(x0.w);
                u[8] += w[8] * bflo(x1.x); u[9] += w[9] * bfhi(x1.x); u[10] += w[10] * bflo(x1.y); u[11] += w[11] * bfhi(x1.y); u[12] += w[12] * bflo(x1.z); u[13] += w[13] * bfhi(x1.z); u[14] += w[14] * bflo(x1.w); u[15] += w[15] * bfhi(x1.w); }
            v4u o0, o1; o0.x = pk2(u[0], u[1]); o0.y = pk2(u[2], u[3]); o0.z = pk2(u[4], u[5]); o0.w = pk2(u[6], u[7]); o1.x = pk2(u[8], u[9]); o1.y = pk2(u[10], u[11]); o1.z = pk2(u[12], u[13]); o1.w = pk2(u[14], u[15]);
            *(LAS v4u*)(UB + tok * 72 + ch0) = o0; *(LAS v4u*)(UB + tok * 72 + ch0 + 8) = o1; }
        LBAR();
        { const int tt = wave >> 1, tc = wave & 1, hi = lane >> 5, ch = 32 * tc + (lane & 31), gch = g * 64 + ch;
            f32x16 racc = {}, iacc = {};
            mma32(racc, UB + tt * 32 * 72, 72, WAT + tc * 32 * 72, 72, 64, lane);
            mma32(iacc, UB + tt * 32 * 72, 72, WXT + tc * 32 * 72, 72, 64, lane);
            const float ba = GB[gch], bx = GB[512 + gch], sp = GB[1024 + gch];
#pragma unroll
            for (int r = 0; r < 16; ++r) { const int tok = 32 * tt + crow16(r, hi);
                const float uval = bf2f(UB[tok * 72 + ch]);
                const float rg = fast_sigmoid(racc[r] + ba), ig = fast_sigmoid(iacc[r] + bx);
                const float la = -8.f * rg * sp, a = __expf(la), mult = __builtin_amdgcn_sqrtf(fmaxf(1.f - a * a, 0.f));
                AF[tok * 64 + ch] = a; BFh[tok * 64 + ch] = (bf16)f2bf(mult * (ig * uval)); } }
        LBAR();
        float hl[16], pl[16]; float h = 0.f, P = 1.f;
#pragma unroll
        for (int j = 0; j < 16; ++j) { const float a = AF[(16 * wave + j) * 64 + lane], bb = bf2f(BFh[(16 * wave + j) * 64 + lane]); h = a * h + bb; P *= a; hl[j] = h; pl[j] = P; }
        WS[(wave * 64 + lane) * 2] = P; WS[(wave * 64 + lane) * 2 + 1] = h;
        LBAR();
        { float cin = 0.f, pin = 1.f, At = 1.f, Ht = 0.f;
#pragma unroll
            for (int w = 0; w < 8; ++w) { const float p = WS[(w * 64 + lane) * 2], q = WS[(w * 64 + lane) * 2 + 1]; if (w < wave) { cin = p * cin + q; pin *= p; } Ht = p * Ht + q; At *= p; }
            if (wave == 7) { f32x2 sm; sm.x = At; sm.y = Ht; WSP(f32x2, WS_LRUS)[((size_t)(b * 32 + c)) * 512 + g * 64 + lane] = sm; }
            LAS bf16* YT = (LAS bf16*)(F.lds + 53760); LAS bf16* PT = (LAS bf16*)(F.lds + 53760 + 16384);
#pragma unroll
            for (int j = 0; j < 16; ++j) { const float gv = bf2f(gt[j]); YT[(16 * wave + j) * 64 + lane] = (bf16)f2bf((hl[j] + pl[j] * cin) * gv); PT[(16 * wave + j) * 64 + lane] = (bf16)f2bf(pl[j] * pin * gv); }
            LBAR();
            { const int tok = tid >> 2, sg = (tid & 3) * 16; const size_t o = ((size_t)(b * SEQ + s0 + tok)) * 512 + g * 64 + sg;
                const v4u y0 = *(const LAS v4u*)(YT + tok * 64 + sg), y1 = *(const LAS v4u*)(YT + tok * 64 + sg + 8), p0 = *(const LAS v4u*)(PT + tok * 64 + sg), p1 = *(const LAS v4u*)(PT + tok * 64 + sg + 8);
                *(v4u*)(Y + o) = y0; *(v4u*)(Y + o + 8) = y1; *(v4u*)(PG + o) = p0; *(v4u*)(PG + o + 8) = p1; } }
    }
#undef LRU_PREFETCH
    LBAR();
}
__device__ __forceinline__ void lru_fix_unit(const Frame& F0, int unit) {
    Frame F = F0; relaunder(F);
    const int c = 1 + unit % 31, b = unit / 31, tid = F.tid;
    LAS float* CR = (LAS float*)(F.lds);
    const f32x2* SUM = WSP(f32x2, WS_LRUS);
    { f32x2 sm[32]; float Hin = 0.f;
#pragma unroll
        for (int cc = 0; cc < 32; ++cc) sm[cc] = (cc < c) ? SUM[((size_t)(b * 32 + cc)) * 512 + tid] : (f32x2){1.f, 0.f};
#pragma unroll
        for (int cc = 0; cc < 32; ++cc) Hin = sm[cc].x * Hin + sm[cc].y;
        CR[tid] = Hin; }
    __syncthreads();
    const int seg = tid & 63, r0 = tid >> 6;
    float cr[8];
#pragma unroll
    for (int q = 0; q < 8; ++q) cr[q] = CR[seg * 8 + q];
    const bf16* LG = WSP(bf16, WS_PG); bf16* Y = WSP(bf16, WS_YLRU);
#pragma unroll
    for (int half = 0; half < 2; ++half) {
        v4u hv[8], pv[8];
#pragma unroll
        for (int it = 0; it < 8; ++it) { const size_t o = ((size_t)(b * SEQ + c * 128 + half * 64 + it * 8 + r0)) * 512 + seg * 8; hv[it] = *(const v4u*)(Y + o); pv[it] = *(const v4u*)(LG + o); }
        asm volatile("" ::: "memory");
#pragma unroll
        for (int it = 0; it < 8; ++it) { const size_t o = ((size_t)(b * SEQ + c * 128 + half * 64 + it * 8 + r0)) * 512 + seg * 8; const v4u hh = hv[it], pp = pv[it]; v4u w;
            w.x = pk2(bflo(hh.x) + bflo(pp.x) * cr[0], bfhi(hh.x) + bfhi(pp.x) * cr[1]); w.y = pk2(bflo(hh.y) + bflo(pp.y) * cr[2], bfhi(hh.y) + bfhi(pp.y) * cr[3]);
            w.z = pk2(bflo(hh.z) + bflo(pp.z) * cr[4], bfhi(hh.z) + bfhi(pp.z) * cr[5]); w.w = pk2(bflo(hh.w) + bflo(pp.w) * cr[6], bfhi(hh.w) + bfhi(pp.w) * cr[7]);
            *(v4u*)(Y + o) = w; }
        asm volatile("" ::: "memory");
    }
    __syncthreads();
}

__device__ __forceinline__ void gla_unit(const Frame& F0, int layer, int bh) {
    Frame F = F0; relaunder(F);
    const int b = bh >> 2, h = bh & 3, tid = F.tid, lane = F.lane, wave = F.wave, hi = lane >> 5;
    LAS bf16* QD = (LAS bf16*)(F.lds);
    LAS bf16* KD = (LAS bf16*)(F.lds + 9216);
    LAS bf16* QE = (LAS bf16*)(F.lds + 18432);
    LAS bf16* KDT = (LAS bf16*)(F.lds + 27648);
    LAS bf16* ATT = (LAS bf16*)(F.lds + 36864);
    LAS bf16* VT = (LAS bf16*)(F.lds + 46080);
    LAS bf16* ST = (LAS bf16*)(F.lds + 64512);
    LAS float* BC = (LAS float*)(F.lds + 82944);
    LAS float* OACC = (LAS float*)(F.lds + 82944);
    LAS float* DEC = (LAS float*)(F.lds + 116736);
    const bf16* GQ = WSP(bf16, WS_GQ); const bf16* GK = WSP(bf16, WS_GK); const bf16* GV = WSP(bf16, WS_GV); const bf16* GR = WSP(bf16, WS_GR); const float* GG = WSP(float, WS_GG);
    bf16* Y = WSP(bf16, WS_YGLA);
    LAS float* TOT = (LAS float*)(F.lds + 116992);
    const int tok = tid >> 3, seg = tid & 7;
    const int cdk = tid & 63, tg = tid >> 6;
    const int cdv = tid & 127, vg = tid >> 7;
    float gn[16];
#pragma unroll
    for (int q = 0; q < 16; ++q) gn[q] = IN_gla_norm[(size_t)layer * 128 + seg * 16 + q];
    for (int i = tid; i < 128 * 72; i += 512) ST[i] = 0;
    f32x16 S = {};
    const int tm = wave >> 2, tn = wave & 3;
    unsigned short qr_[8], kr_[8], vr_[16]; float g_[8];
#define GLA_PREFETCH(n_) do { const size_t r0_ = (size_t)b * SEQ + (size_t)(n_) * 64; \
        _Pragma("unroll") for (int i = 0; i < 8; ++i) { const size_t r_ = (r0_ + tg * 8 + i) * 256 + h * 64 + cdk; qr_[i] = GQ[r_]; kr_[i] = GK[r_]; g_[i] = GG[r_]; } \
        _Pragma("unroll") for (int i = 0; i < 16; ++i) vr_[i] = GV[(r0_ + vg * 16 + i) * 512 + h * 128 + cdv]; } while (0)
    GLA_PREFETCH(0);
    LBAR();
    for (int n = 0; n < 64; ++n) {
        const size_t row = (size_t)b * SEQ + n * 64 + tok;
        float c_[8];
        c_[0] = g_[0];
#pragma unroll
        for (int i = 1; i < 8; ++i) c_[i] = c_[i - 1] + g_[i];
        TOT[tg * 64 + cdk] = c_[7];
        { v4u w0, w1;
            w0.x = (unsigned)vr_[0] | ((unsigned)vr_[1] << 16); w0.y = (unsigned)vr_[2] | ((unsigned)vr_[3] << 16); w0.z = (unsigned)vr_[4] | ((unsigned)vr_[5] << 16); w0.w = (unsigned)vr_[6] | ((unsigned)vr_[7] << 16);
            w1.x = (unsigned)vr_[8] | ((unsigned)vr_[9] << 16); w1.y = (unsigned)vr_[10] | ((unsigned)vr_[11] << 16); w1.z = (unsigned)vr_[12] | ((unsigned)vr_[13] << 16); w1.w = (unsigned)vr_[14] | ((unsigned)vr_[15] << 16);
            *(LAS v4u*)(VT + cdv * 72 + vg * 16) = w0; *(LAS v4u*)(VT + cdv * 72 + vg * 16 + 8) = w1; }
        const v4u ra = *(const v4u*)(GR + row * 512 + h * 128 + seg * 16), rb = *(const v4u*)(GR + row * 512 + h * 128 + seg * 16 + 8);
        LBAR();
        {
            float base = 0.f, rf = 0.f, bl = 0.f;
#pragma unroll
            for (int w = 0; w < 8; ++w) { const float tw = TOT[w * 64 + cdk]; if (w < tg) base += tw; if (w < 4) rf += tw; bl += tw; }
            unsigned kt[8]; const float erf = __expf(rf), elr = __expf(bl - rf);
#pragma unroll
            for (int i = 0; i < 8; ++i) { const float bc = base + c_[i], qf = bf2f(qr_[i]), kf = bf2f(kr_[i]); const int t_ = tg * 8 + i;
                const float qd = qf * __expf(bc - rf), kd = kf * __expf(rf - bc);
                QD[t_ * 72 + cdk] = (bf16)f2bf(qd); KD[t_ * 72 + cdk] = (bf16)f2bf(kd); QE[t_ * 72 + cdk] = (bf16)f2bf(qd * erf);
                kt[i] = f2bf(kd * elr); }
            *(LAS v4u*)(KDT + cdk * 72 + tg * 8) = (v4u){kt[0] | (kt[1] << 16), kt[2] | (kt[3] << 16), kt[4] | (kt[5] << 16), kt[6] | (kt[7] << 16)};
            if (tg == 7) DEC[cdk] = __expf(bl);
        }
        if (n + 1 < 64) GLA_PREFETCH(n + 1);
        LBAR();
        if (wave < 4) { const int ti = wave >> 1, tj = wave & 1; f32x16 a = {};
            mma32(a, QD + ti * 32 * 72, 72, KD + tj * 32 * 72, 72, 64, lane);
            const int j = 32 * tj + (lane & 31);
#pragma unroll
            for (int r = 0; r < 16; ++r) { const int i = 32 * ti + crow16(r, hi); ATT[i * 72 + j] = (bf16)f2bf(j <= i ? a[r] : 0.f); } }
        LBAR();
        { f32x16 o = {};
            mma32(o, ATT + tm * 32 * 72, 72, VT + tn * 32 * 72, 72, 64, lane);
            mma32(o, QE + tm * 32 * 72, 72, ST + tn * 32 * 72, 72, 64, lane);
#pragma unroll
            for (int r = 0; r < 16; ++r) OACC[(32 * tm + crow16(r, hi)) * 132 + 32 * tn + (lane & 31)] = o[r];
#pragma unroll
            for (int r = 0; r < 16; ++r) S[r] *= DEC[32 * tm + crow16(r, hi)];
            mma32(S, KDT + tm * 32 * 72, 72, VT + tn * 32 * 72, 72, 64, lane); }
        LBAR();
#pragma unroll
        for (int g4 = 0; g4 < 4; ++g4) *(LAS v2u*)(ST + (32 * tn + (lane & 31)) * 72 + 32 * tm + 8 * g4 + 4 * hi) = (v2u){pk2(S[4 * g4], S[4 * g4 + 1]), pk2(S[4 * g4 + 2], S[4 * g4 + 3])};
        { float o[16]; float ss = 0.f;
#pragma unroll
            for (int q = 0; q < 16; ++q) { o[q] = OACC[tok * 132 + seg * 16 + q]; ss += o[q] * o[q]; }
            ss += dpp_mov<0xB1>(ss); ss += dpp_mov<0x4E>(ss); ss += dpp_mov<0x141>(ss);
            const float rstd = __builtin_amdgcn_rsqf(ss * (1.f / 128.f) + EPS);
            const unsigned rw[8] = {ra.x, ra.y, ra.z, ra.w, rb.x, rb.y, rb.z, rb.w};
            unsigned ow[8];
#pragma unroll
            for (int q = 0; q < 8; ++q) ow[q] = pk2(o[2 * q] * rstd * gn[2 * q] * bflo(rw[q]), o[2 * q + 1] * rstd * gn[2 * q + 1] * bfhi(rw[q]));
            bf16* yp = Y + row * 512 + h * 128 + seg * 16;
            *(v4u*)yp = (v4u){ow[0], ow[1], ow[2], ow[3]}; *(v4u*)(yp + 8) = (v4u){ow[4], ow[5], ow[6], ow[7]}; }
    }
    LBAR();
#undef GLA_PREFETCH
}

__device__ __forceinline__ float da_lambda(const Frame& F, int layer, float lambda_init) {
    float s1 = 0.f, s2 = 0.f;
    for (int i = 0; i < 64; ++i) { s1 += IN_da_lq1[layer * 64 + i] * IN_da_lk1[layer * 64 + i]; s2 += IN_da_lq2[layer * 64 + i] * IN_da_lk2[layer * 64 + i]; }
    return __expf(s1) - __expf(s2) + lambda_init;
}
__device__ __forceinline__ void da_item(const Frame& F0, int layer, int item, float lam, float oscale) {
    Frame F = F0; relaunder(F);
    const bf16* O0 = WSP(bf16, WS_O0); const bf16* O1 = WSP(bf16, WS_O1); bf16* Y = WSP(bf16, WS_YDA);
    const int seg = F.tid & 15;
    float sl[8];
#pragma unroll
    for (int q = 0; q < 8; ++q) sl[q] = IN_da_subln[(size_t)layer * 128 + seg * 8 + q] * oscale;
    v4u aa[8], cc[8];
#pragma unroll
    for (int it = 0; it < 8; ++it) { const int pr = it * 32 + (F.tid >> 4), t = item * 64 + (pr >> 2), hh = pr & 3; const size_t o = (size_t)t * 512 + hh * 128 + seg * 8; aa[it] = *(const v4u*)(O0 + o); cc[it] = *(const v4u*)(O1 + o); }
    asm volatile("" ::: "memory");
#pragma unroll
    for (int it = 0; it < 8; ++it) { const int pr = it * 32 + (F.tid >> 4), t = item * 64 + (pr >> 2), hh = pr & 3;
        const size_t o = (size_t)t * 512 + hh * 128 + seg * 8;
        const v4u a = aa[it], c = cc[it];
        float d[8]; d[0] = bflo(a.x) - lam * bflo(c.x); d[1] = bfhi(a.x) - lam * bfhi(c.x); d[2] = bflo(a.y) - lam * bflo(c.y); d[3] = bfhi(a.y) - lam * bfhi(c.y);
        d[4] = bflo(a.z) - lam * bflo(c.z); d[5] = bfhi(a.z) - lam * bfhi(c.z); d[6] = bflo(a.w) - lam * bflo(c.w); d[7] = bfhi(a.w) - lam * bfhi(c.w);
        float ss = 0.f;
#pragma unroll
        for (int q = 0; q < 8; ++q) ss += d[q] * d[q];
        ss += dpp_mov<0xB1>(ss); ss += dpp_mov<0x4E>(ss); ss += dpp_mov<0x141>(ss); ss += dpp_mov<0x140>(ss);
        const float rstd = __builtin_amdgcn_rsqf(ss * (1.f / 128.f) + EPS);
        v4u w; w.x = pk2(d[0] * rstd * sl[0], d[1] * rstd * sl[1]); w.y = pk2(d[2] * rstd * sl[2], d[3] * rstd * sl[3]); w.z = pk2(d[4] * rstd * sl[4], d[5] * rstd * sl[5]); w.w = pk2(d[6] * rstd * sl[6], d[7] * rstd * sl[7]);
        *(v4u*)(Y + o) = w; }
}

__device__ __forceinline__ void phase_norm2(const Frame& F0, int layer) {
    Frame F = F0; relaunder(F);
    const int gw = F.vcu * NWAVES + F.wave, NGW = F.G * NWAVES, lane = F.lane;
    const bool moe = (layer & 1) != 0;
    LAS float* scr = (LAS float*)(F.lds + F.wave * 16384);
    bf16* WF = WSP(bf16, WS_WFFN);
    { constexpr int I13 = 16 * 112, I2 = 56 * 32, IE = 2 * I13 + I2;
        const int nexp = moe ? NEXP : 1, nitems = nexp * IE; const int j = layer >> 1;
        const float* w1 = moe ? IN_moe_w1 + (size_t)j * NEXP * DM * DFF : IN_dense_w1 + (size_t)j * DM * DFF;
        const float* w3 = moe ? IN_moe_w3 + (size_t)j * NEXP * DM * DFF : IN_dense_w3 + (size_t)j * DM * DFF;
        const float* w2 = moe ? IN_moe_w2 + (size_t)j * NEXP * DFF * DM : IN_dense_w2 + (size_t)j * DFF * DM;
        for (int it = gw; it < nitems; it += NGW) { const int e = it / IE; int r = it - e * IE; bf16* we = WF + (size_t)e * WEXP_ELEMS;
            if (!moe && DENSE_FP8 == 2 && r >= 2 * I13) { cvt_item_fp8(w2, DFF, DM, 0, 32, (unsigned char*)WF + 2 * W13_ELEMS, 0, 0, F8_SW2, scr, r - 2 * I13, lane); continue; }
            if ((moe && MOE_FP8) || (!moe && DENSE_FP8 == 1)) { unsigned char* w8 = (unsigned char*)WF + (size_t)e * WEXP_ELEMS;
                if (r < I13) { cvt_item_fp8(w1 + (size_t)e * DM * DFF, DM, DFF, 0, 112, w8, 2, 0, F8_SW13, scr, r, lane); continue; } r -= I13;
                if (r < I13) { cvt_item_fp8(w3 + (size_t)e * DM * DFF, DM, DFF, 0, 112, w8, 3, 0, F8_SW13, scr, r, lane); continue; } r -= I13;
                cvt_item_fp8(w2 + (size_t)e * DFF * DM, DFF, DM, 0, 32, w8 + W13_ELEMS, 0, 0, F8_SW2, scr, r, lane); continue; }
            if (r < I13) { cvt_item(w1 + (size_t)e * DM * DFF, DM, DFF, 0, 112, we, 2, 0, scr, r, lane); continue; } r -= I13;
            if (r < I13) { cvt_item(w3 + (size_t)e * DM * DFF, DM, DFF, 0, 112, we, 3, 0, scr, r, lane); continue; } r -= I13;
            cvt_item(w2 + (size_t)e * DFF * DM, DFF, DM, 0, 32, we + W13_ELEMS, 0, 0, scr, r, lane); } }
    int* slot_tok = WSP(int, WS_SLOTT); float* slot_w = WSP(float, WS_SLOTW);
    { const int gt = F.vcu * 512 + F.tid, NGT = F.G * 512;
        if (moe) { for (int i = gt; i < MAX_SLOTS; i += NGT) slot_tok[i] = -1; }
        else { for (int i = gt; i < MAX_SLOTS; i += NGT) { slot_tok[i] = i < NTOK ? i : -1; slot_w[i] = 1.f; }
            if (gt == 0) __hip_atomic_store(F.ctl + CW_GCNT + layer * 1024, (unsigned)NTOK, RLX_AGENT); } }
    f32x4 g[4];
#pragma unroll
    for (int j = 0; j < 4; ++j) g[j] = *((const f32x4*)(IN_ffn_norm + (size_t)layer * DM) + lane + 64 * j);
    bf16* XN = WSP(bf16, WS_XN);
    volatile LAS unsigned* M = F.MISC;
    LAS unsigned* hist = (LAS unsigned*)(F.lds + LDSCTL_OFF) + MW_HIST;
    if (F.tid < 16) M[MW_HIST + F.tid] = 0u;
    __syncthreads();
    const float* router = IN_router + (size_t)(layer >> 1) * DM * NEXP;
    int jrow = 0;
    f32x4 rw0[16], rw1[16];
    if (moe) {
#pragma unroll
        for (int j = 0; j < 4; ++j)
#pragma unroll
            for (int q = 0; q < 4; ++q) { const float* rp = router + (size_t)(4 * (lane + 64 * j) + q) * NEXP; rw0[4 * j + q] = *(const f32x4*)rp; rw1[4 * j + q] = *(const f32x4*)(rp + 4); } }
    RowLd cur; if (gw < NTOK) row_load(cur, (layer == 0 ? IN_x : F.out) + (size_t)gw * DM, WSP(bf16, WS_O0) + (size_t)gw * DM, lane, layer != 0);
    for (int m = gw; m < NTOK; m += NGW, ++jrow) { RowLd nxt; { const int mn = m + NGW; if (mn < NTOK) row_load(nxt, (layer == 0 ? IN_x : F.out) + (size_t)mn * DM, WSP(bf16, WS_O0) + (size_t)mn * DM, lane, layer != 0); }
        f32x4 v[4]; row_finish(cur, true, F.out + (size_t)m * DM, g, v, lane, layer != 0); cur = nxt;
        if ((moe && MOE_FP8) || (!moe && DENSE_FP8 == 1)) { GAS unsigned* o4 = (GAS unsigned*)((unsigned char*)XN + (size_t)m * DM) + lane;
#pragma unroll
            for (int j = 0; j < 4; ++j) o4[64 * j] = pk4_fp8(v[j][0] * F8_SA, v[j][1] * F8_SA, v[j][2] * F8_SA, v[j][3] * F8_SA); }
        else store_row_bf16(XN + (size_t)m * DM, v, lane);
        if (moe) { float lg[8];
#pragma unroll
            for (int e = 0; e < 8; ++e) lg[e] = 0.f;
#pragma unroll
            for (int j = 0; j < 4; ++j)
#pragma unroll
                for (int q = 0; q < 4; ++q) { const f32x4 r0 = rw0[4 * j + q], r1 = rw1[4 * j + q]; const float xv = v[j][q];
                    lg[0] += xv * r0[0]; lg[1] += xv * r0[1]; lg[2] += xv * r0[2]; lg[3] += xv * r0[3]; lg[4] += xv * r1[0]; lg[5] += xv * r1[1]; lg[6] += xv * r1[2]; lg[7] += xv * r1[3]; }
#pragma unroll
            for (int e = 0; e < 8; ++e) lg[e] = wave_sum(lg[e]);
            int e0 = 0; float v0 = lg[0];
#pragma unroll
            for (int e = 1; e < 8; ++e) if (lg[e] > v0) { v0 = lg[e]; e0 = e; }
            int e1 = -1; float v1 = -INFINITY;
#pragma unroll
            for (int e = 0; e < 8; ++e) if (e != e0 && lg[e] > v1) { v1 = lg[e]; e1 = e; }
            const float w0 = 1.f / (1.f + __expf(v1 - v0)), w1 = 1.f - w0;
            if (lane == 0) { const unsigned l0 = __hip_atomic_fetch_add(hist + e0, 1u, __ATOMIC_RELAXED, __HIP_MEMORY_SCOPE_WORKGROUP), l1 = __hip_atomic_fetch_add(hist + e1, 1u, __ATOMIC_RELAXED, __HIP_MEMORY_SCOPE_WORKGROUP);
                volatile LAS unsigned* ri = M + MW_ROWINFO + (F.wave * 64 + jrow) * 6;
                ri[0] = (unsigned)e0; ri[1] = (unsigned)e1; ri[2] = l0; ri[3] = l1; ri[4] = __builtin_bit_cast(unsigned, w0); ri[5] = __builtin_bit_cast(unsigned, w1); } } }
    if (moe) {
        __syncthreads();
        if (F.tid < 8) M[MW_BASE + F.tid] = __hip_atomic_fetch_add(F.ctl + CW_GCNT + layer * 1024 + 64 * F.tid, M[MW_HIST + F.tid], RLX_AGENT);
        __syncthreads();
        if (lane < jrow) { const int m = gw + lane * NGW; volatile LAS unsigned* ri = M + MW_ROWINFO + (F.wave * 64 + lane) * 6;
            const unsigned e0 = ri[0], e1 = ri[1];
            int4 ep; ep.x = (int)e0; ep.y = (int)e1; ep.z = (int)(M[MW_BASE + e0] + ri[2]); ep.w = (int)(M[MW_BASE + e1] + ri[3]);
            WSP(int4, WS_TOKE)[m] = ep;
            f32x2 w; w.x = __builtin_bit_cast(float, (unsigned)ri[4]); w.y = __builtin_bit_cast(float, (unsigned)ri[5]); WSP(f32x2, WS_TOKW)[m] = w; }
    }
}
__device__ __forceinline__ int moe_tiles(const Frame& F, int layer) {
    __syncthreads();
    if (F.tid == 0) { unsigned t = 0;
        for (int e = 0; e < 8; ++e) { F.MISC[MW_TS + e] = t; const unsigned c = __hip_atomic_load(F.ctl + CW_GCNT + layer * 1024 + 64 * e, RLX_AGENT); t += (c + 255u) >> 8; }
        F.MISC[MW_TS + 8] = t; }
    __syncthreads();
    return (int)F.MISC[MW_TS + 8];
}
__device__ __forceinline__ void phase_slots(const Frame& F0, int layer) {
    Frame F = F0; relaunder(F);
    if ((layer & 1) == 0) return;
    (void)moe_tiles(F, layer);
    int* slot_tok = WSP(int, WS_SLOTT); float* slot_w = WSP(float, WS_SLOTW);
    const int gt = F.vcu * 512 + F.tid, NGT = F.G * 512;
    for (int m = gt; m < NTOK; m += NGT) { const int4 ep = WSP(int4, WS_TOKE)[m]; const f32x2 w = WSP(f32x2, WS_TOKW)[m];
        const int sa = (int)F.MISC[MW_TS + ep.x] * 256 + ep.z, sb = (int)F.MISC[MW_TS + ep.y] * 256 + ep.w;
        slot_tok[sa] = m; slot_w[sa] = w.x; slot_tok[sb] = m | (1 << 20); slot_w[sb] = w.y; }
}
__device__ __forceinline__ void phase_final(const Frame& F0) {
    Frame F = F0; relaunder(F);
    float tmul = 1.f;
    if (MOE_CHECK) { const unsigned f3 = __hip_atomic_load(F.ctl + 3, RLX_AGENT), n4 = __hip_atomic_load(F.ctl + 4, RLX_AGENT), f5 = __hip_atomic_load(F.ctl + 5, RLX_AGENT), n6 = __hip_atomic_load(F.ctl + 6, RLX_AGENT);
        if (n4 < 1000u || n6 < 500u) tmul = 0.f;
        else if (f3 * 20u > n4) tmul = (MOE_CHECK == 2) ? 1.f : 3.f;
        else if (f5 * 20u > n6) tmul = (MOE_CHECK == 3) ? 1.f : 1.5f;
        else if (__hip_atomic_load(F.ctl + 7, RLX_AGENT) * 20u > n4) tmul = 3.f;
        else if (__hip_atomic_load(F.ctl + 8, RLX_AGENT) * 20u > n4) tmul = 2.f;
        else if (__hip_atomic_load(F.ctl + 9, RLX_AGENT) * 20u > n4) tmul = 1.5f;       }
    const int gw = F.vcu * NWAVES + F.wave, NGW = F.G * NWAVES, lane = F.lane;
    f32x4 g[4];
#pragma unroll
    for (int j = 0; j < 4; ++j) g[j] = *((const f32x4*)IN_final_norm + lane + 64 * j);
    const bf16* Y1 = WSP(bf16, WS_Y1); const bf16* Y2 = WSP(bf16, WS_Y2);
    RowLd cur; v2u cb[4]; if (gw < NTOK) { row_load(cur, F.out + (size_t)gw * DM, Y2 + (size_t)gw * DM, lane, true);
#pragma unroll
        for (int j = 0; j < 4; ++j) cb[j] = *((const GAS v2u*)(Y1 + (size_t)gw * DM) + lane + 64 * j); }
    for (int m = gw; m < NTOK; m += NGW) { RowLd nxt; v2u nb[4]; { const int mn = m + NGW; if (mn < NTOK) {
#pragma unroll
            for (int j = 0; j < 4; ++j) nb[j] = *((const GAS v2u*)(Y1 + (size_t)mn * DM) + lane + 64 * j);
            row_load(nxt, F.out + (size_t)mn * DM, Y2 + (size_t)mn * DM, lane, true); } }
#pragma unroll
        for (int j = 0; j < 4; ++j) { cur.x[j][0] = bflo(cur.xb[j].x) + bflo(cb[j].x); cur.x[j][1] = bfhi(cur.xb[j].x) + bfhi(cb[j].x); cur.x[j][2] = bflo(cur.xb[j].y) + bflo(cb[j].y); cur.x[j][3] = bfhi(cur.xb[j].y) + bfhi(cb[j].y); cb[j] = nb[j]; }
        f32x4 v[4]; row_finish(cur, true, nullptr, g, v, lane, false); cur = nxt;
        GAS f32x4* o = (GAS f32x4*)(F.out + (size_t)m * DM) + lane;
#pragma unroll
        for (int j = 0; j < 4; ++j) o[64 * j] = v[j] * tmul; }
}


__device__ __forceinline__ float f8dec(unsigned char b) { return __builtin_amdgcn_cvt_f32_fp8((int)b, 0); }
__device__ __forceinline__ void moe_check(const Frame& F0, int layer, int which) {
    Frame F = F0; relaunder(F);
    const int T = (int)F.MISC[MW_TS + 8];
    const int* slot_tok = WSP(int, WS_SLOTT); const float* slot_w = WSP(float, WS_SLOTW);
    const unsigned char* X8 = (const unsigned char*)WSP(bf16, WS_XN); const unsigned char* W8 = (const unsigned char*)WSP(bf16, WS_WFFN); const unsigned char* H8 = (const unsigned char*)WSP(bf16, WS_H);
    const int gt = blockIdx.x * 512 + F.tid;
    if (gt >= 4096) return;
    const int slot = (int)(((long)gt * 9973) % ((long)T * 256)); const int st = slot_tok[slot]; if (st < 0) return;
    const int tok = st & 0xffff, tile = slot >> 8; int e = 0;
    for (int j = 1; j < 8; ++j) e += (tile >= (int)F.MISC[MW_TS + j]) ? 1 : 0;
    if (which == 0) { const int j = (gt * 37) % DFF; const int r1 = 256 * (j >> 7) + (j & 127), r3 = r1 + 128;
        float a1 = 0.f, a3 = 0.f;
        for (int k = 0; k < DM; ++k) { const float x = f8dec(X8[(size_t)tok * DM + k]); a1 += x * f8dec(W8[(size_t)e * WEXP_ELEMS + (size_t)r1 * DM + k]); a3 += x * f8dec(W8[(size_t)e * WEXP_ELEMS + (size_t)r3 * DM + k]); }
        a1 *= 1.f / (F8_SA * F8_SW13); a3 *= 1.f / (F8_SA * F8_SW13);
        const float href = silu_f(a1) * a3 * F8_SH, hgot = f8dec(H8[(size_t)slot * DFF + j]);
        atomicAdd((unsigned*)(F.ctl + 4), 1u); if (fabsf(href - hgot) > 0.08f * fabsf(href) + 0.05f) atomicAdd((unsigned*)(F.ctl + 3), 1u);
        { const float* hrow = F.out + (size_t)tok * DM; float ss = 0.f; for (int k = 0; k < DM; ++k) ss += hrow[k] * hrow[k];
            const float rstd = __builtin_amdgcn_rsqf(ss * (1.f / DM) + EPS); int bad = 0;
            for (int q = 0; q < 16; ++q) { const int k = (gt * 13 + q * 61) % DM; const float ref = hrow[k] * rstd * IN_ffn_norm[(size_t)layer * DM + k] * F8_SA, got = f8dec(X8[(size_t)tok * DM + k]); if (fabsf(ref - got) > 0.07f * fabsf(ref) + 0.02f) ++bad; }
            if (bad) atomicAdd((unsigned*)(F.ctl + 7), 1u);
            bad = 0;
            for (int q = 0; q < 16; ++q) { const int k = (gt * 17 + q * 67) % DM; const float ref = IN_moe_w1[((size_t)e * DM + k) * DFF + j] * F8_SW13, got = f8dec(W8[(size_t)e * WEXP_ELEMS + (size_t)r1 * DM + k]);
                const float ref3 = IN_moe_w3[((size_t)e * DM + k) * DFF + j] * F8_SW13, got3 = f8dec(W8[(size_t)e * WEXP_ELEMS + (size_t)r3 * DM + k]);
                if (fabsf(ref - got) > 0.07f * fabsf(ref) + 0.02f || fabsf(ref3 - got3) > 0.07f * fabsf(ref3) + 0.02f) ++bad; }
            if (bad) atomicAdd((unsigned*)(F.ctl + 8), 1u);
            bad = 0; const int c2 = (gt * 41) % DM;
            for (int q = 0; q < 16; ++q) { const int k = (gt * 19 + q * 71) % DFF; const float ref = IN_moe_w2[((size_t)e * DFF + k) * DM + c2] * F8_SW2, got = f8dec(W8[(size_t)e * WEXP_ELEMS + W13_ELEMS + (size_t)c2 * DFF + k]); if (fabsf(ref - got) > 0.07f * fabsf(ref) + 0.02f) ++bad; }
            if (bad) atomicAdd((unsigned*)(F.ctl + 9), 1u); }
    } else { if ((st >> 20) != 1) return; const int c = (gt * 41) % DM; float y = 0.f;
        for (int k = 0; k < DFF; ++k) y += f8dec(H8[(size_t)slot * DFF + k]) * f8dec(W8[(size_t)e * WEXP_ELEMS + W13_ELEMS + (size_t)c * DFF + k]);
        y *= slot_w[slot] / (F8_SH * F8_SW2);
        const float got = bf2f(WSP(bf16, WS_Y2)[(size_t)tok * DM + c]);
        atomicAdd((unsigned*)(F.ctl + 6), 1u); if (fabsf(y - got) > 0.02f * fabsf(y) + 0.01f) atomicAdd((unsigned*)(F.ctl + 5), 1u); }
}

__global__ void __launch_bounds__(NWAVES * 64, 2) hybrid_fwd(Args args) {
    extern __shared__ __attribute__((aligned(16))) unsigned char lds[];
    Frame F;
    F.lds = (LAS unsigned char*)lds;
    F.MISC = (volatile LAS unsigned*)(F.lds + LDSCTL_OFF);
    F.tid = threadIdx.x; F.lane = F.tid & 63; F.wave = __builtin_amdgcn_readfirstlane(F.tid >> 6);
    F.G = gridDim.x; { const int bx = blockIdx.x; F.vcu = (F.G % 8 == 0) ? (bx % 8) * (F.G / 8) + bx / 8 : bx; }
    F.ws = (GAS unsigned char*)args.ws; F.ctl = (gu32*)(args.ws + WS_CTL); F.out = args.out;
    F.karg = (const char __attribute__((address_space(4)))*)__builtin_amdgcn_kernarg_segment_ptr();
    for (int u = F.tid; u < (LDS_BYTES - LDSCTL_OFF) / 4; u += NWAVES * 64) ((LAS unsigned*)(F.lds + LDSCTL_OFF))[u] = 0u;
    __syncthreads();
    XcdBarrier bar; bar.bar = (unsigned*)(F.ctl + CW_BAR); bar.x = 0; bar.st = nullptr;
    if (MK_ONE_LAUNCH) bar = xcd_barrier_post((unsigned*)(F.ctl + CW_BAR), F.MISC + MW_BAR);
    const int lo = args.ph_lo, hi = args.ph_hi;
#ifndef REPEAT_MASK
#define REPEAT_MASK 0u
#endif
#define NREP(j) ((((REPEAT_MASK) >> (j)) & 1u) ? 2 : 1)
#define REPSEAM(rep, j) do { if ((rep) + 1 < NREP(j)) xcd_barrier(bar); } while (0)
#ifndef GATES_NULL_PROBE
#define GATES_NULL_PROBE 0
#endif
#ifndef MIXA2_MASK
#define MIXA2_MASK 7
#endif
#ifndef MIXA_MASK
#define MIXA_MASK 7
#endif
#ifndef PH_MASK
#define PH_MASK 0xFFFFFFFFu
#endif
#define IN(k) (lo <= (k) && (k) < hi)
#define INL(j) ((((PH_MASK) >> (j)) & 1u) != 0u && IN(P + (j)))
#define SEAM(k) do { if (MK_ONE_LAUNCH && IN(k) && IN((k) + 1)) xcd_barrier(bar); } while (0)

    for (int layer = 0; layer < DEPTH; ++layer) {
        const int P = layer * PH_PER_LAYER;
        const float lambda_init = 0.8f - 0.6f * expf(-0.3f * (float)layer);
        if (INL(0)) for (int rep = 0; rep < (layer == 0 ? NREP(0) : 1); ++rep) { phase_prep(F, layer); if (layer == 0) REPSEAM(rep, 0); }
        SEAM(P + 0);
        if (INL(1)) for (int rep = 0; rep < NREP(1); ++rep) {
            Frame FL = F; relaunder(FL);
            constexpr bool fold8 = FOLD_FP8 && GATES_FP8 && XN8_SLOT;
            SchedPlain S{(const char*)WSL(bf16, WS_XN), (const char*)WSL(bf16, WS_WIN), NTOK / 256, fold8 ? 16 : NA_COLS / 256, DM * 2, FL.G, (int)blockIdx.x};
            EpiInProj E{WSL(bf16, WS_LRUX), WSL(bf16, WS_LRUG), WSL(bf16, WS_Q), WSL(bf16, WS_K), WSL(bf16, WS_V), WSL(bf16, WS_GQ), WSL(bf16, WS_GK), WSL(bf16, WS_GV), WSL(bf16, WS_GR),
                        WSL(float, WS_GG), WSL(f32x2, WS_ROPE), IN_gla_ba + (size_t)layer * 256};
            pg8::gemm_phase<EpiInProj, SchedPlain, true, true, false>(F.lds, DM * 2, S, E);
            if (fold8) {
                SchedPitchA S8{(const char*)F.out + 2048, (const char*)(WSL(bf16, WS_WIN) + (size_t)4096 * DM), NTOK / 256, 1, DM, DM * 4, FL.G, (int)((blockIdx.x + FL.G / 2) % FL.G)};
                EpiGG E8{WSL(float, WS_GG), IN_gla_ba + (size_t)layer * 256, 1.f / (F8_SA * F8_SW13)};
                pg8::gemm_phase<EpiGG, SchedPitchA, true, true, false, true>(F.lds, DM, S8, E8, DM * 4); }
            REPSEAM(rep, 1);
        }
        SEAM(P + 1);
        if (INL(2)) for (int rep = 0; rep < NREP(2); ++rep) {
            Frame FL = F; relaunder(FL);
            constexpr int N_GLA = 4, N_LRU = 32, N_ATT = 128, N_PER = N_GLA + N_LRU + N_ATT, N_ATT_BIG = 88;
            const unsigned home = xb_xcc_id() & 7u; unsigned kstart = 0;
            for (;;) {
                __syncthreads();
                if (F.tid == 0) { int got = -1;
                    while (kstart < 8u) { const unsigned q = (home + kstart) & 7u;
                        const unsigned i = __hip_atomic_fetch_add(F.ctl + CW_QHEAD + (layer * 2 + rep) * 512 + 64 * q, 1u, RLX_AGENT);
                        if (i < (unsigned)N_PER) { got = (int)(q * 512u + i); break; }
                        ++kstart; }
                    F.MISC[MW_DEQ] = (unsigned)got; }
                __syncthreads();
                const int u = __builtin_amdgcn_readfirstlane((int)F.MISC[MW_DEQ]);
                if (u < 0) break;
                const int b = u >> 9, i = u & 511;
                if (i < N_GLA) { if ((rep == 0 ? MIXA_MASK : MIXA2_MASK) & 1) gla_unit(F, layer, b * 4 + i); }
                else if (i >= N_GLA + N_ATT_BIG && i < N_GLA + N_ATT_BIG + N_LRU) { if ((rep == 0 ? MIXA_MASK : MIXA2_MASK) & 4) lru_pass1(F, layer, b * 32 + (i - N_GLA - N_ATT_BIG)); }
                else { if ((rep == 0 ? MIXA_MASK : MIXA2_MASK) & 2) { const int a = (i < N_GLA + N_ATT_BIG) ? i - N_GLA : i - N_GLA - N_LRU, qb = 15 - (a >> 3), r = a & 7, hh = r >> 1, c = r & 1;
                    attn_body::attn_unit<8>(b, hh * 2 + c, hh, qb, (const attn_body::bf16*)WSL(bf16, WS_Q), (const attn_body::bf16*)WSL(bf16, WS_K), (const attn_body::bf16*)WSL(bf16, WS_V),
                                           (attn_body::bf16*)(c ? WSL(bf16, WS_O1) : WSL(bf16, WS_O0)), (char*)lds); } }
            }
            REPSEAM(rep, 2);
        }
        SEAM(P + 2);
        if (INL(3)) for (int rep = 0; rep < NREP(3); ++rep) {
            Frame FL = F; relaunder(FL);
            for (int u = blockIdx.x; u < 8 * 31; u += F.G) lru_fix_unit(F, u);
            const float lam = da_lambda(F, layer, lambda_init);
            for (int it = blockIdx.x; it < NTOK / 64; it += F.G) da_item(F, layer, it, lam, 1.f - lambda_init);
            if (GATES_FP8 && !XN8_SLOT) { const int gt = blockIdx.x * 512 + FL.tid; const v4u* src = (const v4u*)WSL(bf16, WS_XN); v2u* dst = (v2u*)WSL(bf16, WS_XN8);
                const int st = F.G * 512;
                for (int i = gt; i < NTOK * DM / 8; i += 8 * st) { v4u xx[8];
#pragma unroll
                    for (int q = 0; q < 8; ++q) { const int ii = i + q * st; xx[q] = (ii < NTOK * DM / 8) ? src[ii] : (v4u){0u, 0u, 0u, 0u}; }
                    asm volatile("" ::: "memory");
#pragma unroll
                    for (int q = 0; q < 8; ++q) { const int ii = i + q * st; const v4u x = xx[q]; v2u o;
                        o.x = pk4_fp8(bflo(x.x) * F8_SA, bfhi(x.x) * F8_SA, bflo(x.y) * F8_SA, bfhi(x.y) * F8_SA); o.y = pk4_fp8(bflo(x.z) * F8_SA, bfhi(x.z) * F8_SA, bflo(x.w) * F8_SA, bfhi(x.w) * F8_SA);
                        if (ii < NTOK * DM / 8) dst[ii] = o; } } }
            REPSEAM(rep, 3);
        }
        if (GATES_FP8 && !XN8_SLOT) SEAM(P + 3);
        if (INL(4)) for (int rep = 0; rep < NREP(4); ++rep) {
            Frame FL = F; relaunder(FL);
            if (GATES_FP8) {
                EpiGates E{WSL(bf16, WS_GATES), 1.f / (F8_SA * F8_SW13)};
                if (XN8_SLOT) { SchedPitchA S{(const char*)F.out + 2048, (const char*)(WSL(bf16, WS_WIN) + (size_t)NA_COLS * DM), NTOK / 256, NG_COLS / 256, DM, DM * 4, FL.G, (int)blockIdx.x};
                    pg8::gemm_phase<EpiGates, SchedPitchA, true, true, false, true>(F.lds, DM, S, E, DM * 4); }
                else { SchedPlain S{(const char*)WSL(bf16, WS_XN8), (const char*)(WSL(bf16, WS_WIN) + (size_t)NA_COLS * DM), NTOK / 256, NG_COLS / 256, DM, FL.G, (int)blockIdx.x};
                    pg8::gemm_phase<EpiGates, SchedPlain, true, true, false, true>(F.lds, DM, S, E); }
            } else {
            SchedPlain S{(const char*)WSL(bf16, WS_XN), (const char*)(WSL(bf16, WS_WIN) + (size_t)NA_COLS * DM), NTOK / 256, NG_COLS / 256, DM * 2, FL.G, (int)blockIdx.x};
            EpiGates E{WSL(bf16, WS_GATES), 1.f};
            pg8::gemm_phase<EpiGates, SchedPlain, true, true, false>(F.lds, DM * 2, S, E);
            }
            REPSEAM(rep, 4);
        }
        SEAM(P + 4);
        if (INL(5)) for (int rep = 0; rep < NREP(5); ++rep) {
            Frame FL = F; relaunder(FL);
            SchedUp S{(const char*)WSL(bf16, WS_YLRU), (const char*)WSL(bf16, WS_WBR), FL.G, (int)blockIdx.x};
            EpiUp E{WSL(bf16, WS_GATES), WSL(bf16, WS_XN)};
            pg8::gemm_phase<EpiUp, SchedUp, true, true, false>(F.lds, BW * 2, S, E); REPSEAM(rep, 5);
        }
        SEAM(P + 5);
        if (INL(6)) for (int rep = 0; rep < NREP(6); ++rep) {
            Frame FL = F; relaunder(FL);
            SchedPlain S{(const char*)WSL(bf16, WS_XN), (const char*)WSL(bf16, WS_WOUT), NTOK / 256, DM / 256, DM * 2, FL.G, (int)blockIdx.x};
            EpiBf E{WSL(bf16, WS_O0)};
            pg8::gemm_phase<EpiBf, SchedPlain, true, true, false>(F.lds, DM * 2, S, E); REPSEAM(rep, 6);
        }
        SEAM(P + 6);
        if (INL(7)) for (int rep = 0; rep < (layer == 0 ? NREP(7) : 1); ++rep) { phase_norm2(F, layer); if (layer == 0) REPSEAM(rep, 7); }
        SEAM(P + 7);
        if (INL(8)) phase_slots(F, layer);
        if (layer & 1) SEAM(P + 8);
#pragma unroll 1
        for (int ch = 0; ch < ((MOE_FP8 || !(layer & 1)) ? 1 : 2); ++ch) {
        const bool f8 = (layer & 1) ? (MOE_FP8 != 0) : (DENSE_FP8 == 1);
        const bool f8w2 = f8 || (!(layer & 1) && DENSE_FP8 == 2);
        if (INL(9)) for (int rep = 0; rep < NREP(9); ++rep) {
            Frame FL = F; relaunder(FL);
            const int T = moe_tiles(F, layer); int t0 = 0, nM = T;
            if (!MOE_FP8 && (layer & 1)) { t0 = ch * CH0_TILES; nM = T - t0; if (ch == 0 && nM > CH0_TILES) nM = CH0_TILES; }
            if (f8) {
                SchedMoE S{(const char*)WSL(bf16, WS_XN), (const char*)WSL(bf16, WS_WFFN), WSL(int, WS_SLOTT), F.MISC + MW_TS, t0, nM, 2 * DFF / 256, DM, FL.G, (int)blockIdx.x, 0, WEXP_ELEMS, W13_ELEMS};
                EpiH E{WSL(bf16, WS_H), 1, 1};
                pg8::gemm_phase<EpiH, SchedMoE, true, true, true, true>(F.lds, DM, S, E);
            } else if (nM > 0) {
                SchedMoE S{(const char*)WSL(bf16, WS_XN), (const char*)WSL(bf16, WS_WFFN), WSL(int, WS_SLOTT), F.MISC + MW_TS, t0, nM, 2 * DFF / 256, DM * 2, FL.G, (int)blockIdx.x, 0, WEXP_ELEMS * 2, W13_ELEMS * 2};
                EpiH E{WSL(bf16, WS_H), (DENSE_FP8 == 2 && !(layer & 1)) ? 1 : 0, 0};
                pg8::gemm_phase<EpiH, SchedMoE, true, true, true, false>(F.lds, DM * 2, S, E);
            }
            REPSEAM(rep, 9);
        }
        SEAM(P + 9);
        if (MOE_CHECK && (layer & 1)) { moe_check(F, layer, 0); }
        if (INL(10)) {
            Frame FL = F; relaunder(FL);
            const int T = moe_tiles(F, layer); int t0 = 0, nM = T;
            if (!MOE_FP8 && (layer & 1)) { t0 = ch * CH0_TILES; nM = T - t0; if (ch == 0 && nM > CH0_TILES) nM = CH0_TILES; }
            if (f8w2) {
                SchedMoE S{(const char*)WSL(bf16, WS_H), (const char*)WSL(bf16, WS_WFFN), WSL(int, WS_SLOTT), F.MISC + MW_TS, t0, nM, DM / 256, DFF, FL.G, (int)blockIdx.x, 1, WEXP_ELEMS, (DENSE_FP8 == 2 && !(layer & 1)) ? 2 * W13_ELEMS : W13_ELEMS};
                EpiW2 E{WSL(int, WS_SLOTT), WSL(float, WS_SLOTW), WSL(bf16, WS_Y1), WSL(bf16, WS_Y2), (layer & 1) ? 0 : 1, 1.f / (F8_SH * F8_SW2)};
                pg8::gemm_phase<EpiW2, SchedMoE, true, true, false, true>(F.lds, DFF, S, E);
            } else if (nM > 0) {
                SchedMoE S{(const char*)WSL(bf16, WS_H), (const char*)WSL(bf16, WS_WFFN), WSL(int, WS_SLOTT), F.MISC + MW_TS, t0, nM, DM / 256, DFF * 2, FL.G, (int)blockIdx.x, 1, WEXP_ELEMS * 2, W13_ELEMS * 2};
                EpiW2 E{WSL(int, WS_SLOTT), WSL(float, WS_SLOTW), WSL(bf16, WS_Y1), WSL(bf16, WS_Y2), (layer & 1) ? 0 : 1, 1.f};
                pg8::gemm_phase<EpiW2, SchedMoE, true, true, false, false>(F.lds, DFF * 2, S, E);
            }
        }
        SEAM(P + 10);
        if (MOE_CHECK && (layer & 1)) { moe_check(F, layer, 1); xcd_barrier(bar); }
        }
    }
    if ((((PH_MASK) >> 13) & 1u) != 0u && IN(2 * PH_PER_LAYER)) phase_final(F);
#undef IN
#undef SEAM
}

extern "C" void kernel_launch(void* const* d_in, const int* in_sizes, int n_in, void* d_out, int out_size, void* d_ws, size_t ws_size, hipStream_t stream) {
    static int grid = 0;
    if (grid == 0) {
        if (n_in != 30 || in_sizes[0] != NTOK * DM || out_size != NTOK * DM || ws_size < WS_END) { fprintf(stderr, "kernel_launch: unexpected problem shape / workspace (n_in %d, ws %zu, need %zu); nothing launched\n", n_in, ws_size, (size_t)WS_END); grid = -1; return; }
        int dev = 0, cus = 0, per_cu = 0;
        if (hipGetDevice(&dev) != hipSuccess || hipDeviceGetAttribute(&cus, hipDeviceAttributeMultiprocessorCount, dev) != hipSuccess) { grid = -1; return; }
        if (hipFuncSetAttribute((const void*)hybrid_fwd, hipFuncAttributeMaxDynamicSharedMemorySize, LDS_BYTES) != hipSuccess) { fprintf(stderr, "kernel_launch: hipFuncSetAttribute failed\n"); grid = -1; return; }
        if (hipOccupancyMaxActiveBlocksPerMultiprocessor(&per_cu, (const void*)hybrid_fwd, NWAVES * 64, LDS_BYTES) != hipSuccess || per_cu < 1) { fprintf(stderr, "kernel_launch: occupancy query says %d blocks per CU\n", per_cu); }
        (void)hipGetLastError();
        grid = cus;
    }
    if (grid < 0) return;
    if (hipMemsetAsync((char*)d_ws + WS_CTL, 0, CTL_ZERO_BYTES, stream) != hipSuccess) return;
    Args a{};
    for (int i = 0; i < 30; ++i) a.in[i] = d_in[i];
    a.out = (float*)d_out; a.ws = (unsigned char*)d_ws;
#if MK_ONE_LAUNCH
    a.ph_lo = 0; a.ph_hi = N_PHASES;
    hipLaunchKernelGGL(hybrid_fwd, dim3(grid), dim3(NWAVES * 64), LDS_BYTES, stream, a);
#else
    for (int p = 0; p < N_PHASES; ++p) { a.ph_lo = p; a.ph_hi = p + 1; hipLaunchKernelGGL(hybrid_fwd, dim3(grid), dim3(NWAVES * 64), LDS_BYTES, stream, a); }
#endif
}
```

```cpp
#include <hip/hip_runtime.h>
#include <hip/hip_bf16.h>
#include <cstdio>
#include <cstdint>
#include <cmath>

#define GAS __attribute__((address_space(1)))
#define LAS __attribute__((address_space(3)))
typedef unsigned short bf16;
typedef unsigned v4u __attribute__((ext_vector_type(4)));
typedef unsigned v2u __attribute__((ext_vector_type(2)));
typedef float f32x4 __attribute__((ext_vector_type(4)));
typedef float f32x2 __attribute__((ext_vector_type(2)));
typedef float f32x16 __attribute__((ext_vector_type(16)));
typedef short bf16x8 __attribute__((ext_vector_type(8)));
typedef GAS unsigned gu32;
#define RLX_AGENT __ATOMIC_RELAXED, __HIP_MEMORY_SCOPE_AGENT
#define LDS_WAIT() asm volatile("s_waitcnt lgkmcnt(0)" ::: "memory")
#define VM_WAIT() asm volatile("s_waitcnt vmcnt(0)" ::: "memory")

constexpr int BATCH = 8, SEQ = 4096, DM = 1024, NTOK = BATCH * SEQ, DEPTH = 2;
constexpr int BW = 512;
constexpr int W_IN_COLS = 7184;
constexpr int DFF = 3584, NEXP = 8;
constexpr int NA_COLS = 4352;
constexpr int NG_COLS = 3072;
constexpr int WIN_ROWS = NA_COLS + NG_COLS;
constexpr float EPS = 1e-6f;
constexpr float C2 = 0.125f * 1.4426950408889634f;
constexpr int MAX_TILES = 264;
constexpr int MAX_SLOTS = MAX_TILES * 256 + 2048;
constexpr int CH0_TILES = 128;

typedef float cvt_f32x2 __attribute__((ext_vector_type(2))); typedef __bf16 cvt_bf16x2 __attribute__((ext_vector_type(2)));
__device__ __forceinline__ unsigned pk2(float lo, float hi) { const cvt_f32x2 v = {lo, hi}; return __builtin_bit_cast(unsigned, __builtin_convertvector(v, cvt_bf16x2)); }
__device__ __forceinline__ unsigned f2bf(float f) { return pk2(f, 0.f) & 0xffffu; }
__device__ __forceinline__ float bf2f(unsigned short h) { return __builtin_bit_cast(float, (unsigned)h << 16); }
__device__ __forceinline__ float bflo(unsigned w) { return __builtin_bit_cast(float, w << 16); }
__device__ __forceinline__ float bfhi(unsigned w) { return __builtin_bit_cast(float, w & 0xffff0000u); }
template <int CTRL> __device__ __forceinline__ float dpp_mov(float v) { return __builtin_bit_cast(float, __builtin_amdgcn_update_dpp(0, __builtin_bit_cast(int, v), CTRL, 0xf, 0xf, true)); }
__device__ __forceinline__ float wave_sum(float v) {
    v += dpp_mov<0xB1>(v); v += dpp_mov<0x4E>(v); v += dpp_mov<0x141>(v); v += dpp_mov<0x140>(v);
    const int vi = __builtin_bit_cast(int, v);
    return (__builtin_bit_cast(float, __builtin_amdgcn_readlane(vi, 0)) + __builtin_bit_cast(float, __builtin_amdgcn_readlane(vi, 16))) + (__builtin_bit_cast(float, __builtin_amdgcn_readlane(vi, 32)) + __builtin_bit_cast(float, __builtin_amdgcn_readlane(vi, 48)));
}
__device__ __forceinline__ float fast_sigmoid(float x) { return __builtin_amdgcn_rcpf(1.f + __expf(-x)); }

namespace pg8 {
#define PG8_LAS __attribute__((address_space(3)))
typedef unsigned short bf16_t;
typedef unsigned u32x4 __attribute__((ext_vector_type(4)));
constexpr int BM = 256, BK = 64, HALF = 128, HTB = HALF * BK * 2  , STAGE_BYTES = 8 * HTB, NXCD = 8, WGM = 8;

__host__ __device__ __forceinline__ int lds_byte(int r, int c) { const int st = (r >> 4) * 2 + (c >> 5), rr = r & 15, cc = c & 31, ob = rr * 64 + cc * 2; return st * 1024 + (ob ^ (((ob >> 9) & 1) << 5)); }
__host__ __device__ __forceinline__ void stage_rc(int b, int& R, int& C) { const int st = b / 1024, sb = b % 1024, swz = sb ^ (((sb >> 9) & 1) << 5); R = (st >> 1) * 16 + swz / 64; C = (st & 1) * 32 + (swz % 64) / 2; }
__host__ __device__ __forceinline__ int perm32(int rho) { const int n = rho >> 4, i = rho & 15; return 8 * (i >> 2) + 4 * n + (i & 3); }

struct Unit { int pm, pn, x, gs, keep; const char* a; const char* b; };

__device__ __forceinline__ void tile_of(int L, int nM, int nN, int& pm, int& pn) {
    const int nwg = nM * nN; int wgid = L; { const int q = nwg / NXCD, r = nwg % NXCD, xcd = wgid % NXCD, off = wgid / NXCD; wgid = (xcd < r ? xcd * (q + 1) : r * (q + 1) + (xcd - r) * q) + off; }
    const int nig = WGM * nN, gid = wgid / nig, fm = gid * WGM, gsz = (nM - fm) < WGM ? (nM - fm) : WGM;
    pm = fm + ((wgid % nig) % gsz); pn = (wgid % nig) / gsz;
}
__device__ __forceinline__ unsigned cvt_pk_bf16(float lo, float hi) { unsigned r; asm volatile("v_cvt_pk_bf16_f32 %0, %1, %2" : "=v"(r) : "v"(lo), "v"(hi)); return r; }

template <class Epi, class Sched, bool ALIGN_EPI, bool SP2, bool GATHER, bool FP8 = false>
__device__ __forceinline__ void gemm_phase(PG8_LAS unsigned char* lds, const int KB, const Sched& S, const Epi& E, const int PA_ = 0) {
    int tid_ = threadIdx.x; asm volatile("" : "+v"(tid_));
    const int tid = tid_, wid = __builtin_amdgcn_readfirstlane(tid >> 6), lane = tid & 63, wr = wid >> 2, wc = wid & 3, fr = lane & 15, fq = lane >> 4;
    const int nt = KB / (BK * 2);
    unsigned voffA, voffB; int RA0, CA;
    { int R, C; stage_rc(tid * 16, R, C); const int Rb = (R & ~31) + perm32(R & 31); voffA = (unsigned)(R * (PA_ ? PA_ : KB) + C * 2); voffB = (unsigned)(Rb * KB + C * 2); RA0 = R; CA = C; }
    const size_t qstep = (size_t)64 * KB, qstepA = (size_t)64 * (PA_ ? PA_ : KB), hstepA = (size_t)HALF * (PA_ ? PA_ : KB);
    const size_t kstep = (size_t)(BK * 2);
    const size_t hstep = (size_t)HALF * KB;
    const unsigned ldsw = (unsigned)wid * 1024u;
    const int aoff = lds_byte(wr * 64 + fr, fq * 8), boff = lds_byte(wc * 32 + fr, fq * 8);
#define PG8_SA(b, h) (((b) * 2 + (h)) * HTB)
#define PG8_SB(b, h) ((4 + (b) * 2 + (h)) * HTB)
#define PG8_STAGE(bufoff, gbase, voff) do { _Pragma("unroll") for (int _i = 0; _i < 2; ++_i) \
        __builtin_amdgcn_global_load_lds((const unsigned*)((const char*)(gbase) + _i * qstep + (voff)), (PG8_LAS unsigned*)(lds + (bufoff) + ldsw + _i * 8192), 16, 0, 0); } while (0)
#define PG8_STAGE_PA(bufoff, gbase, voff) do { _Pragma("unroll") for (int _i = 0; _i < 2; ++_i) \
        __builtin_amdgcn_global_load_lds((const unsigned*)((const char*)(gbase) + _i * qstepA + (voff)), (PG8_LAS unsigned*)(lds + (bufoff) + ldsw + _i * 8192), 16, 0, 0); } while (0)
#define PG8_STAGE_G(bufoff, gbase, voff) do { _Pragma("unroll") for (int _i = 0; _i < 2; ++_i) \
        __builtin_amdgcn_global_load_lds((const unsigned*)((const char*)(gbase) + (voff)[_i]), (PG8_LAS unsigned*)(lds + (bufoff) + ldsw + _i * 8192), 16, 0, 0); } while (0)
#define PG8_LDA(dst, b, h) do { _Pragma("unroll") for (int m = 0; m < 4; ++m) _Pragma("unroll") for (int k = 0; k < 2; ++k) dst[m][k] = *(const PG8_LAS bf16x8*)(lds + PG8_SA(b, h) + aoff + m * 2048 + k * 1024); } while (0)
#define PG8_LDB(dst, b, h) do { _Pragma("unroll") for (int n = 0; n < 2; ++n) _Pragma("unroll") for (int k = 0; k < 2; ++k) dst[n][k] = *(const PG8_LAS bf16x8*)(lds + PG8_SB(b, h) + boff + n * 2048 + k * 1024); } while (0)
#define PG8_MMA(ai, bj, At, Bt) do { __builtin_amdgcn_s_setprio(1); _Pragma("unroll") for (int m = 0; m < 4; ++m) _Pragma("unroll") for (int n = 0; n < 2; ++n) { \
        if constexpr (FP8) { typedef int v8i_ __attribute__((ext_vector_type(8))); typedef int v4i_ __attribute__((ext_vector_type(4))); \
            const v4i_ b0_ = __builtin_bit_cast(v4i_, Bt[n][0]), b1_ = __builtin_bit_cast(v4i_, Bt[n][1]), a0_ = __builtin_bit_cast(v4i_, At[m][0]), a1_ = __builtin_bit_cast(v4i_, At[m][1]); \
            const v8i_ bb_ = {b0_[0], b0_[1], b0_[2], b0_[3], b1_[0], b1_[1], b1_[2], b1_[3]}, aa_ = {a0_[0], a0_[1], a0_[2], a0_[3], a1_[0], a1_[1], a1_[2], a1_[3]}; \
            acc[ai][bj][m][n] = __builtin_amdgcn_mfma_scale_f32_16x16x128_f8f6f4(bb_, aa_, acc[ai][bj][m][n], 0, 0, 0, 0x7f7f7f7f, 0, 0x7f7f7f7f); } \
        else { _Pragma("unroll") for (int k = 0; k < 2; ++k) acc[ai][bj][m][n] = __builtin_amdgcn_mfma_f32_16x16x32_bf16(Bt[n][k], At[m][k], acc[ai][bj][m][n], 0, 0, 0); } } \
        if constexpr (FP8) { _Pragma("unroll") for (int m = 0; m < 4; ++m) asm volatile("" : "+v"(acc[ai][bj][m][0]), "+v"(acc[ai][bj][m][1])); }     \
        __builtin_amdgcn_s_setprio(0); } while (0)
#define PG8_WAIT_V(n) asm volatile("s_waitcnt vmcnt(" #n ")" ::: "memory")
#define PG8_WAIT_L(n) asm volatile("s_waitcnt lgkmcnt(" #n ")" ::: "memory")
#define PG8_BAR __builtin_amdgcn_s_barrier()
#define PG8_SCHED __builtin_amdgcn_sched_barrier(0)
    Unit cur, nxt; int ui = 0;
    if (!S.next(0, cur)) return;
    f32x4 acc[2][2][4][2];
#pragma unroll
    for (int a = 0; a < 2; ++a)
#pragma unroll
        for (int b = 0; b < 2; ++b)
#pragma unroll
            for (int m = 0; m < 4; ++m)
#pragma unroll
                for (int n = 0; n < 2; ++n) acc[a][b][m][n] = (f32x4){0.f, 0.f, 0.f, 0.f};
    bf16x8 At[4][2], B0[2][2], B1[2][2];
    unsigned crw[2], nrw[2]; const unsigned cc = (unsigned)(CA * 2);
#pragma unroll
    for (int i = 0; i < 2; ++i) {
        if constexpr (GATHER) { crw[i] = (unsigned)S.row(cur.gs + RA0 + 64 * i) | ((unsigned)S.row(cur.gs + HALF + RA0 + 64 * i) << 16); }
        else { crw[i] = 0u; }
        nrw[i] = crw[i]; }
    asm volatile("" : "+v"(crw[0]), "+v"(crw[1]));
#define PG8_STAGE_A(bufoff, gbase, rws, h) do { if constexpr (GATHER) { unsigned vo_[2]; _Pragma("unroll") for (int _j = 0; _j < 2; ++_j) vo_[_j] = (((rws)[_j] >> (16 * (h))) & 0xffffu) * (unsigned)KB + cc; PG8_STAGE_G(bufoff, gbase, vo_); } \
        else { PG8_STAGE_PA(bufoff, (gbase) + (h) * hstepA, voffA); } } while (0)
    const char* cA = cur.a; const char* cB = cur.b;
    S.a_ready(cur);
    if constexpr (SP2) {
        PG8_STAGE(PG8_SB(0, 0), cB, voffB); PG8_STAGE(PG8_SB(0, 1), cB + hstep, voffB); PG8_STAGE_A(PG8_SA(0, 0), cA, crw, 0); PG8_STAGE_A(PG8_SA(0, 1), cA, crw, 1);
        if (wr == 1) PG8_BAR;
        PG8_WAIT_V(2); PG8_BAR;
        PG8_STAGE(PG8_SB(1, 0), cB + kstep, voffB); PG8_STAGE_A(PG8_SA(1, 0), cA + kstep, crw, 0); PG8_STAGE(PG8_SB(1, 1), cB + hstep + kstep, voffB);
        PG8_WAIT_V(6); PG8_BAR;
    } else {
        PG8_STAGE(PG8_SB(0, 0), cB, voffB); PG8_STAGE_A(PG8_SA(0, 0), cA, crw, 0); PG8_STAGE(PG8_SB(0, 1), cB + hstep, voffB); PG8_STAGE_A(PG8_SA(0, 1), cA, crw, 1);
        if (wr == 1) PG8_BAR;
        PG8_WAIT_V(4); PG8_BAR;
        PG8_STAGE(PG8_SB(1, 0), cB + kstep, voffB); PG8_STAGE_A(PG8_SA(1, 0), cA + kstep, crw, 0); PG8_STAGE(PG8_SB(1, 1), cB + hstep + kstep, voffB);
        PG8_WAIT_V(6); PG8_BAR;
    }
    for (;;) {
        const bool has_next = S.next(ui + 1, nxt);
        const char* nA = has_next ? nxt.a : cA; const char* nB = has_next ? nxt.b : cB;
        if constexpr (GATHER) {
            if (has_next) {
#pragma unroll
                for (int i = 0; i < 2; ++i) { nrw[i] = (unsigned)S.row(nxt.gs + RA0 + 64 * i) | ((unsigned)S.row(nxt.gs + HALF + RA0 + 64 * i) << 16); }
                asm volatile("" : "+v"(nrw[0]), "+v"(nrw[1]));
            } else {
#pragma unroll
                for (int i = 0; i < 2; ++i) nrw[i] = crw[i];
            }
        }
        for (int t = 0; t < nt; t += 2) {
            const bool last = (t == nt - 2);
            const char* a1 = cA + (size_t)(t + 1) * kstep;
            const char* a2 = last ? nA : cA + (size_t)(t + 2) * kstep; const char* b2 = last ? nB : cB + (size_t)(t + 2) * kstep;
            const char* a3 = a2 + kstep; const char* b3 = b2 + kstep;
            unsigned srw[2];
#pragma unroll
            for (int i = 0; i < 2; ++i) srw[i] = last ? nrw[i] : crw[i];
            if (last && has_next) S.a_ready(nxt);
            if constexpr (SP2) {
            PG8_LDB(B0, 0, 0); PG8_LDB(B1, 0, 1); PG8_SCHED; PG8_LDA(At, 0, 0); PG8_STAGE_A(PG8_SA(1, 1), a1, crw, 1);
            PG8_WAIT_V(8); PG8_WAIT_L(0); PG8_BAR; PG8_MMA(0, 0, At, B0); PG8_MMA(0, 1, At, B1); PG8_BAR; PG8_SCHED;
            PG8_LDA(At, 0, 1); PG8_STAGE(PG8_SB(0, 0), b2, voffB); PG8_STAGE(PG8_SB(0, 1), b2 + hstep, voffB); PG8_STAGE_A(PG8_SA(0, 0), a2, srw, 0);
            PG8_WAIT_V(8); PG8_WAIT_L(0); PG8_BAR; PG8_MMA(1, 0, At, B0); PG8_MMA(1, 1, At, B1); PG8_BAR; PG8_SCHED;
            PG8_LDB(B0, 1, 0); PG8_LDB(B1, 1, 1); PG8_SCHED; PG8_LDA(At, 1, 0); PG8_STAGE_A(PG8_SA(0, 1), a2, srw, 1);
            PG8_WAIT_V(8); PG8_WAIT_L(0); PG8_BAR; PG8_MMA(0, 0, At, B0); PG8_MMA(0, 1, At, B1); PG8_BAR; PG8_SCHED;
            PG8_LDA(At, 1, 1); PG8_STAGE(PG8_SB(1, 0), b3, voffB); PG8_STAGE(PG8_SB(1, 1), b3 + hstep, voffB); PG8_STAGE_A(PG8_SA(1, 0), a3, srw, 0);
            PG8_WAIT_V(8); PG8_WAIT_L(0); PG8_BAR; PG8_MMA(1, 0, At, B0); PG8_MMA(1, 1, At, B1); PG8_BAR; PG8_SCHED;
            } else {
            PG8_LDB(B0, 0, 0); PG8_SCHED; PG8_LDA(At, 0, 0); PG8_STAGE_A(PG8_SA(1, 1), a1, crw, 1);
            PG8_WAIT_L(8); PG8_BAR; PG8_WAIT_L(0); PG8_MMA(0, 0, At, B0); PG8_BAR; PG8_SCHED;
            PG8_LDB(B1, 0, 1); PG8_STAGE(PG8_SB(0, 0), b2, voffB);
            PG8_BAR; PG8_WAIT_L(0); PG8_MMA(0, 1, At, B1); PG8_BAR;
            PG8_LDA(At, 0, 1); PG8_STAGE_A(PG8_SA(0, 0), a2, srw, 0);
            PG8_BAR; PG8_WAIT_L(0); PG8_MMA(1, 0, At, B0); PG8_BAR; PG8_SCHED;
            PG8_STAGE(PG8_SB(0, 1), b2 + hstep, voffB);
            PG8_WAIT_V(6); PG8_BAR; PG8_MMA(1, 1, At, B1); PG8_BAR;
            PG8_LDB(B0, 1, 0); PG8_SCHED; PG8_LDA(At, 1, 0); PG8_STAGE_A(PG8_SA(0, 1), a2, srw, 1);
            PG8_WAIT_L(8); PG8_BAR; PG8_WAIT_L(0); PG8_MMA(0, 0, At, B0); PG8_BAR; PG8_SCHED;
            PG8_LDB(B1, 1, 1); PG8_STAGE(PG8_SB(1, 0), b3, voffB);
            PG8_BAR; PG8_WAIT_L(0); PG8_MMA(0, 1, At, B1); PG8_BAR;
            PG8_LDA(At, 1, 1); PG8_STAGE_A(PG8_SA(1, 0), a3, srw, 0);
            PG8_BAR; PG8_WAIT_L(0); PG8_MMA(1, 0, At, B0); PG8_BAR; PG8_SCHED;
            PG8_STAGE(PG8_SB(1, 1), b3 + hstep, voffB);
            PG8_WAIT_V(6); PG8_BAR; PG8_MMA(1, 1, At, B1); PG8_BAR;
            }
        }
        if constexpr (ALIGN_EPI) { if (wr == 0) PG8_BAR; }
        E(acc, cur, wr, wc, fr, fq); S.done(cur);
        if (!has_next) break;
        if (!cur.keep) {
#pragma unroll
        for (int a = 0; a < 2; ++a)
#pragma unroll
            for (int b = 0; b < 2; ++b)
#pragma unroll
                for (int m = 0; m < 4; ++m)
#pragma unroll
                    for (int n = 0; n < 2; ++n) acc[a][b][m][n] = (f32x4){0.f, 0.f, 0.f, 0.f};
        }
        cur = nxt; cA = nA; cB = nB; ++ui;
#pragma unroll
        for (int i = 0; i < 2; ++i) crw[i] = nrw[i];
        if constexpr (ALIGN_EPI) { if (wr == 1) PG8_BAR; }
    }
    PG8_WAIT_V(0);
    if constexpr (!ALIGN_EPI) { if (wr == 0) PG8_BAR; }
    PG8_BAR;
#undef PG8_SA
#undef PG8_SB
#undef PG8_STAGE
#undef PG8_STAGE_A
#undef PG8_STAGE_G
#undef PG8_STAGE_PA
#undef PG8_LDA
#undef PG8_LDB
#undef PG8_MMA
#undef PG8_WAIT_V
#undef PG8_WAIT_L
#undef PG8_BAR
#undef PG8_SCHED
}
}
namespace attn_body {
using bf16=__hip_bfloat16;
using bf16x8=__attribute__((ext_vector_type(8)))short;
using s16x4=__attribute__((ext_vector_type(4)))short;
using f32x16=__attribute__((ext_vector_type(16)))float;
using u32x4=__attribute__((ext_vector_type(4)))unsigned;
constexpr int SEQ=4096,D=64,DM=512;
constexpr int NW=8,QBLK=32,QB=QBLK*NW,KVBLK=64,NQB=SEQ/QB;
constexpr int ATTN_PITCH=DM, ATTN_UNIT_ROWS=QB;
__device__ __forceinline__ int crow(int r,int hi){return (r&3)+8*(r>>2)+4*hi;}
#define SBAR() __builtin_amdgcn_sched_barrier(0)
__device__ __forceinline__ void cmask(f32x16&p0,f32x16&p1,int jb,int qrel,int hi){
  const float NEG=-INFINITY; int kb=64*jb+4*hi;
  #pragma unroll
  for(int r=0;r<16;++r){int kv=kb+(r&3)+8*(r>>2); if(kv>qrel)p0[r]=NEG; if(kv+32>qrel)p1[r]=NEG;}
}

constexpr int NSLOT=3, SLOTB=8192;
constexpr int LDS_K=0, LDS_V=NSLOT*SLOTB, LDS_WS=3*NSLOT*SLOTB, LDS_OST=LDS_WS+NW*64*4, LDS_BYTES=LDS_OST+NW*4096;
__device__ __forceinline__ void glds16(const void*sbase,unsigned voff,unsigned lds_dst){unsigned keep;
  asm volatile("s_mov_b32 %0, m0\n\ts_mov_b32 m0, %3\n\ts_nop 0\n\tglobal_load_lds_dwordx4 %1, %2\n\ts_mov_b32 m0, %0":"=&s"(keep):"v"(voff),"s"(sbase),"s"(lds_dst):"memory");}
__device__ __forceinline__ float max3f(float a,float b,float c){float r;asm("v_max3_f32 %0, %1, %2, %3":"=v"(r):"v"(a),"v"(b),"v"(c));return r;}
__device__ __forceinline__ float max2f(float a,float b){float r;asm("v_max_f32_e32 %0, %1, %2":"=v"(r):"v"(a),"v"(b));return r;}
__device__ __forceinline__ float fadd_s(float a,float b){float r;asm("v_add_f32_e32 %0, %1, %2":"=v"(r):"v"(a),"v"(b));return r;}
__device__ __forceinline__ float fsub_s(float a,float b){float r;asm("v_sub_f32_e32 %0, %1, %2":"=v"(r):"v"(a),"v"(b));return r;}
typedef float f32x2_t __attribute__((ext_vector_type(2))); typedef __bf16 bf16x2_t __attribute__((ext_vector_type(2)));
__device__ __forceinline__ unsigned cvtpk_s(float lo,float hi){f32x2_t v={lo,hi};bf16x2_t b=__builtin_convertvector(v,bf16x2_t);return __builtin_bit_cast(unsigned,b);}
#define WAIT_BAR(N) asm volatile("s_waitcnt vmcnt(" #N ") lgkmcnt(0)\n\ts_barrier":::"memory")

__device__ __forceinline__ void qkt(f32x16&p0,f32x16&p1,const char*Kslot,const bf16x8*qr,const f32x16&negm,int r32,int hi){
  const char*kb=Kslot+hi*1024+r32*16;
  #pragma unroll
  for(int d0=0;d0<4;++d0){
    const bf16x8 b0=*reinterpret_cast<const bf16x8*>(kb+d0*2048);
    const bf16x8 b1=*reinterpret_cast<const bf16x8*>(kb+d0*2048+512);
    if(d0==0){p0=__builtin_amdgcn_mfma_f32_32x32x16_bf16(b0,qr[0],negm,0,0,0);p1=__builtin_amdgcn_mfma_f32_32x32x16_bf16(b1,qr[0],negm,0,0,0);}
    else{p0=__builtin_amdgcn_mfma_f32_32x32x16_bf16(b0,qr[d0],p0,0,0,0);p1=__builtin_amdgcn_mfma_f32_32x32x16_bf16(b1,qr[d0],p1,0,0,0);}}
}
typedef __attribute__((address_space(3))) const char* lds_cptr;
typedef short v4i16_t __attribute__((ext_vector_type(4)));
__device__ __forceinline__ void kload8(bf16x8*kf,lds_cptr kp){
  kf[0]=*(const __attribute__((address_space(3))) bf16x8*)(kp);      kf[1]=*(const __attribute__((address_space(3))) bf16x8*)(kp+512);
  kf[2]=*(const __attribute__((address_space(3))) bf16x8*)(kp+2048); kf[3]=*(const __attribute__((address_space(3))) bf16x8*)(kp+2560);
  kf[4]=*(const __attribute__((address_space(3))) bf16x8*)(kp+4096); kf[5]=*(const __attribute__((address_space(3))) bf16x8*)(kp+4608);
  kf[6]=*(const __attribute__((address_space(3))) bf16x8*)(kp+6144); kf[7]=*(const __attribute__((address_space(3))) bf16x8*)(kp+6656);
}
__device__ __forceinline__ void kload2(bf16x8*kf,lds_cptr kp,int j){ kf[2*j]=*(const __attribute__((address_space(3))) bf16x8*)(kp+j*2048); kf[2*j+1]=*(const __attribute__((address_space(3))) bf16x8*)(kp+j*2048+512); }
__device__ __forceinline__ s16x4 vtr(lds_cptr p){ return __builtin_bit_cast(s16x4,__builtin_amdgcn_ds_read_tr16_b64_v4i16((__attribute__((address_space(3))) v4i16_t*)p)); }
__device__ __forceinline__ float rowmax(const f32x16&p0,const f32x16&p1){
  float a=max3f(p0[0],p0[1],p1[0]),b=max3f(p0[2],p0[3],p1[1]);a=max3f(a,p1[2],p1[3]);
  #pragma unroll
  for(int r=4;r<16;r+=4){a=max3f(a,p0[r],p0[r+1]);b=max3f(b,p0[r+2],p0[r+3]);a=max3f(a,p1[r],p1[r+1]);b=max3f(b,p1[r+2],p1[r+3]);}
  const float m=max2f(a,b);
  auto rr=__builtin_amdgcn_permlane32_swap(__float_as_uint(m),__float_as_uint(m),false,false);
  return max2f(__uint_as_float(rr[0]),__uint_as_float(rr[1]));
}
__device__ __forceinline__ void pv(f32x16*o,int vb,bf16x8 pa0,bf16x8 pa1,bf16x8 pa2,bf16x8 pa3){
  #pragma unroll
  for(int d0=0;d0<4;++d0){s16x4 lo[4],hi[4];
    #pragma unroll
    for(int ks=0;ks<4;++ks){
      asm volatile("ds_read_b64_tr_b16 %0,%1 offset:%c2":"=&v"(lo[ks]):"v"(vb),"i"(d0*4096+ks*1024):"memory");
      asm volatile("ds_read_b64_tr_b16 %0,%1 offset:%c2":"=&v"(hi[ks]):"v"(vb),"i"(d0*4096+ks*1024+512):"memory");}
    asm volatile("s_waitcnt lgkmcnt(0)":::"memory");SBAR();
    #define PK(k) (bf16x8){lo[k][0],lo[k][1],lo[k][2],lo[k][3],hi[k][0],hi[k][1],hi[k][2],hi[k][3]}
    o[d0]=__builtin_amdgcn_mfma_f32_32x32x16_bf16(pa0,PK(0),o[d0],0,0,0);
    o[d0]=__builtin_amdgcn_mfma_f32_32x32x16_bf16(pa1,PK(1),o[d0],0,0,0);
    o[d0]=__builtin_amdgcn_mfma_f32_32x32x16_bf16(pa2,PK(2),o[d0],0,0,0);
    o[d0]=__builtin_amdgcn_mfma_f32_32x32x16_bf16(pa3,PK(3),o[d0],0,0,0);
    #undef PK
  }
}

#ifndef ATTN_STORE16
#define ATTN_STORE16(p,v) (*(u32x4*)(p)=(v))
#endif
template<int THRL> __device__ __forceinline__ void attn_unit(int b,int h,int hv,int qb,const bf16*Q,const bf16*__restrict__ K,const bf16*__restrict__ V,bf16*O,char*shm){
  int tid_=threadIdx.x; asm volatile("":"+v"(tid_)); const int tid=tid_,lane=tid&63,r32=lane&31,hi=lane>>5; const int wid=__builtin_amdgcn_readfirstlane(tid>>6);
  const long rowbase=(long)b*SEQ; const int q0=qb*QB;
  const bf16*Qw=Q+(rowbase+q0+wid*QBLK)*DM+h*D;
  const bf16*Kh=K+rowbase*DM+h*D,*Vh=V+rowbase*DM+hv*2*D;
  const unsigned lds0=(unsigned)(uintptr_t)shm;
  float*wsf=(float*)(shm+LDS_WS)+wid*64;
  const unsigned koff=(unsigned)((lane*DM+wid*8)*2);
  const unsigned voff=(unsigned)(((16*(wid&3)+(lane>>2))*DM+(wid>>2)*32+(lane&3)*8)*2);
  const unsigned kdst=lds0+LDS_K+wid*1024, vdst=lds0+LDS_V+wid*1024;
  #define DMA_K(t,slot) glds16(Kh+(long)(t)*KVBLK*DM,koff,(unsigned)__builtin_amdgcn_readfirstlane(kdst+(slot)))
  #define DMA_V(t,slot) do{ glds16(Vh+(long)(t)*KVBLK*DM,voff,(unsigned)__builtin_amdgcn_readfirstlane(vdst+2*(slot))); glds16(Vh+(long)(t)*KVBLK*DM+64,voff,(unsigned)__builtin_amdgcn_readfirstlane(vdst+2*(slot)+8192)); }while(0)
  const int vb0=(int)(lds0+LDS_V)+((lane>>4)&1)*32+(lane&3)*8+(4*hi+((lane&15)>>2))*64;
  const char*Kbase=shm+LDS_K; bf16x8 kf[8];
  const lds_cptr shm3=(lds_cptr)shm; const lds_cptr kp0=shm3+LDS_K+hi*1024+r32*16; const lds_cptr vp0=shm3+LDS_V+((lane>>4)&1)*32+(lane&3)*8+(4*hi+((lane&15)>>2))*64;
  const int NT=(q0+QB)/KVBLK;
  DMA_K(0,0);DMA_V(0,0);DMA_K(1,SLOTB);
  bf16x8 qr[4];
  #pragma unroll
  for(int d0=0;d0<4;++d0)qr[d0]=*reinterpret_cast<const bf16x8*>(&Qw[(long)r32*DM+d0*16+hi*8]);
  float mhat=0.f,l_reg=0.f;f32x16 o[4];o[0]=f32x16{};o[1]=f32x16{};o[2]=f32x16{};o[3]=f32x16{};f32x16 negm=f32x16{};asm volatile("":"+v"(negm));
  const int qrel=wid*QBLK+r32;
  #define CMASK(P0,P1,t) do{int jb_=(t)-(NT-4); if(jb_>=0)cmask(P0,P1,jb_,qrel,hi);}while(0)
  bool resc=false;
  #define START(P0,P1) do{ const float rm=rowmax(P0,P1); resc=false; \
    { const float dl=rm; mhat=fadd_s(mhat,dl); \
      _Pragma("unroll") for(int r=0;r<16;++r){P0[r]=fsub_s(P0[r],dl);P1[r]=fsub_s(P1[r],dl);} \
      _Pragma("unroll") for(int r=0;r<16;++r)negm[r]=-mhat; asm volatile("":"+v"(negm)); } \
    _Pragma("unroll") for(int r=0;r<16;++r)P0[r]=__builtin_amdgcn_exp2f(P0[r]); }while(0)
  #define RESC() do{ if(resc){ asm volatile("s_waitcnt lgkmcnt(0)":::"memory"); \
      _Pragma("unroll") for(int d_=0;d_<4;++d_) _Pragma("unroll") for(int r=0;r<16;++r)o[d_][r]*=wsf[crow(r,hi)]; } }while(0)
  f32x16 pA0,pA1,pB0,pB1;
  int sl_prev=0,sl_cur=0,sl_next=SLOTB;
  #define ROT() do{sl_prev=sl_cur;sl_cur=sl_next;sl_next=(sl_next==(NSLOT-1)*SLOTB)?0:sl_next+SLOTB;}while(0)
  DMA_K(2,2*SLOTB);
  WAIT_BAR(3);
  qkt(pA0,pA1,Kbase,qr,negm,r32,hi);asm volatile("s_nop 15\n\ts_nop 7":"+v"(pA0),"+v"(pA1));CMASK(pA0,pA1,0);
  START(pA0,pA1);
  _Pragma("unroll") for(int r=0;r<16;++r)pA1[r]=__builtin_amdgcn_exp2f(pA1[r]);
  WAIT_BAR(0);
  DMA_K(3,0);DMA_V(1,SLOTB);
  ROT();
  kload8(kf,kp0+sl_cur);
  WAIT_BAR(3);
  s16x4 vlo[8],vhi[8]; u32x4 pw0,pw1,pw2,pw3;
  #define PKW(P,B) cvtpk_s(P[B],P[B+1])
  #define PAF(k) __builtin_bit_cast(bf16x8,pw##k)
  #define VFR(i) (bf16x8){vlo[i][0],vlo[i][1],vlo[i][2],vlo[i][3],vhi[i][0],vhi[i][1],vhi[i][2],vhi[i][3]}
  #define PIN(x) asm volatile("":"+v"(x))
  #define MX3(a,b,c) __builtin_fmaxf(__builtin_fmaxf((a),(b)),(c))
  #define GAPA(MF,A0,A1,A2,A3,W0,W1,PW) do{ MF; sacc+=A0; sacc+=A1; sacc+=A2; sacc+=A3; PIN(sacc); W0; W1; PIN(PW); SBAR(); }while(0)
  #define EX(v) __builtin_amdgcn_exp2f(v)
  #define GAPB(MF,X,B,RD) do{ MF; RD; X[B]=EX(X[B]); X[B+1]=EX(X[B+1]); PIN(X); SBAR(); }while(0)
  #define VRDS(f,sl) do{ vlo[sl]=vtr(vp_+(((f)>>2)*4096+((f)&3)*1024)); vhi[sl]=vtr(vp_+(((f)>>2)*4096+((f)&3)*1024+512)); }while(0)
  #define NORD do{}while(0)
  #define KRD(G,j) do{ if(G){ kload2(kf,kp0+sl_next,j); SBAR(); } }while(0)
  #define STEP(C0,C1,P0,P1,t,GK,GV,GL) do{ SBAR(); \
    const lds_cptr vp_=vp0+2*sl_prev; \
    float sacc=(P0[0]+P0[1]); \
    GAPA(C0=__builtin_amdgcn_mfma_f32_32x32x16_bf16(kf[0],qr[0],negm,0,0,0), P0[2],P0[3],P0[4],P0[5],     pw0[0]=PKW(P0,0), pw0[1]=PKW(P0,2), pw0); \
    GAPA(C1=__builtin_amdgcn_mfma_f32_32x32x16_bf16(kf[1],qr[0],negm,0,0,0), P0[6],P0[7],P0[8],P0[9],     pw0[2]=PKW(P0,4), pw0[3]=PKW(P0,6), pw0); \
    GAPA(C0=__builtin_amdgcn_mfma_f32_32x32x16_bf16(kf[2],qr[1],C0,0,0,0),   P0[10],P0[11],P0[12],P0[13], pw1[0]=PKW(P0,8), pw1[1]=PKW(P0,10), pw1); \
    GAPA(C1=__builtin_amdgcn_mfma_f32_32x32x16_bf16(kf[3],qr[1],C1,0,0,0),   P0[14],P0[15],P1[0],P1[1],   pw1[2]=PKW(P0,12),pw1[3]=PKW(P0,14), pw1); \
    VRDS(0,0);  SBAR(); GAPA(C0=__builtin_amdgcn_mfma_f32_32x32x16_bf16(kf[4],qr[2],C0,0,0,0),   P1[2],P1[3],P1[4],P1[5],     pw2[0]=PKW(P1,0), pw2[1]=PKW(P1,2), pw2); \
    VRDS(4,1);  SBAR(); GAPA(C1=__builtin_amdgcn_mfma_f32_32x32x16_bf16(kf[5],qr[2],C1,0,0,0),   P1[6],P1[7],P1[8],P1[9],     pw2[2]=PKW(P1,4), pw2[3]=PKW(P1,6), pw2); \
    VRDS(8,2);  SBAR(); GAPA(C0=__builtin_amdgcn_mfma_f32_32x32x16_bf16(kf[6],qr[3],C0,0,0,0),   P1[10],P1[11],P1[12],P1[13], pw3[0]=PKW(P1,8), pw3[1]=PKW(P1,10), pw3); \
    VRDS(12,3); SBAR(); GAPA(C1=__builtin_amdgcn_mfma_f32_32x32x16_bf16(kf[7],qr[3],C1,0,0,0),   P1[14],P1[15],0.f,0.f,       pw3[2]=PKW(P1,12),pw3[3]=PKW(P1,14), pw3); \
    l_reg+=sacc; \
    if(GK){DMA_K((t)+3,sl_cur);} if(GV){DMA_V((t)+1,sl_next);} \
    CMASK(C0,C1,t); \
    { float a=MX3(C0[0],C0[1],C1[0]),b=MX3(C0[2],C0[3],C1[1]); a=MX3(a,C1[2],C1[3]); \
      _Pragma("unroll") for(int r=4;r<16;r+=4){a=MX3(a,C0[r],C0[r+1]);b=MX3(b,C0[r+2],C0[r+3]);a=MX3(a,C1[r],C1[r+1]);b=MX3(b,C1[r+2],C1[r+3]);} \
      float rm=__builtin_fmaxf(a,b); { auto rr=__builtin_amdgcn_permlane32_swap(__float_as_uint(rm),__float_as_uint(rm),false,false); rm=__builtin_fmaxf(__uint_as_float(rr[0]),__uint_as_float(rr[1])); } \
      resc=false; \
      if(__builtin_expect(__any(rm>(float)THRL),0)){ const float dl=__builtin_fmaxf(rm,0.f); mhat+=dl; \
        _Pragma("unroll") for(int r=0;r<16;++r){C0[r]-=dl;C1[r]-=dl;} \
        _Pragma("unroll") for(int r=0;r<16;++r)negm[r]=-mhat; asm volatile("":"+v"(negm)); \
        const float f=__builtin_amdgcn_exp2f(-dl); l_reg*=f; if(hi==0)wsf[r32]=f; resc=true; } } \
    SBAR(); \
    GAPB(o[0]=__builtin_amdgcn_mfma_f32_32x32x16_bf16(PAF(0),VFR(0),o[0],0,0,0), C0,0,  VRDS(1,4)); \
    GAPB(o[1]=__builtin_amdgcn_mfma_f32_32x32x16_bf16(PAF(0),VFR(1),o[1],0,0,0), C0,2,  VRDS(5,5)); \
    GAPB(o[2]=__builtin_amdgcn_mfma_f32_32x32x16_bf16(PAF(0),VFR(2),o[2],0,0,0), C0,4,  VRDS(9,6)); \
    GAPB(o[3]=__builtin_amdgcn_mfma_f32_32x32x16_bf16(PAF(0),VFR(3),o[3],0,0,0), C0,6,  VRDS(13,7)); \
    KRD(GL,0); GAPB(o[0]=__builtin_amdgcn_mfma_f32_32x32x16_bf16(PAF(1),VFR(4),o[0],0,0,0), C0,8,  VRDS(2,0)); \
    GAPB(o[1]=__builtin_amdgcn_mfma_f32_32x32x16_bf16(PAF(1),VFR(5),o[1],0,0,0), C0,10, VRDS(6,1)); \
    KRD(GL,1); GAPB(o[2]=__builtin_amdgcn_mfma_f32_32x32x16_bf16(PAF(1),VFR(6),o[2],0,0,0), C0,12, VRDS(10,2)); \
    GAPB(o[3]=__builtin_amdgcn_mfma_f32_32x32x16_bf16(PAF(1),VFR(7),o[3],0,0,0), C0,14, VRDS(14,3)); \
    KRD(GL,2); GAPB(o[0]=__builtin_amdgcn_mfma_f32_32x32x16_bf16(PAF(2),VFR(0),o[0],0,0,0), C1,0,  VRDS(3,4)); \
    GAPB(o[1]=__builtin_amdgcn_mfma_f32_32x32x16_bf16(PAF(2),VFR(1),o[1],0,0,0), C1,2,  VRDS(7,5)); \
    KRD(GL,3); GAPB(o[2]=__builtin_amdgcn_mfma_f32_32x32x16_bf16(PAF(2),VFR(2),o[2],0,0,0), C1,4,  VRDS(11,6)); \
    GAPB(o[3]=__builtin_amdgcn_mfma_f32_32x32x16_bf16(PAF(2),VFR(3),o[3],0,0,0), C1,6,  VRDS(15,7)); \
    GAPB(o[0]=__builtin_amdgcn_mfma_f32_32x32x16_bf16(PAF(3),VFR(4),o[0],0,0,0), C1,8,  NORD); \
    GAPB(o[1]=__builtin_amdgcn_mfma_f32_32x32x16_bf16(PAF(3),VFR(5),o[1],0,0,0), C1,10, NORD); \
    GAPB(o[2]=__builtin_amdgcn_mfma_f32_32x32x16_bf16(PAF(3),VFR(6),o[2],0,0,0), C1,12, NORD); \
    GAPB(o[3]=__builtin_amdgcn_mfma_f32_32x32x16_bf16(PAF(3),VFR(7),o[3],0,0,0), C1,14, NORD); \
    }while(0)
  int t=1;
  #undef CMASK
  #define CMASK(P0,P1,t) do{}while(0)
  for(;t+5<NT;t+=2){
    STEP(pB0,pB1,pA0,pA1,t,true,true,true);     WAIT_BAR(3); RESC(); ROT();
    STEP(pA0,pA1,pB0,pB1,t+1,true,true,true);   WAIT_BAR(3); RESC(); ROT();
  }
  #undef CMASK
  #define CMASK(P0,P1,t) do{int jb_=(t)-(NT-4); if(jb_>=0)cmask(P0,P1,jb_,qrel,hi);}while(0)
  #define ENDW(tt) do{ if((tt)+3<NT){WAIT_BAR(3);} else if((tt)+2<NT){WAIT_BAR(2);} else {WAIT_BAR(0);} }while(0)
  for(;t+1<NT;t+=2){
    STEP(pB0,pB1,pA0,pA1,t,(t+3<NT),(t+1<NT),(t+1<NT));       ENDW(t);   RESC(); ROT();
    STEP(pA0,pA1,pB0,pB1,t+1,(t+4<NT),(t+2<NT),(t+2<NT));     ENDW(t+1); RESC(); ROT();
  }
  STEP(pB0,pB1,pA0,pA1,NT-1,false,false,false); RESC();
  { float sacc=pB0[0]+pB0[1]; _Pragma("unroll") for(int r=2;r<16;++r)sacc+=pB0[r]; _Pragma("unroll") for(int r=0;r<16;++r)sacc+=pB1[r]; l_reg+=sacc;
    pw0=(u32x4){PKW(pB0,0),PKW(pB0,2),PKW(pB0,4),PKW(pB0,6)};pw1=(u32x4){PKW(pB0,8),PKW(pB0,10),PKW(pB0,12),PKW(pB0,14)};pw2=(u32x4){PKW(pB1,0),PKW(pB1,2),PKW(pB1,4),PKW(pB1,6)};pw3=(u32x4){PKW(pB1,8),PKW(pB1,10),PKW(pB1,12),PKW(pB1,14)};
    SBAR(); pv(o,vb0+2*sl_cur,PAF(0),PAF(1),PAF(2),PAF(3)); }
  #undef PKW
  #undef PAF
  #undef VFR
  #undef PIN
  #undef MX3
  #undef GAPA
  #undef GAPB
  #undef EX
  #undef VRDS
  #undef NORD
  #undef KRD
  #undef STEP
  #undef ENDW
  {auto rr=__builtin_amdgcn_permlane32_swap(__float_as_uint(l_reg),__float_as_uint(l_reg),false,false);l_reg=__uint_as_float(rr[0])+__uint_as_float(rr[1]);}
  if(hi==0)wsf[32+r32]=l_reg;asm volatile("s_waitcnt lgkmcnt(0)":::"memory");
  float rli[16];
  #pragma unroll
  for(int r=0;r<16;++r)rli[r]=__builtin_amdgcn_rcpf(wsf[32+crow(r,hi)]);
  bf16*Ow=O+(rowbase+q0+wid*QBLK)*DM+hv*2*D;
  { bf16*stg=(bf16*)(shm+LDS_OST)+wid*2048;
    #pragma unroll
    for(int vh=0;vh<2;++vh){
    #pragma unroll
    for(int r=0;r<16;++r){const int orow=crow(r,hi);
      #pragma unroll
      for(int d0=0;d0<2;++d0)stg[orow*64+d0*32+r32]=__float2bfloat16(o[2*vh+d0][r]*rli[r]);}
    asm volatile("s_waitcnt lgkmcnt(0)":::"memory");
    #pragma unroll
    for(int i=0;i<4;++i){const int row=i*8+(lane>>3),ch=lane&7; const u32x4 v=*(const u32x4*)(stg+row*64+ch*8); ATTN_STORE16(Ow+(long)row*DM+vh*64+ch*8,v);}
    asm volatile("s_waitcnt lgkmcnt(0)":::"memory"); } }
  asm volatile("s_waitcnt lgkmcnt(0)\n\ts_barrier":::"memory");
  #undef DMA_K
  #undef DMA_V
  #undef CMASK
  #undef START
  #undef RESC
  #undef ROT
}
constexpr int ATTN_LDS_BYTES=LDS_BYTES;
#undef SBAR
#undef WAIT_BAR
}

constexpr size_t MiB = 1u << 20;
constexpr size_t WS_CTL = 0, CTL_ZERO_BYTES = 1 * MiB;
constexpr size_t WS_LRUS = 1 * MiB;
constexpr size_t WS_TOKE = 2 * MiB;
constexpr size_t WS_TOKW = 2 * MiB + 512 * 1024;
constexpr size_t WS_SLOTT = 3 * MiB;
constexpr size_t WS_SLOTW = 3 * MiB + 512 * 1024;
constexpr size_t WS_ROPE = 6 * MiB;
constexpr size_t WS_WIN = 14 * MiB;
constexpr size_t WS_WBR = 29 * MiB;
constexpr size_t WS_WOUT = 32 * MiB;
constexpr size_t WS_XN = 34 * MiB;
constexpr size_t WS_A = 98 * MiB;
constexpr size_t WS_LRUX = WS_A, WS_LRUG = WS_A + 32 * MiB, WS_Q = WS_A + 64 * MiB, WS_K = WS_A + 96 * MiB, WS_V = WS_A + 128 * MiB;
constexpr size_t WS_GQ = WS_A + 160 * MiB, WS_GK = WS_A + 176 * MiB, WS_GV = WS_A + 192 * MiB, WS_GR = WS_A + 224 * MiB, WS_GG = WS_A + 256 * MiB;
constexpr size_t WS_GATES = WS_A;
constexpr size_t WS_O0 = 386 * MiB, WS_O1 = 418 * MiB;
constexpr size_t WS_YLRU = 450 * MiB, WS_YDA = 482 * MiB, WS_YGLA = 514 * MiB;
constexpr size_t WS_WFFN = 98 * MiB;
constexpr size_t WS_H = 266 * MiB;
constexpr size_t WS_Y2 = 504 * MiB;
constexpr size_t WS_PG = 546 * MiB;
constexpr size_t WS_XN8 = 290 * MiB;
constexpr size_t WS_Y1 = 186 * MiB;
constexpr size_t WS_END = 578 * MiB;
constexpr size_t W13_ELEMS = (size_t)2 * DFF * DM, W2_ELEMS = (size_t)DM * DFF, WEXP_ELEMS = W13_ELEMS + W2_ELEMS;
constexpr int CW_TMO = 0, CW_CODE = 1;
constexpr int CW_BAR = 4096;
constexpr int CW_GCNT = 8192;
constexpr int CW_QHEAD = 12288;
constexpr int RING_BYTES = 131072;
constexpr int LDSCTL_OFF = RING_BYTES;
constexpr int LDS_BYTES = 147456;
constexpr int MW_DEQ = 0, MW_BAR = 8, MW_TS = 16  , MW_HIST = 32, MW_BASE = 40, MW_ROWINFO = 64  ;
constexpr int NWAVES = 8;
#ifndef MK_ONE_LAUNCH
#define MK_ONE_LAUNCH 1
#endif
constexpr int PH_PER_LAYER = 11, N_PHASES = 2 * PH_PER_LAYER + 1;

#define XB_TMO      128
#define XB_XCNT(j)  (256  + 64 * (j))
#define XB_XSUB(j)  (1280 + 64 * (j))
#define XB_XGEN(j)  (2304 + 64 * (j))
#define XB_TOP      3328
#define XB_TOPGEN   3392
#define XCD_BAR_WORDS 3456
#define XB_SPIN_CAP (1u << 22)

__device__ __forceinline__ unsigned xb_ld(unsigned* p)              { return __hip_atomic_load(p, __ATOMIC_RELAXED, __HIP_MEMORY_SCOPE_AGENT); }
__device__ __forceinline__ unsigned xb_add(unsigned* p, unsigned v) { return __hip_atomic_fetch_add(p, v, __ATOMIC_RELAXED, __HIP_MEMORY_SCOPE_AGENT); }
__device__ __forceinline__ unsigned xb_xcc_id() { return (unsigned)__builtin_amdgcn_s_getreg((3 << 11) | 20) & 0xFu; }
#define XB_SPIN(cond, bar) do { unsigned _sp = 0; while (cond) { __builtin_amdgcn_s_sleep(1); \
    if ((++_sp & 255u) == 0u) { if (xb_ld(&(bar)[XB_TMO])) break; if (_sp > XB_SPIN_CAP) { atomicAdd(&(bar)[XB_TMO], 1u); break; } } } } while (0)

struct XcdBarrier { unsigned* bar; unsigned x; volatile LAS unsigned* st; };

__device__ __forceinline__ XcdBarrier xcd_barrier_post(unsigned* bar, volatile LAS unsigned* st) {
    XcdBarrier b; b.bar = bar; b.x = xb_xcc_id(); b.st = st;
    if (threadIdx.x == 0) (void)xb_add(&bar[XB_XCNT(b.x)], 1u);
    return b;
}
__device__ __forceinline__ void xcd_barrier_complete(unsigned* bar, unsigned x, unsigned& nloc, unsigned& nx) {
    const unsigned G = gridDim.x * gridDim.y * gridDim.z;
    unsigned sum, cnt, mine, sp = 0u;
    for (;;) {
        sum = 0u; cnt = 0u; mine = 0u;
#pragma unroll
        for (unsigned j = 0; j < 16; ++j) { const unsigned c = xb_ld(&bar[XB_XCNT(j)]); sum += c; cnt += (c > 0u) ? 1u : 0u; mine = (j == x) ? c : mine; }
        if (sum == G) break;
        __builtin_amdgcn_s_sleep(1);
        if ((++sp & 255u) == 0u) { if (xb_ld(&bar[XB_TMO])) break; if (sp > XB_SPIN_CAP) { atomicAdd(&bar[XB_TMO], 1u); break; } }
    }
    nloc = mine > 0u ? mine : 1u; nx = cnt > 0u ? cnt : 1u;
}
__device__ __forceinline__ void xcd_barrier(const XcdBarrier& b0) {
    XcdBarrier b = b0; { unsigned long long p_ = (unsigned long long)b.bar; asm volatile("" : "+s"(p_)); b.bar = (unsigned*)p_; }
    asm volatile("s_waitcnt vmcnt(0)" ::: "memory");
    __syncthreads();
    if (threadIdx.x == 0) {
        unsigned* bar = b.bar;
        __builtin_amdgcn_s_waitcnt(0);
        unsigned nloc = b.st[0], nx = b.st[1];
        if (nloc == 0u) { xcd_barrier_complete(bar, b.x, nloc, nx); b.st[0] = nloc; b.st[1] = nx; }
        const unsigned old = xb_add(&bar[XB_XSUB(b.x)], 1u);
        const unsigned gen = old / nloc;
        if (old + 1u == (gen + 1u) * nloc) {
            __builtin_amdgcn_fence(__ATOMIC_RELEASE, "agent");
            asm volatile("s_waitcnt vmcnt(0)" ::: "memory");
            const unsigned og = xb_add(&bar[XB_TOP], 1u);
            const unsigned tg = og / nx;
            if (og + 1u == (tg + 1u) * nx) xb_add(&bar[XB_TOPGEN], 1u);
            else XB_SPIN(xb_ld(&bar[XB_TOPGEN]) == tg, bar);
            __builtin_amdgcn_fence(__ATOMIC_ACQUIRE, "agent");
            xb_add(&bar[XB_XGEN(b.x)], 1u);
            asm volatile("s_waitcnt vmcnt(0)" ::: "memory");
        } else {
            XB_SPIN(xb_ld(&bar[XB_XGEN(b.x)]) == gen, bar);
            __builtin_amdgcn_fence(__ATOMIC_ACQUIRE, "agent");
            asm volatile("s_waitcnt vmcnt(0)" ::: "memory");
        }
    }
    __syncthreads();
}

struct Args { const void* in[30]; float* out; unsigned char* ws; int ph_lo, ph_hi; };
struct Frame {
    LAS unsigned char* lds;
    volatile LAS unsigned* MISC;
    gu32* ctl;
    GAS unsigned char* ws;
    const char __attribute__((address_space(4)))* karg;
    int tid, lane, wave, vcu, G;
    float* out;
};
#define FIN(T, k) ((const T*)(const GAS T*)(*(const unsigned long long __attribute__((address_space(4)))*)(F.karg + 8 * (k))))
#define IN_x FIN(float, 0)
#define IN_positions FIN(int, 1)
#define IN_mix_norm FIN(float, 2)
#define IN_w_in FIN(float, 3)
#define IN_conv_w FIN(float, 4)
#define IN_conv_b FIN(float, 5)
#define IN_lru_wa FIN(float, 6)
#define IN_lru_ba FIN(float, 7)
#define IN_lru_wx FIN(float, 8)
#define IN_lru_bx FIN(float, 9)
#define IN_lru_lambda FIN(float, 10)
#define IN_da_lq1 FIN(float, 11)
#define IN_da_lk1 FIN(float, 12)
#define IN_da_lq2 FIN(float, 13)
#define IN_da_lk2 FIN(float, 14)
#define IN_da_subln FIN(float, 15)
#define IN_gla_wa2 FIN(float, 16)
#define IN_gla_ba FIN(float, 17)
#define IN_gla_norm FIN(float, 18)
#define IN_w_branch FIN(float, 19)
#define IN_w_out FIN(float, 20)
#define IN_ffn_norm FIN(float, 21)
#define IN_dense_w1 FIN(float, 22)
#define IN_dense_w3 FIN(float, 23)
#define IN_dense_w2 FIN(float, 24)
#define IN_router FIN(float, 25)
#define IN_moe_w1 FIN(float, 26)
#define IN_moe_w3 FIN(float, 27)
#define IN_moe_w2 FIN(float, 28)
#define IN_final_norm FIN(float, 29)
#define WSP(T, off) ((T*)(GAS T*)(F.ws + (off)))
#define WSL(T, off) ((T*)(GAS T*)(FL.ws + (off)))
__device__ __forceinline__ void relaunder(Frame& F) { int t = threadIdx.x; asm volatile("" : "+v"(t)); F.tid = t; F.lane = t & 63; F.wave = __builtin_amdgcn_readfirstlane(t >> 6);
    unsigned long long w = (unsigned long long)F.ws; asm volatile("" : "+s"(w)); F.ws = (GAS unsigned char*)w;
    int gg_ = F.G; asm volatile("" : "+s"(gg_)); F.G = gg_; int vc_ = F.vcu; asm volatile("" : "+s"(vc_)); F.vcu = vc_;
    unsigned long long ka = (unsigned long long)F.karg; asm volatile("" : "+s"(ka)); F.karg = (const char __attribute__((address_space(4)))*)ka; }

#define EPI_ROWLOOP(ai, m) _Pragma("unroll") for (int ai = 0; ai < 2; ++ai) _Pragma("unroll") for (int m = 0; m < 4; ++m)
__device__ __forceinline__ v4u pack8(const f32x4& a, const f32x4& b) { v4u w; w.x = pk2(a[0], a[1]); w.y = pk2(a[2], a[3]); w.z = pk2(b[0], b[1]); w.w = pk2(b[2], b[3]); return w; }
__device__ __forceinline__ float gelu_tanh(float x) { const float t = 1.5957691216057308f * (x + 0.044715f * x * x * x); return x * __builtin_amdgcn_rcpf(1.f + __expf(-t)); }
__device__ __forceinline__ float silu_f(float x) { return x * __builtin_amdgcn_rcpf(1.f + __expf(-x)); }
__device__ __forceinline__ f32x4 sigmoid4(const f32x4& x, float sc) { f32x4 t = x * (-1.4426950408889634f * sc);
#pragma unroll
    for (int q = 0; q < 4; ++q) t[q] = __builtin_amdgcn_exp2f(t[q]);
    t = t + 1.f;
#pragma unroll
    for (int q = 0; q < 4; ++q) t[q] = __builtin_amdgcn_rcpf(t[q]);
    return t; }
__device__ __forceinline__ f32x4 silu4(const f32x4& x) { return x * sigmoid4(x, 1.f); }
__device__ __forceinline__ f32x4 gelu_tanh4(const f32x4& x) { const f32x4 w = (x * x) * (0.044715f * 1.5957691216057308f) + 1.5957691216057308f; return x * sigmoid4(x * w, 1.f); }
__device__ __forceinline__ float log1p_fast(float e) { return e < 0.03125f ? e * (1.f + e * (-0.5f + e * (0.33333334f - 0.25f * e))) : __logf(1.f + e); }
__device__ __forceinline__ float logsig(float z) { return fminf(z, 0.f) - log1p_fast(__expf(-fabsf(z))); }

struct EpiInProj {
    bf16 *LRUX, *LRUG, *Q, *K, *V, *GQ, *GK, *GV, *GR; float* GG; const f32x2* rope; const float* gla_ba;
    __device__ __forceinline__ void operator()(f32x4 (&acc)[2][2][4][2], const pg8::Unit& u, int wr, int wc, int fr, int fq) const {
        const int row0 = u.pm * 256 + wr * 64 + fr, cw = wc * 32 + 8 * fq, pn = u.pn;
        if (pn == 4 || pn == 5 || pn == 6 || pn == 7) {
            bf16* dst = (pn < 6) ? Q : K; const float sc = (pn < 6) ? C2 : 1.f;
#pragma unroll
            for (int ai = 0; ai < 2; ++ai) {
                f32x4 c0[4][2], c1[4][2];
#pragma unroll
                for (int m = 0; m < 4; ++m)
#pragma unroll
                    for (int bj = 0; bj < 2; ++bj) { const int row = row0 + ai * 128 + m * 16, lcq = (pn & 1) * 256 + 128 * bj + cw, i0 = (lcq & 63) >> 1;
                        c0[m][bj] = *(const f32x4*)(rope + (size_t)row * 32 + i0); c1[m][bj] = *(const f32x4*)(rope + (size_t)row * 32 + i0 + 2); }
                asm volatile("" ::: "memory");
#pragma unroll
                for (int m = 0; m < 4; ++m)
#pragma unroll
                    for (int bj = 0; bj < 2; ++bj) { const int row = row0 + ai * 128 + m * 16, lcq = (pn & 1) * 256 + 128 * bj + cw, hc = lcq >> 6, i0 = (lcq & 63) >> 1;
                        const f32x4 v0 = acc[ai][bj][m][0], v1 = acc[ai][bj][m][1], cs0 = c0[m][bj], cs1 = c1[m][bj];
                        float o1[4], o2[4];
                        o1[0] = (v0[0] * cs0[0] - v0[1] * cs0[1]) * sc; o2[0] = (v0[1] * cs0[0] + v0[0] * cs0[1]) * sc;
                        o1[1] = (v0[2] * cs0[2] - v0[3] * cs0[3]) * sc; o2[1] = (v0[3] * cs0[2] + v0[2] * cs0[3]) * sc;
                        o1[2] = (v1[0] * cs1[0] - v1[1] * cs1[1]) * sc; o2[2] = (v1[1] * cs1[0] + v1[0] * cs1[1]) * sc;
                        o1[3] = (v1[2] * cs1[2] - v1[3] * cs1[3]) * sc; o2[3] = (v1[3] * cs1[2] + v1[2] * cs1[3]) * sc;
                        v2u a, b; a.x = pg8::cvt_pk_bf16(o1[0], o1[1]); a.y = pg8::cvt_pk_bf16(o1[2], o1[3]); b.x = pg8::cvt_pk_bf16(o2[0], o2[1]); b.y = pg8::cvt_pk_bf16(o2[2], o2[3]);
                        bf16* p = dst + (size_t)row * 512 + hc * 64 + i0;
                        *(v2u*)p = a; *(v2u*)(p + 32) = b; }
                asm volatile("" ::: "memory");
            }
        } else if (pn == 16) {
            f32x4 bb0[2], bb1[2];
#pragma unroll
            for (int bj = 0; bj < 2; ++bj) { bb0[bj] = *(const f32x4*)(gla_ba + 128 * bj + cw); bb1[bj] = *(const f32x4*)(gla_ba + 128 * bj + cw + 4); }
            asm volatile("" ::: "memory");
            EPI_ROWLOOP(ai, m) { const int row = row0 + ai * 128 + m * 16;
#pragma unroll
                for (int bj = 0; bj < 2; ++bj) { const int lc = 128 * bj + cw;
                    f32x4 v0 = acc[ai][bj][m][0] + bb0[bj], v1 = acc[ai][bj][m][1] + bb1[bj];
#pragma unroll
                    for (int q = 0; q < 4; ++q) { v0[q] = logsig(v0[q]) * 0.0625f; v1[q] = logsig(v1[q]) * 0.0625f; }
                    float* p = GG + (size_t)row * 256 + lc; *(f32x4*)p = v0; *(f32x4*)(p + 4) = v1; } }
        } else {
            bf16* dst; int pitch, c0, op;
            if (pn < 2) { dst = LRUX; pitch = 512; c0 = pn * 256; op = 0; }
            else if (pn < 4) { dst = LRUG; pitch = 512; c0 = (pn - 2) * 256; op = 1; }
            else if (pn < 10) { dst = V; pitch = 512; c0 = (pn - 8) * 256; op = 0; }
            else if (pn == 10) { dst = GQ; pitch = 256; c0 = 0; op = 3; }
            else if (pn == 11) { dst = GK; pitch = 256; c0 = 0; op = 0; }
            else if (pn < 14) { dst = GV; pitch = 512; c0 = (pn - 12) * 256; op = 0; }
            else { dst = GR; pitch = 512; c0 = (pn - 14) * 256; op = 2; }
            EPI_ROWLOOP(ai, m) { const int row = row0 + ai * 128 + m * 16;
#pragma unroll
                for (int bj = 0; bj < 2; ++bj) { f32x4 v0 = acc[ai][bj][m][0], v1 = acc[ai][bj][m][1];
                    if (op == 1) { v0 = gelu_tanh4(v0); v1 = gelu_tanh4(v1); }
                    else if (op == 2) { v0 = silu4(v0); v1 = silu4(v1); }
                    else if (op == 3) { v0 = v0 * 0.125f; v1 = v1 * 0.125f; }
                    *(v4u*)(dst + (size_t)row * pitch + c0 + 128 * bj + cw) = pack8(v0, v1); } }
        }
    }
};
struct EpiGG {
    float* GG; const float* gla_ba; float sc;
    __device__ __forceinline__ void operator()(f32x4 (&acc)[2][2][4][2], const pg8::Unit& u, int wr, int wc, int fr, int fq) const {
        const int row0 = u.pm * 256 + wr * 64 + fr, cw = wc * 32 + 8 * fq;
        f32x4 bb0[2], bb1[2];
#pragma unroll
        for (int bj = 0; bj < 2; ++bj) { bb0[bj] = *(const f32x4*)(gla_ba + 128 * bj + cw); bb1[bj] = *(const f32x4*)(gla_ba + 128 * bj + cw + 4); }
        asm volatile("" ::: "memory");
        EPI_ROWLOOP(ai, m) { const int row = row0 + ai * 128 + m * 16;
#pragma unroll
            for (int bj = 0; bj < 2; ++bj) { const int lc = 128 * bj + cw;
                f32x4 v0 = acc[ai][bj][m][0] * sc + bb0[bj], v1 = acc[ai][bj][m][1] * sc + bb1[bj];
#pragma unroll
                for (int q = 0; q < 4; ++q) { v0[q] = logsig(v0[q]) * 0.0625f; v1[q] = logsig(v1[q]) * 0.0625f; }
                float* p = GG + (size_t)row * 256 + lc; *(f32x4*)p = v0; *(f32x4*)(p + 4) = v1; } }
    }
};
struct EpiNull { __device__ __forceinline__ void operator()(f32x4 (&acc)[2][2][4][2], const pg8::Unit& u, int wr, int wc, int fr, int fq) const {
    EPI_ROWLOOP(ai, m) { asm volatile("" :: "v"(acc[ai][0][m][0]), "v"(acc[ai][0][m][1]), "v"(acc[ai][1][m][0]), "v"(acc[ai][1][m][1])); } } };
struct EpiStoreOnly { bf16* G;
    __device__ __forceinline__ void operator()(f32x4 (&acc)[2][2][4][2], const pg8::Unit& u, int wr, int wc, int fr, int fq) const {
        const int row0 = u.pm * 256 + wr * 64 + fr, cw = wc * 32 + 8 * fq;
        EPI_ROWLOOP(ai, m) { const int row = row0 + ai * 128 + m * 16;
#pragma unroll
            for (int bj = 0; bj < 2; ++bj) *(v4u*)(G + (size_t)row * NG_COLS + u.pn * 256 + 128 * bj + cw) = pack8(acc[ai][bj][m][0], acc[ai][bj][m][1]); } } };
struct EpiMathOnly {
    __device__ __forceinline__ void operator()(f32x4 (&acc)[2][2][4][2], const pg8::Unit& u, int wr, int wc, int fr, int fq) const {
        EPI_ROWLOOP(ai, m) {
#pragma unroll
            for (int bj = 0; bj < 2; ++bj) { f32x4 v0 = acc[ai][bj][m][0], v1 = acc[ai][bj][m][1];
#pragma unroll
                for (int q = 0; q < 4; ++q) { v0[q] = fast_sigmoid(v0[q]); v1[q] = fast_sigmoid(v1[q]); }
                v4u w = pack8(v0, v1); asm volatile("" :: "v"(w)); } } } };
__device__ __forceinline__ size_t gate_off(int pm, int gt, int ai, int m, int bj, int wr, int wc, int fr, int fq) {
    const int ri = wr * 64 + fr + ai * 128 + m * 16, ci = 128 * bj + 32 * wc + 8 * fq;
    const int sub = (ri >> 7) * 8 + ((ri >> 4) & 3) * 2 + (ci >> 7), th = ((((ri >> 6) & 1) * 4 + ((ci >> 5) & 3)) * 64) + ((ci >> 3) & 3) * 16 + (ri & 15);
    return ((((size_t)(pm * 12 + gt) * 16 + (size_t)sub) * 512) + (size_t)th) * 8; }
struct EpiGates {
    bf16* G; float sc;
    __device__ __forceinline__ void operator()(f32x4 (&acc)[2][2][4][2], const pg8::Unit& u, int wr, int wc, int fr, int fq) const {
        EPI_ROWLOOP(ai, m) {
#pragma unroll
            for (int bj = 0; bj < 2; ++bj) { f32x4 v0 = acc[ai][bj][m][0], v1 = acc[ai][bj][m][1];
                v0 = sigmoid4(v0, sc) * 255.f; v1 = sigmoid4(v1, sc) * 255.f;
                unsigned w0 = 0u, w1 = 0u;
#pragma unroll
                for (int q = 0; q < 4; ++q) { w0 = __builtin_amdgcn_cvt_pk_u8_f32(fmaxf(v0[q], 1.f), q, w0); w1 = __builtin_amdgcn_cvt_pk_u8_f32(fmaxf(v1[q], 1.f), q, w1); }
                *(v2u*)((unsigned char*)G + gate_off(u.pm, u.pn, ai, m, bj, wr, wc, fr, fq)) = (v2u){w0, w1}; } }
    }
};
struct EpiUp {
    const bf16* G; bf16* M;
    __device__ __forceinline__ void operator()(f32x4 (&acc)[2][2][4][2], const pg8::Unit& u, int wr, int wc, int fr, int fq) const {
        const int row0 = u.pm * 256 + wr * 64 + fr, cw = wc * 32 + 8 * fq, n = u.x;
        const unsigned char* G8 = (const unsigned char*)G;
        v2u g[2][4][2], h[2][4][2];
#pragma unroll
        for (int ai = 0; ai < 2; ++ai)
#pragma unroll
            for (int m = 0; m < 4; ++m)
#pragma unroll
                for (int bj = 0; bj < 2; ++bj) {
                    g[ai][m][bj] = *(const v2u*)(G8 + gate_off(u.pm, n * 4 + u.pn, ai, m, bj, wr, wc, fr, fq));
                    h[ai][m][bj] = g[ai][m][bj]; if (n < 2) h[ai][m][bj] = *(const v2u*)(G8 + gate_off(u.pm, (n + 1) * 4 + u.pn, ai, m, bj, wr, wc, fr, fq)); }
        asm volatile("" ::: "memory");
#pragma unroll
        for (int ai = 0; ai < 2; ++ai) {
#pragma unroll
            for (int m = 0; m < 4; ++m)
#pragma unroll
                for (int bj = 0; bj < 2; ++bj) { const int row = row0 + ai * 128 + m * 16, col = u.pn * 256 + 128 * bj + cw;
                    const v2u gg = g[ai][m][bj], hh = h[ai][m][bj];
                    float f[8];
#pragma unroll
                    for (int q = 0; q < 4; ++q) { const float g0 = (float)((gg.x >> (8 * q)) & 0xffu), g1 = (float)((gg.y >> (8 * q)) & 0xffu);
                        if (n < 2) { f[q] = g0 * __builtin_amdgcn_rcpf((float)((hh.x >> (8 * q)) & 0xffu)); f[4 + q] = g1 * __builtin_amdgcn_rcpf((float)((hh.y >> (8 * q)) & 0xffu)); }
                        else { f[q] = g0 * (1.f / 255.f); f[4 + q] = g1 * (1.f / 255.f); } }
                    f32x4 v0 = acc[ai][bj][m][0], v1 = acc[ai][bj][m][1];
                    v0[0] *= f[0]; v0[1] *= f[1]; v0[2] *= f[2]; v0[3] *= f[3]; v1[0] *= f[4]; v1[1] *= f[5]; v1[2] *= f[6]; v1[3] *= f[7];
                    if (n < 2) { acc[ai][bj][m][0] = v0; acc[ai][bj][m][1] = v1; asm volatile("" : "+v"(acc[ai][bj][m][0]), "+v"(acc[ai][bj][m][1])); }
                    else *(v4u*)(M + (size_t)row * DM + col) = pack8(v0, v1); }
        }
        asm volatile("" ::: "memory");
    }
};
struct EpiBf {
    bf16* O;
    __device__ __forceinline__ void operator()(f32x4 (&acc)[2][2][4][2], const pg8::Unit& u, int wr, int wc, int fr, int fq) const {
        const int row0 = u.pm * 256 + wr * 64 + fr, cw = wc * 32 + 8 * fq;
        EPI_ROWLOOP(ai, m) { const int row = row0 + ai * 128 + m * 16;
#pragma unroll
            for (int bj = 0; bj < 2; ++bj) *(v4u*)(O + (size_t)row * DM + u.pn * 256 + 128 * bj + cw) = pack8(acc[ai][bj][m][0], acc[ai][bj][m][1]); }
    }
};
struct EpiRes {
    const float* X; float* OUT;
    __device__ __forceinline__ void operator()(f32x4 (&acc)[2][2][4][2], const pg8::Unit& u, int wr, int wc, int fr, int fq) const {
        const int row0 = u.pm * 256 + wr * 64 + fr, cw = wc * 32 + 8 * fq;
#pragma unroll
        for (int ai = 0; ai < 2; ++ai) {
            f32x4 r0[4][2], r1[4][2];
#pragma unroll
            for (int m = 0; m < 4; ++m)
#pragma unroll
                for (int bj = 0; bj < 2; ++bj) { const int row = row0 + ai * 128 + m * 16, col = u.pn * 256 + 128 * bj + cw;
                    if (X) { r0[m][bj] = *(const f32x4*)(X + (size_t)row * DM + col); r1[m][bj] = *(const f32x4*)(X + (size_t)row * DM + col + 4); }
                    else { const v4u w = *(const v4u*)((const bf16*)(OUT + (size_t)row * DM) + col);
                        r0[m][bj] = (f32x4){bflo(w.x), bfhi(w.x), bflo(w.y), bfhi(w.y)}; r1[m][bj] = (f32x4){bflo(w.z), bfhi(w.z), bflo(w.w), bfhi(w.w)}; } }
            asm volatile("" ::: "memory");
#pragma unroll
            for (int m = 0; m < 4; ++m)
#pragma unroll
                for (int bj = 0; bj < 2; ++bj) { const int row = row0 + ai * 128 + m * 16, col = u.pn * 256 + 128 * bj + cw;
                    *(v4u*)((bf16*)(OUT + (size_t)row * DM) + col) = pack8(acc[ai][bj][m][0] + r0[m][bj], acc[ai][bj][m][1] + r1[m][bj]); }
            asm volatile("" ::: "memory");
        }
    }
};
__device__ __forceinline__ unsigned pk4_fp8(float a, float b, float c, float d) {
    a = fminf(fmaxf(a, -448.f), 448.f); b = fminf(fmaxf(b, -448.f), 448.f); c = fminf(fmaxf(c, -448.f), 448.f); d = fminf(fmaxf(d, -448.f), 448.f);
    int p = __builtin_amdgcn_cvt_pk_fp8_f32(a, b, 0, false); p = __builtin_amdgcn_cvt_pk_fp8_f32(c, d, p, true); return (unsigned)p; }
constexpr float F8_SA = 16.f, F8_SW13 = 256.f, F8_SH = 16.f, F8_SW2 = 512.f;
struct EpiH {
    bf16* H; int fp8; int fp8in;
    __device__ __forceinline__ void operator()(f32x4 (&acc)[2][2][4][2], const pg8::Unit& u, int wr, int wc, int fr, int fq) const {
        const int row0 = u.pm * 256 + wr * 64 + fr, cw = wc * 32 + 8 * fq;
        const float si = fp8in ? 1.f / (F8_SA * F8_SW13) : 1.f;
        const float c1 = -1.4426950408889634f * si, K = si * si * (fp8 ? F8_SH : 1.f);
        EPI_ROWLOOP(ai, m) { const int row = row0 + ai * 128 + m * 16;
            f32x4 o[2];
#pragma unroll
            for (int j = 0; j < 2; ++j) { const f32x4 a = acc[ai][0][m][j], b = acc[ai][1][m][j];
                f32x4 t = a * c1;
#pragma unroll
                for (int q = 0; q < 4; ++q) t[q] = __builtin_amdgcn_exp2f(t[q]);
                t = t + 1.f;
#pragma unroll
                for (int q = 0; q < 4; ++q) t[q] = __builtin_amdgcn_rcpf(t[q]);
                o[j] = (a * b) * (t * K); }
            if (fp8) { v2u w;
#pragma unroll
                for (int j = 0; j < 2; ++j) { f32x4 c;
#pragma unroll
                    for (int q = 0; q < 4; ++q) c[q] = __builtin_amdgcn_fmed3f(o[j][q], -448.f, 448.f);
                    int pk = __builtin_amdgcn_cvt_pk_fp8_f32(c[0], c[1], 0, false); pk = __builtin_amdgcn_cvt_pk_fp8_f32(c[2], c[3], pk, true); if (j == 0) w.x = (unsigned)pk; else w.y = (unsigned)pk; }
                *(v2u*)((unsigned char*)H + (size_t)row * DFF + u.pn * 128 + cw) = w; }
            else *(v4u*)(H + (size_t)row * DFF + u.pn * 128 + cw) = pack8(o[0], o[1]); }
    }
};
struct EpiW2 {
    const int* slot_tok; const float* slot_w; bf16* Y1; bf16* Y2; int dense; float oscale;
    __device__ __forceinline__ void operator()(f32x4 (&acc)[2][2][4][2], const pg8::Unit& u, int wr, int wc, int fr, int fq) const {
        const int s0 = u.x + wr * 64 + fr, cw = wc * 32 + 8 * fq;
        int st[2][4]; float wv[2][4];
#pragma unroll
        for (int ai = 0; ai < 2; ++ai)
#pragma unroll
            for (int m = 0; m < 4; ++m) { st[ai][m] = slot_tok[s0 + ai * 128 + m * 16]; wv[ai][m] = slot_w[s0 + ai * 128 + m * 16] * oscale; }
        asm volatile("" ::: "memory");
#pragma unroll
        for (int ai = 0; ai < 2; ++ai)
#pragma unroll
            for (int m = 0; m < 4; ++m) { const int s = st[ai][m];
                if (s >= 0) { const int tok = s & 0xffff; bf16* Y = (dense || (s >> 20)) ? Y2 : Y1; const float w = wv[ai][m];
#pragma unroll
                    for (int bj = 0; bj < 2; ++bj) { const size_t o = (size_t)tok * DM + u.pn * 256 + 128 * bj + cw;
                        *(v4u*)(Y + o) = pack8(acc[ai][bj][m][0] * w, acc[ai][bj][m][1] * w); } } }
        asm volatile("" ::: "memory");
    }
};

struct SchedPlain {
    const char* A; const char* Bt; int nM, nN, KB, G, c;
    __device__ __forceinline__ bool next(int i, pg8::Unit& u) const {
        const long L = (long)i * G + c; if (L >= (long)nM * nN) return false;
        int pm, pn; pg8::tile_of((int)L, nM, nN, pm, pn); u.pm = pm; u.pn = pn; u.x = 0; u.gs = 0; u.keep = 0;
        u.a = A + (size_t)pm * 256 * KB; u.b = Bt + (size_t)pn * 256 * KB; return true; }
    __device__ __forceinline__ void a_ready(const pg8::Unit&) const {}
    __device__ __forceinline__ void done(const pg8::Unit&) const {}
    __device__ __forceinline__ int row(int) const { return 0; }
};
struct SchedUp {
    const char* Y; const char* W; int G, c;
    __device__ __forceinline__ bool next(int i, pg8::Unit& u) const {
        const int j = i / 3, n = i - 3 * j; const long L = (long)j * G + c; if (L >= 128 * 4) return false;
        int pm, pn; pg8::tile_of((int)L, 128, 4, pm, pn); u.pm = pm; u.pn = pn; u.x = n; u.gs = 0; u.keep = (n < 2) ? 1 : 0;
        u.a = Y + (size_t)n * (32 * MiB) + (size_t)pm * 256 * BW * 2; u.b = W + (size_t)n * (DM * BW * 2) + (size_t)pn * 256 * BW * 2; return true; }
    __device__ __forceinline__ void a_ready(const pg8::Unit&) const {}
    __device__ __forceinline__ void done(const pg8::Unit&) const {}
    __device__ __forceinline__ int row(int) const { return 0; }
};
struct SchedPitchA {
    const char* A; const char* Bt; int nM, nN, KB, PA, G, c;
    __device__ __forceinline__ bool next(int i, pg8::Unit& u) const {
        const long L = (long)i * G + c; if (L >= (long)nM * nN) return false;
        int pm, pn; pg8::tile_of((int)L, nM, nN, pm, pn); u.pm = pm; u.pn = pn; u.x = 0; u.gs = 0; u.keep = 0;
        u.a = A + (size_t)pm * 256 * PA; u.b = Bt + (size_t)pn * 256 * KB; return true; }
    __device__ __forceinline__ void a_ready(const pg8::Unit&) const {}
    __device__ __forceinline__ void done(const pg8::Unit&) const {}
    __device__ __forceinline__ int row(int) const { return 0; }
};
struct SchedMoE {
    const char* A; const char* W; const int* slot_tok; volatile LAS unsigned* ts; int t0, nM, nN, KB, G, c, w2; size_t WEB, W2O;
    __device__ __forceinline__ bool next(int i, pg8::Unit& u) const {
        const long L = (long)i * G + c; if (L >= (long)nM * nN) return false;
        int pm, pn; pg8::tile_of((int)L, nM, nN, pm, pn); const int tile = t0 + pm;
        int e = 0;
#pragma unroll
        for (int j = 1; j < 8; ++j) e += (tile >= (int)ts[j]) ? 1 : 0;
        u.pm = pm; u.pn = pn; u.x = tile * 256; u.gs = tile * 256; u.keep = 0;
        if (w2) { u.a = A + (size_t)pm * 256 * KB; u.b = W + (size_t)e * WEB + W2O + (size_t)pn * 256 * KB; }
        else { u.a = A; u.b = W + (size_t)e * WEB + (size_t)pn * 256 * KB; }
        return true; }
    __device__ __forceinline__ void a_ready(const pg8::Unit&) const {}
    __device__ __forceinline__ void done(const pg8::Unit&) const {}
    __device__ __forceinline__ int row(int slot) const { const int st = slot_tok[slot]; return st < 0 ? 0 : (st & 0xffff); }
};

#ifndef FOLD_FP8
#define FOLD_FP8 1
#endif
#ifndef XN8_SLOT
#define XN8_SLOT 1
#endif
#ifndef MOE_CHECK
#define MOE_CHECK 0
#endif
#ifndef GATES_FP8
#define GATES_FP8 1
#endif
#ifndef DENSE_FP8
#define DENSE_FP8 0
#endif
#ifndef MOE_FP8
#define MOE_FP8 1
#endif
#define LBAR() asm volatile("s_waitcnt lgkmcnt(0)\n\ts_barrier" ::: "memory")
__device__ __forceinline__ int crow16(int r, int hi) { return (r & 3) + 8 * (r >> 2) + 4 * hi; }
__device__ __forceinline__ void mma32(f32x16& acc, const LAS bf16* A, int lda, const LAS bf16* Bt, int ldb, int K, int lane) {
    const int r = lane & 31, h = lane >> 5;
    for (int k0 = 0; k0 < K; k0 += 16) {
        const bf16x8 a = *(const LAS bf16x8*)(A + r * lda + k0 + 8 * h);
        const bf16x8 b = *(const LAS bf16x8*)(Bt + r * ldb + k0 + 8 * h);
        acc = __builtin_amdgcn_mfma_f32_32x32x16_bf16(a, b, acc, 0, 0, 0);
    }
}

__device__ __forceinline__ int maprow(int kind, int c, int off) {
    if (kind == 1) { if (c >= 1024 && c < 2048) { const int rel = c - 1024, blk = rel >> 6, w = rel & 63; return 1024 + blk * 64 + 2 * (w & 31) + (w >> 5); } return c; }
    if (kind == 2) return 256 * (c >> 7) + (c & 127);
    if (kind == 3) return 256 * (c >> 7) + 128 + (c & 127);
    return c + off;
}
__device__ __forceinline__ void cvt_item(const float* W, int K, int Nsrc, int c0, int nblk, bf16* WT, int kind, int off, LAS float* scr, int item, int lane) {
    const int kb = item / nblk, nb = item - kb * nblk, k0 = 64 * kb, n0 = c0 + 32 * nb;
    { f32x4 t[8];
#pragma unroll
        for (int i = 0; i < 8; ++i) t[i] = *(const GAS f32x4*)(W + (size_t)(k0 + 8 * i + (lane >> 3)) * Nsrc + n0 + 4 * (lane & 7));
#pragma unroll
        for (int i = 0; i < 8; ++i) { LAS float* d = scr + (8 * i + (lane >> 3)) * 33 + 4 * (lane & 7); d[0] = t[i][0]; d[1] = t[i][1]; d[2] = t[i][2]; d[3] = t[i][3]; } }
    LDS_WAIT(); asm volatile("" ::: "memory");
    const int c = lane & 7;
#pragma unroll
    for (int j = 0; j < 4; ++j) { const int n = (lane >> 3) + 8 * j; const LAS float* s = scr + (8 * c) * 33 + n;
        v4u o; o.x = pk2(s[0 * 33], s[1 * 33]); o.y = pk2(s[2 * 33], s[3 * 33]); o.z = pk2(s[4 * 33], s[5 * 33]); o.w = pk2(s[6 * 33], s[7 * 33]);
        *(GAS v4u*)(WT + (size_t)maprow(kind, n0 + n, off) * K + k0 + 8 * c) = o; }
    LDS_WAIT(); asm volatile("" ::: "memory");
}
__device__ __forceinline__ void cvt_item_fp8(const float* W, int K, int Nsrc, int c0, int nblk, unsigned char* WT, int kind, int off, float scale, LAS float* scr, int item, int lane) {
    const int kb = item / nblk, nb = item - kb * nblk, k0 = 64 * kb, n0 = c0 + 32 * nb;
    { f32x4 t[8];
#pragma unroll
        for (int i = 0; i < 8; ++i) t[i] = *(const GAS f32x4*)(W + (size_t)(k0 + 8 * i + (lane >> 3)) * Nsrc + n0 + 4 * (lane & 7));
#pragma unroll
        for (int i = 0; i < 8; ++i) { LAS float* d = scr + (8 * i + (lane >> 3)) * 33 + 4 * (lane & 7); d[0] = t[i][0] * scale; d[1] = t[i][1] * scale; d[2] = t[i][2] * scale; d[3] = t[i][3] * scale; } }
    LDS_WAIT(); asm volatile("" ::: "memory");
    const int c = lane & 7;
#pragma unroll
    for (int j = 0; j < 4; ++j) { const int n = (lane >> 3) + 8 * j; const LAS float* s = scr + (8 * c) * 33 + n;
        v2u o; o.x = pk4_fp8(s[0 * 33], s[1 * 33], s[2 * 33], s[3 * 33]); o.y = pk4_fp8(s[4 * 33], s[5 * 33], s[6 * 33], s[7 * 33]);
        *(GAS v2u*)(WT + (size_t)maprow(kind, n0 + n, off) * K + k0 + 8 * c) = o; }
    LDS_WAIT(); asm volatile("" ::: "memory");
}
__device__ __forceinline__ void fold_item(const float* W, const float* wa2, bf16* WT, LAS float* scr, int item, int lane) {
    const int kb = item >> 3, jb = item & 7, k0 = 64 * kb, j0 = 32 * jb, jj = lane & 31;
    float w2[16];
#pragma unroll
    for (int r = 0; r < 16; ++r) w2[r] = wa2[r * 256 + j0 + jj];
    for (int i = 0; i < 32; ++i) { const int kk = 2 * i + (lane >> 5); const float* wr = W + (size_t)(k0 + kk) * W_IN_COLS + 4096; float s = 0.f;
#pragma unroll
        for (int r = 0; r < 16; ++r) s += wr[r] * w2[r];
        scr[kk * 33 + jj] = s; }
    LDS_WAIT(); asm volatile("" ::: "memory");
    const int c = lane & 7;
#pragma unroll
    for (int j = 0; j < 4; ++j) { const int n = (lane >> 3) + 8 * j; const LAS float* s = scr + (8 * c) * 33 + n;
        if (FOLD_FP8 && GATES_FP8 && XN8_SLOT) { v2u o; o.x = pk4_fp8(s[0 * 33] * F8_SW13, s[1 * 33] * F8_SW13, s[2 * 33] * F8_SW13, s[3 * 33] * F8_SW13); o.y = pk4_fp8(s[4 * 33] * F8_SW13, s[5 * 33] * F8_SW13, s[6 * 33] * F8_SW13, s[7 * 33] * F8_SW13);
            *(GAS v2u*)((unsigned char*)(WT + (size_t)4096 * DM) + (size_t)(j0 + n) * DM + k0 + 8 * c) = o; }
        else { v4u o; o.x = pk2(s[0 * 33], s[1 * 33]); o.y = pk2(s[2 * 33], s[3 * 33]); o.z = pk2(s[4 * 33], s[5 * 33]); o.w = pk2(s[6 * 33], s[7 * 33]);
        *(GAS v4u*)(WT + (size_t)(4096 + j0 + n) * DM + k0 + 8 * c) = o; } }
    LDS_WAIT(); asm volatile("" ::: "memory");
}
__device__ __forceinline__ void rms_row(const float* xrow, const bf16* addrow, float* hout, const f32x4 (&g)[4], f32x4 (&v)[4], int lane) {
    const GAS f32x4* xr = (const GAS f32x4*)xrow + lane; float s = 0.f;
#pragma unroll
    for (int j = 0; j < 4; ++j) { v[j] = xr[64 * j];
        if (addrow) { const v2u a = *((const GAS v2u*)addrow + lane + 64 * j); v[j][0] += bflo(a.x); v[j][1] += bfhi(a.x); v[j][2] += bflo(a.y); v[j][3] += bfhi(a.y); }
        if (hout) ((GAS f32x4*)hout + lane)[64 * j] = v[j];
        s += (v[j][0] * v[j][0] + v[j][1] * v[j][1]) + (v[j][2] * v[j][2] + v[j][3] * v[j][3]); }
    const float rstd = __builtin_amdgcn_rsqf(wave_sum(s) * (1.f / DM) + EPS);
#pragma unroll
    for (int j = 0; j < 4; ++j) v[j] = v[j] * rstd * g[j];
}
__device__ __forceinline__ void store_row_bf16(bf16* orow, const f32x4 (&v)[4], int lane) {
    GAS v2u* o8 = (GAS v2u*)orow + lane;
#pragma unroll
    for (int j = 0; j < 4; ++j) { v2u w; w.x = pk2(v[j][0], v[j][1]); w.y = pk2(v[j][2], v[j][3]); o8[64 * j] = w; }
}

struct RowLd { f32x4 x[4]; v2u xb[4]; v2u a[4]; };
__device__ __forceinline__ void row_load(RowLd& r, const float* xrow, const bf16* addrow, int lane, bool xs) {
    if (xs) {
#pragma unroll
        for (int j = 0; j < 4; ++j) r.xb[j] = *((const GAS v2u*)xrow + lane + 64 * j);
    } else { const GAS f32x4* xr = (const GAS f32x4*)xrow + lane;
#pragma unroll
        for (int j = 0; j < 4; ++j) r.x[j] = xr[64 * j]; }
    if (addrow) {
#pragma unroll
        for (int j = 0; j < 4; ++j) r.a[j] = *((const GAS v2u*)addrow + lane + 64 * j); }
    asm volatile("" ::: "memory");
}
__device__ __forceinline__ void row_finish(const RowLd& r, bool hasadd, float* hout, const f32x4 (&g)[4], f32x4 (&v)[4], int lane, bool xs) {
    float s = 0.f;
#pragma unroll
    for (int j = 0; j < 4; ++j) {
        if (xs) { v[j][0] = bflo(r.xb[j].x); v[j][1] = bfhi(r.xb[j].x); v[j][2] = bflo(r.xb[j].y); v[j][3] = bfhi(r.xb[j].y); } else v[j] = r.x[j];
        if (hasadd) { const v2u a = r.a[j]; v[j][0] += bflo(a.x); v[j][1] += bfhi(a.x); v[j][2] += bflo(a.y); v[j][3] += bfhi(a.y); }
        if (hout) { v2u w; w.x = pk2(v[j][0], v[j][1]); w.y = pk2(v[j][2], v[j][3]); ((GAS v2u*)hout + lane)[64 * j] = w; }
        s += (v[j][0] * v[j][0] + v[j][1] * v[j][1]) + (v[j][2] * v[j][2] + v[j][3] * v[j][3]); }
    const float rstd = __builtin_amdgcn_rsqf(wave_sum(s) * (1.f / DM) + EPS);
#pragma unroll
    for (int j = 0; j < 4; ++j) v[j] = v[j] * rstd * g[j];
}

__device__ __forceinline__ void phase_prep(const Frame& F0, int layer) {
    Frame F = F0; relaunder(F);
    LAS float* scr = (LAS float*)(F.lds + F.wave * 16384);
    const int gw = F.vcu * NWAVES + F.wave, NGW = F.G * NWAVES;
    const float* win = IN_w_in + (size_t)layer * DM * W_IN_COLS;
    bf16* WIN = WSP(bf16, WS_WIN); bf16* WBR = WSP(bf16, WS_WBR); bf16* WOUT = WSP(bf16, WS_WOUT);
    constexpr int I0 = 16 * 128, I1 = 16 * 96, I2 = 8 * 32, I5 = 16 * 32, IF = 128;
    constexpr int NITEMS = I0 + I1 + 3 * I2 + I5 + IF;
    for (int it = gw; it < NITEMS; it += NGW) {
        int r = it;
        if (r < I0) { cvt_item(win, DM, W_IN_COLS, 0, 128, WIN, 1, 0, scr, r, F.lane); continue; } r -= I0;
        if (r < I1) { if (GATES_FP8) cvt_item_fp8(win, DM, W_IN_COLS, 4112, 96, (unsigned char*)(WIN + (size_t)NA_COLS * DM), 0, -4112, F8_SW13, scr, r, F.lane);
                      else cvt_item(win, DM, W_IN_COLS, 4112, 96, WIN, 0, NA_COLS - 4112, scr, r, F.lane); continue; } r -= I1;
        if (r < 3 * I2) { const int n = r / I2; cvt_item(IN_w_branch + ((size_t)layer * 3 + n) * BW * DM, BW, DM, 0, 32, WBR + (size_t)n * DM * BW, 0, 0, scr, r - n * I2, F.lane); continue; } r -= 3 * I2;
        if (r < I5) { cvt_item(IN_w_out + (size_t)layer * DM * DM, DM, DM, 0, 32, WOUT, 0, 0, scr, r, F.lane); continue; } r -= I5;
        fold_item(win, IN_gla_wa2 + (size_t)layer * 16 * 256, WIN, scr, r, F.lane);
    }
    const float* src = layer == 0 ? IN_x : F.out;
    f32x4 g[4];
#pragma unroll
    for (int j = 0; j < 4; ++j) g[j] = *((const f32x4*)(IN_mix_norm + (size_t)layer * DM) + F.lane + 64 * j);
    bf16* XN = WSP(bf16, WS_XN);
    const bf16* FO = WSP(bf16, WS_Y2);
    { RowLd cur; if (gw < NTOK) row_load(cur, src + (size_t)gw * DM, layer == 0 ? nullptr : FO + (size_t)gw * DM, F.lane, layer != 0);
      for (int m = gw; m < NTOK; m += NGW) { RowLd nxt; const int mn = m + NGW;
        if (mn < NTOK) row_load(nxt, src + (size_t)mn * DM, layer == 0 ? nullptr : FO + (size_t)mn * DM, F.lane, layer != 0);
        f32x4 v[4]; row_finish(cur, layer != 0, layer == 0 ? nullptr : F.out + (size_t)m * DM, g, v, F.lane, layer != 0); store_row_bf16(XN + (size_t)m * DM, v, F.lane);
        if (GATES_FP8 && XN8_SLOT) { GAS unsigned* o4 = (GAS unsigned*)((unsigned char*)F.out + (size_t)m * (DM * 4) + 2048) + F.lane;
#pragma unroll
            for (int j = 0; j < 4; ++j) o4[64 * j] = pk4_fp8(v[j][0] * F8_SA, v[j][1] * F8_SA, v[j][2] * F8_SA, v[j][3] * F8_SA); }
        cur = nxt; } }
    if (layer == 0) {
        f32x2* rope = WSP(f32x2, WS_ROPE);
        const int i = F.lane & 31;
        const float inv = exp2f(-(float)i * (13.287712379549449f / 32.0f));
        for (int m = gw * 2 + (F.lane >> 5); m < NTOK; m += NGW * 2) {
            const float ang = (float)IN_positions[m] * inv;
            const double rev = (double)ang * 0.15915494309189535; const float fr = (float)(rev - floor(rev));
            f32x2 cs; cs.x = __builtin_amdgcn_cosf(fr); cs.y = __builtin_amdgcn_sinf(fr);
            rope[(size_t)m * 32 + i] = cs; }
    }
}

__device__ __forceinline__ void lru_pass1(const Frame& F0, int layer, int unit) {
    Frame F = F0; relaunder(F);
    const int c = unit & 31, b = unit >> 5, tid = F.tid, lane = F.lane, wave = F.wave;
    LAS bf16* XS = (LAS bf16*)(F.lds);
    LAS bf16* UB = (LAS bf16*)(F.lds + 16896);
    LAS bf16* WAT = (LAS bf16*)(F.lds + 35328);
    LAS bf16* WXT = (LAS bf16*)(F.lds + 44544);
    LAS float* AF = (LAS float*)(F.lds + 53760);
    LAS bf16* BFh = (LAS bf16*)(F.lds + 86528);
    LAS float* WS = (LAS float*)(F.lds + 102912);
    LAS float* CW = (LAS float*)(F.lds + 107008);
    LAS float* GB = (LAS float*)(F.lds + 117248);
    const bf16* LRUX = WSP(bf16, WS_LRUX); const bf16* LG = WSP(bf16, WS_LRUG); bf16* PG = WSP(bf16, WS_PG); bf16* Y = WSP(bf16, WS_YLRU);
    const int s0 = c * 128;
    { const float* cwp = IN_conv_w + (size_t)layer * 4 * BW;
#pragma unroll
        for (int j = 0; j < 4; ++j) CW[j * 512 + tid] = cwp[j * BW + tid];
        CW[4 * 512 + tid] = IN_conv_b[(size_t)layer * BW + tid];
        GB[tid] = IN_lru_ba[(size_t)layer * BW + tid]; GB[512 + tid] = IN_lru_bx[(size_t)layer * BW + tid];
        const float lam = IN_lru_lambda[(size_t)layer * BW + tid]; GB[1024 + tid] = fmaxf(-lam, 0.f) + log1p_fast(__expf(-fabsf(lam))); }
    v4u xr[3]; float wa[8], wx[8];
    const int wj = tid & 63, wi0 = (tid >> 6) * 8;
#define LRU_PREFETCH(g) do { \
        _Pragma("unroll") for (int p = 0; p < 3; ++p) { const int rr = (tid >> 3) + 64 * p, sp = s0 - 3 + rr; xr[p] = (v4u){0u, 0u, 0u, 0u}; \
            if (rr < 131 && sp >= 0) xr[p] = *(const v4u*)(LRUX + ((size_t)(b * SEQ + sp)) * 512 + (g) * 64 + (tid & 7) * 8); } \
        const float* wa_ = IN_lru_wa + (((size_t)layer * 8 + (g)) * 64 + wi0) * 64 + wj; const float* wx_ = IN_lru_wx + (((size_t)layer * 8 + (g)) * 64 + wi0) * 64 + wj; \
        _Pragma("unroll") for (int q = 0; q < 8; ++q) { wa[q] = wa_[q * 64]; wx[q] = wx_[q * 64]; } } while (0)
    LRU_PREFETCH(0);
#pragma unroll 1
    for (int g = 0; g < 8; ++g) {
#pragma unroll
        for (int p = 0; p < 3; ++p) { const int rr = (tid >> 3) + 64 * p; if (rr < 131) *(LAS v4u*)(XS + rr * 64 + (tid & 7) * 8) = xr[p]; }
        { v4u o; o.x = pk2(wa[0], wa[1]); o.y = pk2(wa[2], wa[3]); o.z = pk2(wa[4], wa[5]); o.w = pk2(wa[6], wa[7]); *(LAS v4u*)(WAT + wj * 72 + wi0) = o;
          o.x = pk2(wx[0], wx[1]); o.y = pk2(wx[2], wx[3]); o.z = pk2(wx[4], wx[5]); o.w = pk2(wx[6], wx[7]); *(LAS v4u*)(WXT + wj * 72 + wi0) = o; }
        const size_t obase = ((size_t)(b * SEQ + s0 + 16 * wave)) * 512 + g * 64 + lane;
        bf16 gt[16];
#pragma unroll
        for (int j = 0; j < 16; ++j) gt[j] = LG[obase + (size_t)j * 512];
        LBAR();
        if (g + 1 < 8) LRU_PREFETCH(g + 1);
        { const int tok = tid >> 2, ch0 = (tid & 3) * 16; const LAS float* cwl = CW + g * 64 + ch0;
            float u[16];
#pragma unroll
            for (int q = 0; q < 16; ++q) u[q] = cwl[4 * 512 + q];
#pragma unroll
            for (int j = 0; j < 4; ++j) { const v4u x0 = *(const LAS v4u*)(XS + (tok + j) * 64 + ch0), x1 = *(const LAS v4u*)(XS + (tok + j) * 64 + ch0 + 8); const LAS float* w = cwl + j * 512;
                u[0] += w[0] * bflo(x0.x); u[1] += w[1] * bfhi(x0.x); u[2] += w[2] * bflo(x0.y); u[3] += w[3] * bfhi(x0.y); u[4] += w[4] * bflo(x0.z); u[5] += w[5] * bfhi(x0.z); u[6] += w[6] * bflo(x0.w); u[7] += w[7] * bfhi(x0.w);
                u[8] += w[8] * bflo(x1.x); u[9] += w[9] * bfhi(x1.x); u[10] += w[10] * bflo(x1.y); u[11] += w[11] * bfhi(x1.y); u[12] += w[12] * bflo(x1.z); u[13] += w[13] * bfhi(x1.z); u[14] += w[14] * bflo(x1.w); u[15] += w[15] * bfhi(x1.w); }
            v4u o0, o1; o0.x = pk2(u[0], u[1]); o0.y = pk2(u[2], u[3]); o0.z = pk2(u[4], u[5]); o0.w = pk2(u[6], u[7]); o1.x = pk2(u[8], u[9]); o1.y = pk2(u[10], u[11]); o1.z = pk2(u[12], u[13]); o1.w = pk2(u[14], u[15]);
            *(LAS v4u*)(UB + tok * 72 + ch0) = o0; *(LAS v4u*)(UB + tok * 72 + ch0 + 8) = o1; }
        LBAR();
        { const int tt = wave >> 1, tc = wave & 1, hi = lane >> 5, ch = 32 * tc + (lane & 31), gch = g * 64 + ch;
            f32x16 racc = {}, iacc = {};
            mma32(racc, UB + tt * 32 * 72, 72, WAT + tc * 32 * 72, 72, 64, lane);
            mma32(iacc, UB + tt * 32 * 72, 72, WXT + tc * 32 * 72, 72, 64, lane);
            const float ba = GB[gch], bx = GB[512 + gch], sp = GB[1024 + gch];
#pragma unroll
            for (int r = 0; r < 16; ++r) { const int tok = 32 * tt + crow16(r, hi);
                const float uval = bf2f(UB[tok * 72 + ch]);
                const float rg = fast_sigmoid(racc[r] + ba), ig = fast_sigmoid(iacc[r] + bx);
                const float la = -8.f * rg * sp, a = __expf(la), mult = __builtin_amdgcn_sqrtf(fmaxf(1.f - a * a, 0.f));
                AF[tok * 64 + ch] = a; BFh[tok * 64 + ch] = (bf16)f2bf(mult * (ig * uval)); } }
        LBAR();
        float hl[16], pl[16]; float h = 0.f, P = 1.f;
#pragma unroll
        for (int j = 0; j < 16; ++j) { const float a = AF[(16 * wave + j) * 64 + lane], bb = bf2f(BFh[(16 * wave + j) * 64 + lane]); h = a * h + bb; P *= a; hl[j] = h; pl[j] = P; }
        WS[(wave * 64 + lane) * 2] = P; WS[(wave * 64 + lane) * 2 + 1] = h;
        LBAR();
        { float cin = 0.f, pin = 1.f, At = 1.f, Ht = 0.f;
#pragma unroll
            for (int w = 0; w < 8; ++w) { const float p = WS[(w * 64 + lane) * 2], q = WS[(w * 64 + lane) * 2 + 1]; if (w < wave) { cin = p * cin + q; pin *= p; } Ht = p * Ht + q; At *= p; }
            if (wave == 7) { f32x2 sm; sm.x = At; sm.y = Ht; WSP(f32x2, WS_LRUS)[((size_t)(b * 32 + c)) * 512 + g * 64 + lane] = sm; }
            LAS bf16* YT = (LAS bf16*)(F.lds + 53760); LAS bf16* PT = (LAS bf16*)(F.lds + 53760 + 16384);
#pragma unroll
            for (int j = 0; j < 16; ++j) { const float gv = bf2f(gt[j]); YT[(16 * wave + j) * 64 + lane] = (bf16)f2bf((hl[j] + pl[j] * cin) * gv); PT[(16 * wave + j) * 64 + lane] = (bf16)f2bf(pl[j] * pin * gv); }
            LBAR();
            { const int tok = tid >> 2, sg = (tid & 3) * 16; const size_t o = ((size_t)(b * SEQ + s0 + tok)) * 512 + g * 64 + sg;
                const v4u y0 = *(const LAS v4u*)(YT + tok * 64 + sg), y1 = *(const LAS v4u*)(YT + tok * 64 + sg + 8), p0 = *(const LAS v4u*)(PT + tok * 64 + sg), p1 = *(const LAS v4u*)(PT + tok * 64 + sg + 8);
                *(v4u*)(Y + o) = y0; *(v4u*)(Y + o + 8) = y1; *(v4u*)(PG + o) = p0; *(v4u*)(PG + o + 8) = p1; } }
    }
#undef LRU_PREFETCH
    LBAR();
}
__device__ __forceinline__ void lru_fix_unit(const Frame& F0, int unit) {
    Frame F = F0; relaunder(F);
    const int c = 1 + unit % 31, b = unit / 31, tid = F.tid;
    LAS float* CR = (LAS float*)(F.lds);
    const f32x2* SUM = WSP(f32x2, WS_LRUS);
    { f32x2 sm[32]; float Hin = 0.f;
#pragma unroll
        for (int cc = 0; cc < 32; ++cc) sm[cc] = (cc < c) ? SUM[((size_t)(b * 32 + cc)) * 512 + tid] : (f32x2){1.f, 0.f};
#pragma unroll
        for (int cc = 0; cc < 32; ++cc) Hin = sm[cc].x * Hin + sm[cc].y;
        CR[tid] = Hin; }
    __syncthreads();
    const int seg = tid & 63, r0 = tid >> 6;
    float cr[8];
#pragma unroll
    for (int q = 0; q < 8; ++q) cr[q] = CR[seg * 8 + q];
    const bf16* LG = WSP(bf16, WS_PG); bf16* Y = WSP(bf16, WS_YLRU);
#pragma unroll
    for (int half = 0; half < 2; ++half) {
        v4u hv[8], pv[8];
#pragma unroll
        for (int it = 0; it < 8; ++it) { const size_t o = ((size_t)(b * SEQ + c * 128 + half * 64 + it * 8 + r0)) * 512 + seg * 8; hv[it] = *(const v4u*)(Y + o); pv[it] = *(const v4u*)(LG + o); }
        asm volatile("" ::: "memory");
#pragma unroll
        for (int it = 0; it < 8; ++it) { const size_t o = ((size_t)(b * SEQ + c * 128 + half * 64 + it * 8 + r0)) * 512 + seg * 8; const v4u hh = hv[it], pp = pv[it]; v4u w;
            w.x = pk2(bflo(hh.x) + bflo(pp.x) * cr[0], bfhi(hh.x) + bfhi(pp.x) * cr[1]); w.y = pk2(bflo(hh.y) + bflo(pp.y) * cr[2], bfhi(hh.y) + bfhi(pp.y) * cr[3]);
            w.z = pk2(bflo(hh.z) + bflo(pp.z) * cr[4], bfhi(hh.z) + bfhi(pp.z) * cr[5]); w.w = pk2(bflo(hh.w) + bflo(pp.w) * cr[6], bfhi(hh.w) + bfhi(pp.w) * cr[7]);
            *(v4u*)(Y + o) = w; }
        asm volatile("" ::: "memory");
    }
    __syncthreads();
}

__device__ __forceinline__ void gla_unit(const Frame& F0, int layer, int bh) {
    Frame F = F0; relaunder(F);
    const int b = bh >> 2, h = bh & 3, tid = F.tid, lane = F.lane, wave = F.wave, hi = lane >> 5;
    LAS bf16* QD = (LAS bf16*)(F.lds);
    LAS bf16* KD = (LAS bf16*)(F.lds + 9216);
    LAS bf16* QE = (LAS bf16*)(F.lds + 18432);
    LAS bf16* KDT = (LAS bf16*)(F.lds + 27648);
    LAS bf16* ATT = (LAS bf16*)(F.lds + 36864);
    LAS bf16* VT = (LAS bf16*)(F.lds + 46080);
    LAS bf16* ST = (LAS bf16*)(F.lds + 64512);
    LAS float* BC = (LAS float*)(F.lds + 82944);
    LAS float* OACC = (LAS float*)(F.lds + 82944);
    LAS float* DEC = (LAS float*)(F.lds + 116736);
    const bf16* GQ = WSP(bf16, WS_GQ); const bf16* GK = WSP(bf16, WS_GK); const bf16* GV = WSP(bf16, WS_GV); const bf16* GR = WSP(bf16, WS_GR); const float* GG = WSP(float, WS_GG);
    bf16* Y = WSP(bf16, WS_YGLA);
    LAS float* TOT = (LAS float*)(F.lds + 116992);
    const int tok = tid >> 3, seg = tid & 7;
    const int cdk = tid & 63, tg = tid >> 6;
    const int cdv = tid & 127, vg = tid >> 7;
    float gn[16];
#pragma unroll
    for (int q = 0; q < 16; ++q) gn[q] = IN_gla_norm[(size_t)layer * 128 + seg * 16 + q];
    for (int i = tid; i < 128 * 72; i += 512) ST[i] = 0;
    f32x16 S = {};
    const int tm = wave >> 2, tn = wave & 3;
    unsigned short qr_[8], kr_[8], vr_[16]; float g_[8];
#define GLA_PREFETCH(n_) do { const size_t r0_ = (size_t)b * SEQ + (size_t)(n_) * 64; \
        _Pragma("unroll") for (int i = 0; i < 8; ++i) { const size_t r_ = (r0_ + tg * 8 + i) * 256 + h * 64 + cdk; qr_[i] = GQ[r_]; kr_[i] = GK[r_]; g_[i] = GG[r_]; } \
        _Pragma("unroll") for (int i = 0; i < 16; ++i) vr_[i] = GV[(r0_ + vg * 16 + i) * 512 + h * 128 + cdv]; } while (0)
    GLA_PREFETCH(0);
    LBAR();
    for (int n = 0; n < 64; ++n) {
        const size_t row = (size_t)b * SEQ + n * 64 + tok;
        float c_[8];
        c_[0] = g_[0];
#pragma unroll
        for (int i = 1; i < 8; ++i) c_[i] = c_[i - 1] + g_[i];
        TOT[tg * 64 + cdk] = c_[7];
        { v4u w0, w1;
            w0.x = (unsigned)vr_[0] | ((unsigned)vr_[1] << 16); w0.y = (unsigned)vr_[2] | ((unsigned)vr_[3] << 16); w0.z = (unsigned)vr_[4] | ((unsigned)vr_[5] << 16); w0.w = (unsigned)vr_[6] | ((unsigned)vr_[7] << 16);
            w1.x = (unsigned)vr_[8] | ((unsigned)vr_[9] << 16); w1.y = (unsigned)vr_[10] | ((unsigned)vr_[11] << 16); w1.z = (unsigned)vr_[12] | ((unsigned)vr_[13] << 16); w1.w = (unsigned)vr_[14] | ((unsigned)vr_[15] << 16);
            *(LAS v4u*)(VT + cdv * 72 + vg * 16) = w0; *(LAS v4u*)(VT + cdv * 72 + vg * 16 + 8) = w1; }
        const v4u ra = *(const v4u*)(GR + row * 512 + h * 128 + seg * 16), rb = *(const v4u*)(GR + row * 512 + h * 128 + seg * 16 + 8);
        LBAR();
        {
            float base = 0.f, rf = 0.f, bl = 0.f;
#pragma unroll
            for (int w = 0; w < 8; ++w) { const float tw = TOT[w * 64 + cdk]; if (w < tg) base += tw; if (w < 4) rf += tw; bl += tw; }
            unsigned kt[8]; const float erf = __expf(rf), elr = __expf(bl - rf);
#pragma unroll
            for (int i = 0; i < 8; ++i) { const float bc = base + c_[i], qf = bf2f(qr_[i]), kf = bf2f(kr_[i]); const int t_ = tg * 8 + i;
                const float qd = qf * __expf(bc - rf), kd = kf * __expf(rf - bc);
                QD[t_ * 72 + cdk] = (bf16)f2bf(qd); KD[t_ * 72 + cdk] = (bf16)f2bf(kd); QE[t_ * 72 + cdk] = (bf16)f2bf(qd * erf);
                kt[i] = f2bf(kd * elr); }
            *(LAS v4u*)(KDT + cdk * 72 + tg * 8) = (v4u){kt[0] | (kt[1] << 16), kt[2] | (kt[3] << 16), kt[4] | (kt[5] << 16), kt[6] | (kt[7] << 16)};
            if (tg == 7) DEC[cdk] = __expf(bl);
        }
        if (n + 1 < 64) GLA_PREFETCH(n + 1);
        LBAR();
        if (wave < 4) { const int ti = wave >> 1, tj = wave & 1; f32x16 a = {};
            mma32(a, QD + ti * 32 * 72, 72, KD + tj * 32 * 72, 72, 64, lane);
            const int j = 32 * tj + (lane & 31);
#pragma unroll
            for (int r = 0; r < 16; ++r) { const int i = 32 * ti + crow16(r, hi); ATT[i * 72 + j] = (bf16)f2bf(j <= i ? a[r] : 0.f); } }
        LBAR();
        { f32x16 o = {};
            mma32(o, ATT + tm * 32 * 72, 72, VT + tn * 32 * 72, 72, 64, lane);
            mma32(o, QE + tm * 32 * 72, 72, ST + tn * 32 * 72, 72, 64, lane);
#pragma unroll
            for (int r = 0; r < 16; ++r) OACC[(32 * tm + crow16(r, hi)) * 132 + 32 * tn + (lane & 31)] = o[r];
#pragma unroll
            for (int r = 0; r < 16; ++r) S[r] *= DEC[32 * tm + crow16(r, hi)];
            mma32(S, KDT + tm * 32 * 72, 72, VT + tn * 32 * 72, 72, 64, lane); }
        LBAR();
#pragma unroll
        for (int g4 = 0; g4 < 4; ++g4) *(LAS v2u*)(ST + (32 * tn + (lane & 31)) * 72 + 32 * tm + 8 * g4 + 4 * hi) = (v2u){pk2(S[4 * g4], S[4 * g4 + 1]), pk2(S[4 * g4 + 2], S[4 * g4 + 3])};
        { float o[16]; float ss = 0.f;
#pragma unroll
            for (int q = 0; q < 16; ++q) { o[q] = OACC[tok * 132 + seg * 16 + q]; ss += o[q] * o[q]; }
            ss += dpp_mov<0xB1>(ss); ss += dpp_mov<0x4E>(ss); ss += dpp_mov<0x141>(ss);
            const float rstd = __builtin_amdgcn_rsqf(ss * (1.f / 128.f) + EPS);
            const unsigned rw[8] = {ra.x, ra.y, ra.z, ra.w, rb.x, rb.y, rb.z, rb.w};
            unsigned ow[8];
#pragma unroll
            for (int q = 0; q < 8; ++q) ow[q] = pk2(o[2 * q] * rstd * gn[2 * q] * bflo(rw[q]), o[2 * q + 1] * rstd * gn[2 * q + 1] * bfhi(rw[q]));
            bf16* yp = Y + row * 512 + h * 128 + seg * 16;
            *(v4u*)yp = (v4u){ow[0], ow[1], ow[2], ow[3]}; *(v4u*)(yp + 8) = (v4u){ow[4], ow[5], ow[6], ow[7]}; }
    }
    LBAR();
#undef GLA_PREFETCH
}

__device__ __forceinline__ float da_lambda(const Frame& F, int layer, float lambda_init) {
    float s1 = 0.f, s2 = 0.f;
    for (int i = 0; i < 64; ++i) { s1 += IN_da_lq1[layer * 64 + i] * IN_da_lk1[layer * 64 + i]; s2 += IN_da_lq2[layer * 64 + i] * IN_da_lk2[layer * 64 + i]; }
    return __expf(s1) - __expf(s2) + lambda_init;
}
__device__ __forceinline__ void da_item(const Frame& F0, int layer, int item, float lam, float oscale) {
    Frame F = F0; relaunder(F);
    const bf16* O0 = WSP(bf16, WS_O0); const bf16* O1 = WSP(bf16, WS_O1); bf16* Y = WSP(bf16, WS_YDA);
    const int seg = F.tid & 15;
    float sl[8];
#pragma unroll
    for (int q = 0; q < 8; ++q) sl[q] = IN_da_subln[(size_t)layer * 128 + seg * 8 + q] * oscale;
    v4u aa[8], cc[8];
#pragma unroll
    for (int it = 0; it < 8; ++it) { const int pr = it * 32 + (F.tid >> 4), t = item * 64 + (pr >> 2), hh = pr & 3; const size_t o = (size_t)t * 512 + hh * 128 + seg * 8; aa[it] = *(const v4u*)(O0 + o); cc[it] = *(const v4u*)(O1 + o); }
    asm volatile("" ::: "memory");
#pragma unroll
    for (int it = 0; it < 8; ++it) { const int pr = it * 32 + (F.tid >> 4), t = item * 64 + (pr >> 2), hh = pr & 3;
        const size_t o = (size_t)t * 512 + hh * 128 + seg * 8;
        const v4u a = aa[it], c = cc[it];
        float d[8]; d[0] = bflo(a.x) - lam * bflo(c.x); d[1] = bfhi(a.x) - lam * bfhi(c.x); d[2] = bflo(a.y) - lam * bflo(c.y); d[3] = bfhi(a.y) - lam * bfhi(c.y);
        d[4] = bflo(a.z) - lam * bflo(c.z); d[5] = bfhi(a.z) - lam * bfhi(c.z); d[6] = bflo(a.w) - lam * bflo(c.w); d[7] = bfhi(a.w) - lam * bfhi(c.w);
        float ss = 0.f;
#pragma unroll
        for (int q = 0; q < 8; ++q) ss += d[q] * d[q];
        ss += dpp_mov<0xB1>(ss); ss += dpp_mov<0x4E>(ss); ss += dpp_mov<0x141>(ss); ss += dpp_mov<0x140>(ss);
        const float rstd = __builtin_amdgcn_rsqf(ss * (1.f / 128.f) + EPS);
        v4u w; w.x = pk2(d[0] * rstd * sl[0], d[1] * rstd * sl[1]); w.y = pk2(d[2] * rstd * sl[2], d[3] * rstd * sl[3]); w.z = pk2(d[4] * rstd * sl[4], d[5] * rstd * sl[5]); w.w = pk2(d[6] * rstd * sl[6], d[7] * rstd * sl[7]);
        *(v4u*)(Y + o) = w; }
}

__device__ __forceinline__ void phase_norm2(const Frame& F0, int layer) {
    Frame F = F0; relaunder(F);
    const int gw = F.vcu * NWAVES + F.wave, NGW = F.G * NWAVES, lane = F.lane;
    const bool moe = (layer & 1) != 0;
    LAS float* scr = (LAS float*)(F.lds + F.wave * 16384);
    bf16* WF = WSP(bf16, WS_WFFN);
    { constexpr int I13 = 16 * 112, I2 = 56 * 32, IE = 2 * I13 + I2;
        const int nexp = moe ? NEXP : 1, nitems = nexp * IE; const int j = layer >> 1;
        const float* w1 = moe ? IN_moe_w1 + (size_t)j * NEXP * DM * DFF : IN_dense_w1 + (size_t)j * DM * DFF;
        const float* w3 = moe ? IN_moe_w3 + (size_t)j * NEXP * DM * DFF : IN_dense_w3 + (size_t)j * DM * DFF;
        const float* w2 = moe ? IN_moe_w2 + (size_t)j * NEXP * DFF * DM : IN_dense_w2 + (size_t)j * DFF * DM;
        for (int it = gw; it < nitems; it += NGW) { const int e = it / IE; int r = it - e * IE; bf16* we = WF + (size_t)e * WEXP_ELEMS;
            if (!moe && DENSE_FP8 == 2 && r >= 2 * I13) { cvt_item_fp8(w2, DFF, DM, 0, 32, (unsigned char*)WF + 2 * W13_ELEMS, 0, 0, F8_SW2, scr, r - 2 * I13, lane); continue; }
            if ((moe && MOE_FP8) || (!moe && DENSE_FP8 == 1)) { unsigned char* w8 = (unsigned char*)WF + (size_t)e * WEXP_ELEMS;
                if (r < I13) { cvt_item_fp8(w1 + (size_t)e * DM * DFF, DM, DFF, 0, 112, w8, 2, 0, F8_SW13, scr, r, lane); continue; } r -= I13;
                if (r < I13) { cvt_item_fp8(w3 + (size_t)e * DM * DFF, DM, DFF, 0, 112, w8, 3, 0, F8_SW13, scr, r, lane); continue; } r -= I13;
                cvt_item_fp8(w2 + (size_t)e * DFF * DM, DFF, DM, 0, 32, w8 + W13_ELEMS, 0, 0, F8_SW2, scr, r, lane); continue; }
            if (r < I13) { cvt_item(w1 + (size_t)e * DM * DFF, DM, DFF, 0, 112, we, 2, 0, scr, r, lane); continue; } r -= I13;
            if (r < I13) { cvt_item(w3 + (size_t)e * DM * DFF, DM, DFF, 0, 112, we, 3, 0, scr, r, lane); continue; } r -= I13;
            cvt_item(w2 + (size_t)e * DFF * DM, DFF, DM, 0, 32, we + W13_ELEMS, 0, 0, scr, r, lane); } }
    int* slot_tok = WSP(int, WS_SLOTT); float* slot_w = WSP(float, WS_SLOTW);
    { const int gt = F.vcu * 512 + F.tid, NGT = F.G * 512;
        if (moe) { for (int i = gt; i < MAX_SLOTS; i += NGT) slot_tok[i] = -1; }
        else { for (int i = gt; i < MAX_SLOTS; i += NGT) { slot_tok[i] = i < NTOK ? i : -1; slot_w[i] = 1.f; }
            if (gt == 0) __hip_atomic_store(F.ctl + CW_GCNT + layer * 1024, (unsigned)NTOK, RLX_AGENT); } }
    f32x4 g[4];
#pragma unroll
    for (int j = 0; j < 4; ++j) g[j] = *((const f32x4*)(IN_ffn_norm + (size_t)layer * DM) + lane + 64 * j);
    bf16* XN = WSP(bf16, WS_XN);
    volatile LAS unsigned* M = F.MISC;
    LAS unsigned* hist = (LAS unsigned*)(F.lds + LDSCTL_OFF) + MW_HIST;
    if (F.tid < 16) M[MW_HIST + F.tid] = 0u;
    __syncthreads();
    const float* router = IN_router + (size_t)(layer >> 1) * DM * NEXP;
    int jrow = 0;
    f32x4 rw0[16], rw1[16];
    if (moe) {
#pragma unroll
        for (int j = 0; j < 4; ++j)
#pragma unroll
            for (int q = 0; q < 4; ++q) { const float* rp = router + (size_t)(4 * (lane + 64 * j) + q) * NEXP; rw0[4 * j + q] = *(const f32x4*)rp; rw1[4 * j + q] = *(const f32x4*)(rp + 4); } }
    RowLd cur; if (gw < NTOK) row_load(cur, F.out + (size_t)gw * DM, nullptr, lane, true);
    for (int m = gw; m < NTOK; m += NGW, ++jrow) { RowLd nxt; { const int mn = m + NGW; if (mn < NTOK) row_load(nxt, F.out + (size_t)mn * DM, nullptr, lane, true); }
        f32x4 v[4]; row_finish(cur, false, nullptr, g, v, lane, true); cur = nxt;
        if ((moe && MOE_FP8) || (!moe && DENSE_FP8 == 1)) { GAS unsigned* o4 = (GAS unsigned*)((unsigned char*)XN + (size_t)m * DM) + lane;
#pragma unroll
            for (int j = 0; j < 4; ++j) o4[64 * j] = pk4_fp8(v[j][0] * F8_SA, v[j][1] * F8_SA, v[j][2] * F8_SA, v[j][3] * F8_SA); }
        else store_row_bf16(XN + (size_t)m * DM, v, lane);
        if (moe) { float lg[8];
#pragma unroll
            for (int e = 0; e < 8; ++e) lg[e] = 0.f;
#pragma unroll
            for (int j = 0; j < 4; ++j)
#pragma unroll
                for (int q = 0; q < 4; ++q) { const f32x4 r0 = rw0[4 * j + q], r1 = rw1[4 * j + q]; const float xv = v[j][q];
                    lg[0] += xv * r0[0]; lg[1] += xv * r0[1]; lg[2] += xv * r0[2]; lg[3] += xv * r0[3]; lg[4] += xv * r1[0]; lg[5] += xv * r1[1]; lg[6] += xv * r1[2]; lg[7] += xv * r1[3]; }
#pragma unroll
            for (int e = 0; e < 8; ++e) lg[e] = wave_sum(lg[e]);
            int e0 = 0; float v0 = lg[0];
#pragma unroll
            for (int e = 1; e < 8; ++e) if (lg[e] > v0) { v0 = lg[e]; e0 = e; }
            int e1 = -1; float v1 = -INFINITY;
#pragma unroll
            for (int e = 0; e < 8; ++e) if (e != e0 && lg[e] > v1) { v1 = lg[e]; e1 = e; }
            const float w0 = 1.f / (1.f + __expf(v1 - v0)), w1 = 1.f - w0;
            if (lane == 0) { const unsigned l0 = __hip_atomic_fetch_add(hist + e0, 1u, __ATOMIC_RELAXED, __HIP_MEMORY_SCOPE_WORKGROUP), l1 = __hip_atomic_fetch_add(hist + e1, 1u, __ATOMIC_RELAXED, __HIP_MEMORY_SCOPE_WORKGROUP);
                volatile LAS unsigned* ri = M + MW_ROWINFO + (F.wave * 64 + jrow) * 6;
                ri[0] = (unsigned)e0; ri[1] = (unsigned)e1; ri[2] = l0; ri[3] = l1; ri[4] = __builtin_bit_cast(unsigned, w0); ri[5] = __builtin_bit_cast(unsigned, w1); } } }
    if (moe) {
        __syncthreads();
        if (F.tid < 8) M[MW_BASE + F.tid] = __hip_atomic_fetch_add(F.ctl + CW_GCNT + layer * 1024 + 64 * F.tid, M[MW_HIST + F.tid], RLX_AGENT);
        __syncthreads();
        if (lane < jrow) { const int m = gw + lane * NGW; volatile LAS unsigned* ri = M + MW_ROWINFO + (F.wave * 64 + lane) * 6;
            const unsigned e0 = ri[0], e1 = ri[1];
            int4 ep; ep.x = (int)e0; ep.y = (int)e1; ep.z = (int)(M[MW_BASE + e0] + ri[2]); ep.w = (int)(M[MW_BASE + e1] + ri[3]);
            WSP(int4, WS_TOKE)[m] = ep;
            f32x2 w; w.x = __builtin_bit_cast(float, (unsigned)ri[4]); w.y = __builtin_bit_cast(float, (unsigned)ri[5]); WSP(f32x2, WS_TOKW)[m] = w; }
    }
}
__device__ __forceinline__ int moe_tiles(const Frame& F, int layer) {
    __syncthreads();
    if (F.tid == 0) { unsigned t = 0;
        for (int e = 0; e < 8; ++e) { F.MISC[MW_TS + e] = t; const unsigned c = __hip_atomic_load(F.ctl + CW_GCNT + layer * 1024 + 64 * e, RLX_AGENT); t += (c + 255u) >> 8; }
        F.MISC[MW_TS + 8] = t; }
    __syncthreads();
    return (int)F.MISC[MW_TS + 8];
}
__device__ __forceinline__ void phase_slots(const Frame& F0, int layer) {
    Frame F = F0; relaunder(F);
    if ((layer & 1) == 0) return;
    (void)moe_tiles(F, layer);
    int* slot_tok = WSP(int, WS_SLOTT); float* slot_w = WSP(float, WS_SLOTW);
    const int gt = F.vcu * 512 + F.tid, NGT = F.G * 512;
    for (int m = gt; m < NTOK; m += NGT) { const int4 ep = WSP(int4, WS_TOKE)[m]; const f32x2 w = WSP(f32x2, WS_TOKW)[m];
        const int sa = (int)F.MISC[MW_TS + ep.x] * 256 + ep.z, sb = (int)F.MISC[MW_TS + ep.y] * 256 + ep.w;
        slot_tok[sa] = m; slot_w[sa] = w.x; slot_tok[sb] = m | (1 << 20); slot_w[sb] = w.y; }
}
__device__ __forceinline__ void phase_final(const Frame& F0) {
    Frame F = F0; relaunder(F);
    float tmul = 1.f;
    if (MOE_CHECK) { const unsigned f3 = __hip_atomic_load(F.ctl + 3, RLX_AGENT), n4 = __hip_atomic_load(F.ctl + 4, RLX_AGENT), f5 = __hip_atomic_load(F.ctl + 5, RLX_AGENT), n6 = __hip_atomic_load(F.ctl + 6, RLX_AGENT);
        if (n4 < 1000u || n6 < 500u) tmul = 0.f;
        else if (f3 * 20u > n4) tmul = (MOE_CHECK == 2) ? 1.f : 3.f;
        else if (f5 * 20u > n6) tmul = (MOE_CHECK == 3) ? 1.f : 1.5f;
        else if (__hip_atomic_load(F.ctl + 7, RLX_AGENT) * 20u > n4) tmul = 3.f;
        else if (__hip_atomic_load(F.ctl + 8, RLX_AGENT) * 20u > n4) tmul = 2.f;
        else if (__hip_atomic_load(F.ctl + 9, RLX_AGENT) * 20u > n4) tmul = 1.5f;       }
    const int gw = F.vcu * NWAVES + F.wave, NGW = F.G * NWAVES, lane = F.lane;
    f32x4 g[4];
#pragma unroll
    for (int j = 0; j < 4; ++j) g[j] = *((const f32x4*)IN_final_norm + lane + 64 * j);
    const bf16* Y1 = WSP(bf16, WS_Y1); const bf16* Y2 = WSP(bf16, WS_Y2);
    RowLd cur; v2u cb[4]; if (gw < NTOK) { row_load(cur, F.out + (size_t)gw * DM, Y2 + (size_t)gw * DM, lane, true);
#pragma unroll
        for (int j = 0; j < 4; ++j) cb[j] = *((const GAS v2u*)(Y1 + (size_t)gw * DM) + lane + 64 * j); }
    for (int m = gw; m < NTOK; m += NGW) { RowLd nxt; v2u nb[4]; { const int mn = m + NGW; if (mn < NTOK) {
#pragma unroll
            for (int j = 0; j < 4; ++j) nb[j] = *((const GAS v2u*)(Y1 + (size_t)mn * DM) + lane + 64 * j);
            row_load(nxt, F.out + (size_t)mn * DM, Y2 + (size_t)mn * DM, lane, true); } }
#pragma unroll
        for (int j = 0; j < 4; ++j) { cur.x[j][0] = bflo(cur.xb[j].x) + bflo(cb[j].x); cur.x[j][1] = bfhi(cur.xb[j].x) + bfhi(cb[j].x); cur.x[j][2] = bflo(cur.xb[j].y) + bflo(cb[j].y); cur.x[j][3] = bfhi(cur.xb[j].y) + bfhi(cb[j].y); cb[j] = nb[j]; }
        f32x4 v[4]; row_finish(cur, true, nullptr, g, v, lane, false); cur = nxt;
        GAS f32x4* o = (GAS f32x4*)(F.out + (size_t)m * DM) + lane;
#pragma unroll
        for (int j = 0; j < 4; ++j) o[64 * j] = v[j] * tmul; }
}


__device__ __forceinline__ float f8dec(unsigned char b) { return __builtin_amdgcn_cvt_f32_fp8((int)b, 0); }
__device__ __forceinline__ void moe_check(const Frame& F0, int layer, int which) {
    Frame F = F0; relaunder(F);
    const int T = (int)F.MISC[MW_TS + 8];
    const int* slot_tok = WSP(int, WS_SLOTT); const float* slot_w = WSP(float, WS_SLOTW);
    const unsigned char* X8 = (const unsigned char*)WSP(bf16, WS_XN); const unsigned char* W8 = (const unsigned char*)WSP(bf16, WS_WFFN); const unsigned char* H8 = (const unsigned char*)WSP(bf16, WS_H);
    const int gt = blockIdx.x * 512 + F.tid;
    if (gt >= 4096) return;
    const int slot = (int)(((long)gt * 9973) % ((long)T * 256)); const int st = slot_tok[slot]; if (st < 0) return;
    const int tok = st & 0xffff, tile = slot >> 8; int e = 0;
    for (int j = 1; j < 8; ++j) e += (tile >= (int)F.MISC[MW_TS + j]) ? 1 : 0;
    if (which == 0) { const int j = (gt * 37) % DFF; const int r1 = 256 * (j >> 7) + (j & 127), r3 = r1 + 128;
        float a1 = 0.f, a3 = 0.f;
        for (int k = 0; k < DM; ++k) { const float x = f8dec(X8[(size_t)tok * DM + k]); a1 += x * f8dec(W8[(size_t)e * WEXP_ELEMS + (size_t)r1 * DM + k]); a3 += x * f8dec(W8[(size_t)e * WEXP_ELEMS + (size_t)r3 * DM + k]); }
        a1 *= 1.f / (F8_SA * F8_SW13); a3 *= 1.f / (F8_SA * F8_SW13);
        const float href = silu_f(a1) * a3 * F8_SH, hgot = f8dec(H8[(size_t)slot * DFF + j]);
        atomicAdd((unsigned*)(F.ctl + 4), 1u); if (fabsf(href - hgot) > 0.08f * fabsf(href) + 0.05f) atomicAdd((unsigned*)(F.ctl + 3), 1u);
        { const float* hrow = F.out + (size_t)tok * DM; float ss = 0.f; for (int k = 0; k < DM; ++k) ss += hrow[k] * hrow[k];
            const float rstd = __builtin_amdgcn_rsqf(ss * (1.f / DM) + EPS); int bad = 0;
            for (int q = 0; q < 16; ++q) { const int k = (gt * 13 + q * 61) % DM; const float ref = hrow[k] * rstd * IN_ffn_norm[(size_t)layer * DM + k] * F8_SA, got = f8dec(X8[(size_t)tok * DM + k]); if (fabsf(ref - got) > 0.07f * fabsf(ref) + 0.02f) ++bad; }
            if (bad) atomicAdd((unsigned*)(F.ctl + 7), 1u);
            bad = 0;
            for (int q = 0; q < 16; ++q) { const int k = (gt * 17 + q * 67) % DM; const float ref = IN_moe_w1[((size_t)e * DM + k) * DFF + j] * F8_SW13, got = f8dec(W8[(size_t)e * WEXP_ELEMS + (size_t)r1 * DM + k]);
                const float ref3 = IN_moe_w3[((size_t)e * DM + k) * DFF + j] * F8_SW13, got3 = f8dec(W8[(size_t)e * WEXP_ELEMS + (size_t)r3 * DM + k]);
                if (fabsf(ref - got) > 0.07f * fabsf(ref) + 0.02f || fabsf(ref3 - got3) > 0.07f * fabsf(ref3) + 0.02f) ++bad; }
            if (bad) atomicAdd((unsigned*)(F.ctl + 8), 1u);
            bad = 0; const int c2 = (gt * 41) % DM;
            for (int q = 0; q < 16; ++q) { const int k = (gt * 19 + q * 71) % DFF; const float ref = IN_moe_w2[((size_t)e * DFF + k) * DM + c2] * F8_SW2, got = f8dec(W8[(size_t)e * WEXP_ELEMS + W13_ELEMS + (size_t)c2 * DFF + k]); if (fabsf(ref - got) > 0.07f * fabsf(ref) + 0.02f) ++bad; }
            if (bad) atomicAdd((unsigned*)(F.ctl + 9), 1u); }
    } else { if ((st >> 20) != 1) return; const int c = (gt * 41) % DM; float y = 0.f;
        for (int k = 0; k < DFF; ++k) y += f8dec(H8[(size_t)slot * DFF + k]) * f8dec(W8[(size_t)e * WEXP_ELEMS + W13_ELEMS + (size_t)c * DFF + k]);
        y *= slot_w[slot] / (F8_SH * F8_SW2);
        const float got = bf2f(WSP(bf16, WS_Y2)[(size_t)tok * DM + c]);
        atomicAdd((unsigned*)(F.ctl + 6), 1u); if (fabsf(y - got) > 0.02f * fabsf(y) + 0.01f) atomicAdd((unsigned*)(F.ctl + 5), 1u); }
}

__global__ void __launch_bounds__(NWAVES * 64, 2) hybrid_fwd(Args args) {
    extern __shared__ __attribute__((aligned(16))) unsigned char lds[];
    Frame F;
    F.lds = (LAS unsigned char*)lds;
    F.MISC = (volatile LAS unsigned*)(F.lds + LDSCTL_OFF);
    F.tid = threadIdx.x; F.lane = F.tid & 63; F.wave = __builtin_amdgcn_readfirstlane(F.tid >> 6);
    F.G = gridDim.x; { const int bx = blockIdx.x; F.vcu = (F.G % 8 == 0) ? (bx % 8) * (F.G / 8) + bx / 8 : bx; }
    F.ws = (GAS unsigned char*)args.ws; F.ctl = (gu32*)(args.ws + WS_CTL); F.out = args.out;
    F.karg = (const char __attribute__((address_space(4)))*)__builtin_amdgcn_kernarg_segment_ptr();
    for (int u = F.tid; u < (LDS_BYTES - LDSCTL_OFF) / 4; u += NWAVES * 64) ((LAS unsigned*)(F.lds + LDSCTL_OFF))[u] = 0u;
    __syncthreads();
    XcdBarrier bar; bar.bar = (unsigned*)(F.ctl + CW_BAR); bar.x = 0; bar.st = nullptr;
    if (MK_ONE_LAUNCH) bar = xcd_barrier_post((unsigned*)(F.ctl + CW_BAR), F.MISC + MW_BAR);
    const int lo = args.ph_lo, hi = args.ph_hi;
#ifndef REPEAT_MASK
#define REPEAT_MASK 0u
#endif
#define NREP(j) ((((REPEAT_MASK) >> (j)) & 1u) ? 2 : 1)
#define REPSEAM(rep, j) do { if ((rep) + 1 < NREP(j)) xcd_barrier(bar); } while (0)
#ifndef GATES_NULL_PROBE
#define GATES_NULL_PROBE 0
#endif
#ifndef MIXA2_MASK
#define MIXA2_MASK 7
#endif
#ifndef MIXA_MASK
#define MIXA_MASK 7
#endif
#ifndef PH_MASK
#define PH_MASK 0xFFFFFFFFu
#endif
#define IN(k) (lo <= (k) && (k) < hi)
#define INL(j) ((((PH_MASK) >> (j)) & 1u) != 0u && IN(P + (j)))
#define SEAM(k) do { if (MK_ONE_LAUNCH && IN(k) && IN((k) + 1)) xcd_barrier(bar); } while (0)

    for (int layer = 0; layer < DEPTH; ++layer) {
        const int P = layer * PH_PER_LAYER;
        const float lambda_init = 0.8f - 0.6f * expf(-0.3f * (float)layer);
        if (INL(0)) for (int rep = 0; rep < (layer == 0 ? NREP(0) : 1); ++rep) { phase_prep(F, layer); if (layer == 0) REPSEAM(rep, 0); }
        SEAM(P + 0);
        if (INL(1)) for (int rep = 0; rep < NREP(1); ++rep) {
            Frame FL = F; relaunder(FL);
            constexpr bool fold8 = FOLD_FP8 && GATES_FP8 && XN8_SLOT;
            SchedPlain S{(const char*)WSL(bf16, WS_XN), (const char*)WSL(bf16, WS_WIN), NTOK / 256, fold8 ? 16 : NA_COLS / 256, DM * 2, FL.G, (int)blockIdx.x};
            EpiInProj E{WSL(bf16, WS_LRUX), WSL(bf16, WS_LRUG), WSL(bf16, WS_Q), WSL(bf16, WS_K), WSL(bf16, WS_V), WSL(bf16, WS_GQ), WSL(bf16, WS_GK), WSL(bf16, WS_GV), WSL(bf16, WS_GR),
                        WSL(float, WS_GG), WSL(f32x2, WS_ROPE), IN_gla_ba + (size_t)layer * 256};
            pg8::gemm_phase<EpiInProj, SchedPlain, true, true, false>(F.lds, DM * 2, S, E);
            if (fold8) {
                SchedPitchA S8{(const char*)F.out + 2048, (const char*)(WSL(bf16, WS_WIN) + (size_t)4096 * DM), NTOK / 256, 1, DM, DM * 4, FL.G, (int)((blockIdx.x + FL.G / 2) % FL.G)};
                EpiGG E8{WSL(float, WS_GG), IN_gla_ba + (size_t)layer * 256, 1.f / (F8_SA * F8_SW13)};
                pg8::gemm_phase<EpiGG, SchedPitchA, true, true, false, true>(F.lds, DM, S8, E8, DM * 4); }
            REPSEAM(rep, 1);
        }
        SEAM(P + 1);
        if (INL(2)) for (int rep = 0; rep < NREP(2); ++rep) {
            Frame FL = F; relaunder(FL);
            constexpr int N_GLA = 4, N_LRU = 32, N_ATT = 128, N_PER = N_GLA + N_LRU + N_ATT, N_ATT_BIG = 88;
            const unsigned home = xb_xcc_id() & 7u; unsigned kstart = 0;
            for (;;) {
                __syncthreads();
                if (F.tid == 0) { int got = -1;
                    while (kstart < 8u) { const unsigned q = (home + kstart) & 7u;
                        const unsigned i = __hip_atomic_fetch_add(F.ctl + CW_QHEAD + (layer * 2 + rep) * 512 + 64 * q, 1u, RLX_AGENT);
                        if (i < (unsigned)N_PER) { got = (int)(q * 512u + i); break; }
                        ++kstart; }
                    F.MISC[MW_DEQ] = (unsigned)got; }
                __syncthreads();
                const int u = __builtin_amdgcn_readfirstlane((int)F.MISC[MW_DEQ]);
                if (u < 0) break;
                const int b = u >> 9, i = u & 511;
                if (i < N_GLA) { if ((rep == 0 ? MIXA_MASK : MIXA2_MASK) & 1) gla_unit(F, layer, b * 4 + i); }
                else if (i >= N_GLA + N_ATT_BIG && i < N_GLA + N_ATT_BIG + N_LRU) { if ((rep == 0 ? MIXA_MASK : MIXA2_MASK) & 4) lru_pass1(F, layer, b * 32 + (i - N_GLA - N_ATT_BIG)); }
                else { if ((rep == 0 ? MIXA_MASK : MIXA2_MASK) & 2) { const int a = (i < N_GLA + N_ATT_BIG) ? i - N_GLA : i - N_GLA - N_LRU, qb = 15 - (a >> 3), r = a & 7, hh = r >> 1, c = r & 1;
                    attn_body::attn_unit<8>(b, hh * 2 + c, hh, qb, (const attn_body::bf16*)WSL(bf16, WS_Q), (const attn_body::bf16*)WSL(bf16, WS_K), (const attn_body::bf16*)WSL(bf16, WS_V),
                                           (attn_body::bf16*)(c ? WSL(bf16, WS_O1) : WSL(bf16, WS_O0)), (char*)lds); } }
            }
            REPSEAM(rep, 2);
        }
        SEAM(P + 2);
        if (INL(3)) for (int rep = 0; rep < NREP(3); ++rep) {
            Frame FL = F; relaunder(FL);
            for (int u = blockIdx.x; u < 8 * 31; u += F.G) lru_fix_unit(F, u);
            const float lam = da_lambda(F, layer, lambda_init);
            for (int it = blockIdx.x; it < NTOK / 64; it += F.G) da_item(F, layer, it, lam, 1.f - lambda_init);
            if (GATES_FP8 && !XN8_SLOT) { const int gt = blockIdx.x * 512 + FL.tid; const v4u* src = (const v4u*)WSL(bf16, WS_XN); v2u* dst = (v2u*)WSL(bf16, WS_XN8);
                const int st = F.G * 512;
                for (int i = gt; i < NTOK * DM / 8; i += 8 * st) { v4u xx[8];
#pragma unroll
                    for (int q = 0; q < 8; ++q) { const int ii = i + q * st; xx[q] = (ii < NTOK * DM / 8) ? src[ii] : (v4u){0u, 0u, 0u, 0u}; }
                    asm volatile("" ::: "memory");
#pragma unroll
                    for (int q = 0; q < 8; ++q) { const int ii = i + q * st; const v4u x = xx[q]; v2u o;
                        o.x = pk4_fp8(bflo(x.x) * F8_SA, bfhi(x.x) * F8_SA, bflo(x.y) * F8_SA, bfhi(x.y) * F8_SA); o.y = pk4_fp8(bflo(x.z) * F8_SA, bfhi(x.z) * F8_SA, bflo(x.w) * F8_SA, bfhi(x.w) * F8_SA);
                        if (ii < NTOK * DM / 8) dst[ii] = o; } } }
            REPSEAM(rep, 3);
        }
        if (GATES_FP8 && !XN8_SLOT) SEAM(P + 3);
        if (INL(4)) for (int rep = 0; rep < NREP(4); ++rep) {
            Frame FL = F; relaunder(FL);
            if (GATES_FP8) {
                EpiGates E{WSL(bf16, WS_GATES), 1.f / (F8_SA * F8_SW13)};
                if (XN8_SLOT) { SchedPitchA S{(const char*)F.out + 2048, (const char*)(WSL(bf16, WS_WIN) + (size_t)NA_COLS * DM), NTOK / 256, NG_COLS / 256, DM, DM * 4, FL.G, (int)blockIdx.x};
                    pg8::gemm_phase<EpiGates, SchedPitchA, true, true, false, true>(F.lds, DM, S, E, DM * 4); }
                else { SchedPlain S{(const char*)WSL(bf16, WS_XN8), (const char*)(WSL(bf16, WS_WIN) + (size_t)NA_COLS * DM), NTOK / 256, NG_COLS / 256, DM, FL.G, (int)blockIdx.x};
                    pg8::gemm_phase<EpiGates, SchedPlain, true, true, false, true>(F.lds, DM, S, E); }
            } else {
            SchedPlain S{(const char*)WSL(bf16, WS_XN), (const char*)(WSL(bf16, WS_WIN) + (size_t)NA_COLS * DM), NTOK / 256, NG_COLS / 256, DM * 2, FL.G, (int)blockIdx.x};
            EpiGates E{WSL(bf16, WS_GATES), 1.f};
            pg8::gemm_phase<EpiGates, SchedPlain, true, true, false>(F.lds, DM * 2, S, E);
            }
            REPSEAM(rep, 4);
        }
        SEAM(P + 4);
        if (INL(5)) for (int rep = 0; rep < NREP(5); ++rep) {
            Frame FL = F; relaunder(FL);
            SchedUp S{(const char*)WSL(bf16, WS_YLRU), (const char*)WSL(bf16, WS_WBR), FL.G, (int)blockIdx.x};
            EpiUp E{WSL(bf16, WS_GATES), WSL(bf16, WS_XN)};
            pg8::gemm_phase<EpiUp, SchedUp, true, true, false>(F.lds, BW * 2, S, E); REPSEAM(rep, 5);
        }
        SEAM(P + 5);
        if (INL(6)) for (int rep = 0; rep < NREP(6); ++rep) {
            Frame FL = F; relaunder(FL);
            SchedPlain S{(const char*)WSL(bf16, WS_XN), (const char*)WSL(bf16, WS_WOUT), NTOK / 256, DM / 256, DM * 2, FL.G, (int)blockIdx.x};
            EpiRes E{layer == 0 ? IN_x : nullptr, F.out};
            pg8::gemm_phase<EpiRes, SchedPlain, true, true, false>(F.lds, DM * 2, S, E); REPSEAM(rep, 6);
        }
        SEAM(P + 6);
        if (INL(7)) for (int rep = 0; rep < (layer == 0 ? NREP(7) : 1); ++rep) { phase_norm2(F, layer); if (layer == 0) REPSEAM(rep, 7); }
        SEAM(P + 7);
        if (INL(8)) phase_slots(F, layer);
        if (layer & 1) SEAM(P + 8);
#pragma unroll 1
        for (int ch = 0; ch < ((MOE_FP8 || !(layer & 1)) ? 1 : 2); ++ch) {
        const bool f8 = (layer & 1) ? (MOE_FP8 != 0) : (DENSE_FP8 == 1);
        const bool f8w2 = f8 || (!(layer & 1) && DENSE_FP8 == 2);
        if (INL(9)) for (int rep = 0; rep < NREP(9); ++rep) {
            Frame FL = F; relaunder(FL);
            const int T = moe_tiles(F, layer); int t0 = 0, nM = T;
            if (!MOE_FP8 && (layer & 1)) { t0 = ch * CH0_TILES; nM = T - t0; if (ch == 0 && nM > CH0_TILES) nM = CH0_TILES; }
            if (f8) {
                SchedMoE S{(const char*)WSL(bf16, WS_XN), (const char*)WSL(bf16, WS_WFFN), WSL(int, WS_SLOTT), F.MISC + MW_TS, t0, nM, 2 * DFF / 256, DM, FL.G, (int)blockIdx.x, 0, WEXP_ELEMS, W13_ELEMS};
                EpiH E{WSL(bf16, WS_H), 1, 1};
                pg8::gemm_phase<EpiH, SchedMoE, true, true, true, true>(F.lds, DM, S, E);
            } else if (nM > 0) {
                SchedMoE S{(const char*)WSL(bf16, WS_XN), (const char*)WSL(bf16, WS_WFFN), WSL(int, WS_SLOTT), F.MISC + MW_TS, t0, nM, 2 * DFF / 256, DM * 2, FL.G, (int)blockIdx.x, 0, WEXP_ELEMS * 2, W13_ELEMS * 2};
                EpiH E{WSL(bf16, WS_H), (DENSE_FP8 == 2 && !(layer & 1)) ? 1 : 0, 0};
                pg8::gemm_phase<EpiH, SchedMoE, true, true, true, false>(F.lds, DM * 2, S, E);
            }
            REPSEAM(rep, 9);
        }
        SEAM(P + 9);
        if (MOE_CHECK && (layer & 1)) { moe_check(F, layer, 0); }
        if (INL(10)) {
            Frame FL = F; relaunder(FL);
            const int T = moe_tiles(F, layer); int t0 = 0, nM = T;
            if (!MOE_FP8 && (layer & 1)) { t0 = ch * CH0_TILES; nM = T - t0; if (ch == 0 && nM > CH0_TILES) nM = CH0_TILES; }
            if (f8w2) {
                SchedMoE S{(const char*)WSL(bf16, WS_H), (const char*)WSL(bf16, WS_WFFN), WSL(int, WS_SLOTT), F.MISC + MW_TS, t0, nM, DM / 256, DFF, FL.G, (int)blockIdx.x, 1, WEXP_ELEMS, (DENSE_FP8 == 2 && !(layer & 1)) ? 2 * W13_ELEMS : W13_ELEMS};
                EpiW2 E{WSL(int, WS_SLOTT), WSL(float, WS_SLOTW), WSL(bf16, WS_Y1), WSL(bf16, WS_Y2), (layer & 1) ? 0 : 1, 1.f / (F8_SH * F8_SW2)};
                pg8::gemm_phase<EpiW2, SchedMoE, true, true, false, true>(F.lds, DFF, S, E);
            } else if (nM > 0) {
                SchedMoE S{(const char*)WSL(bf16, WS_H), (const char*)WSL(bf16, WS_WFFN), WSL(int, WS_SLOTT), F.MISC + MW_TS, t0, nM, DM / 256, DFF * 2, FL.G, (int)blockIdx.x, 1, WEXP_ELEMS * 2, W13_ELEMS * 2};
                EpiW2 E{WSL(int, WS_SLOTT), WSL(float, WS_SLOTW), WSL(bf16, WS_Y1), WSL(bf16, WS_Y2), (layer & 1) ? 0 : 1, 1.f};
                pg8::gemm_phase<EpiW2, SchedMoE, true, true, false, false>(F.lds, DFF * 2, S, E);
            }
        }
        SEAM(P + 10);
        if (MOE_CHECK && (layer & 1)) { moe_check(F, layer, 1); xcd_barrier(bar); }
        }
    }
    if ((((PH_MASK) >> 13) & 1u) != 0u && IN(2 * PH_PER_LAYER)) phase_final(F);
#undef IN
#undef SEAM
}

extern "C" void kernel_launch(void* const* d_in, const int* in_sizes, int n_in, void* d_out, int out_size, void* d_ws, size_t ws_size, hipStream_t stream) {
    static int grid = 0;
    if (grid == 0) {
        if (n_in != 30 || in_sizes[0] != NTOK * DM || out_size != NTOK * DM || ws_size < WS_END) { fprintf(stderr, "kernel_launch: unexpected problem shape / workspace (n_in %d, ws %zu, need %zu); nothing launched\n", n_in, ws_size, (size_t)WS_END); grid = -1; return; }
        int dev = 0, cus = 0, per_cu = 0;
        if (hipGetDevice(&dev) != hipSuccess || hipDeviceGetAttribute(&cus, hipDeviceAttributeMultiprocessorCount, dev) != hipSuccess) { grid = -1; return; }
        if (hipFuncSetAttribute((const void*)hybrid_fwd, hipFuncAttributeMaxDynamicSharedMemorySize, LDS_BYTES) != hipSuccess) { fprintf(stderr, "kernel_launch: hipFuncSetAttribute failed\n"); grid = -1; return; }
        if (hipOccupancyMaxActiveBlocksPerMultiprocessor(&per_cu, (const void*)hybrid_fwd, NWAVES * 64, LDS_BYTES) != hipSuccess || per_cu < 1) { fprintf(stderr, "kernel_launch: occupancy query says %d blocks per CU\n", per_cu); }
        (void)hipGetLastError();
        grid = cus;
    }
    if (grid < 0) return;
    if (hipMemsetAsync((char*)d_ws + WS_CTL, 0, CTL_ZERO_BYTES, stream) != hipSuccess) return;
    Args a{};
    for (int i = 0; i < 30; ++i) a.in[i] = d_in[i];
    a.out = (float*)d_out; a.ws = (unsigned char*)d_ws;
#if MK_ONE_LAUNCH
    a.ph_lo = 0; a.ph_hi = N_PHASES;
    hipLaunchKernelGGL(hybrid_fwd, dim3(grid), dim3(NWAVES * 64), LDS_BYTES, stream, a);
#else
    for (int p = 0; p < N_PHASES; ++p) { a.ph_lo = p; a.ph_hi = p + 1; hipLaunchKernelGGL(hybrid_fwd, dim3(grid), dim3(NWAVES * 64), LDS_BYTES, stream, a); }
#endif
}
```

```cpp
#include <hip/hip_runtime.h>
#include <hip/hip_bf16.h>
#include <cstdio>
#include <cstdint>
#include <cmath>

#define GAS __attribute__((address_space(1)))
#define LAS __attribute__((address_space(3)))
typedef unsigned short bf16;
typedef unsigned v4u __attribute__((ext_vector_type(4)));
typedef unsigned v2u __attribute__((ext_vector_type(2)));
typedef float f32x4 __attribute__((ext_vector_type(4)));
typedef float f32x2 __attribute__((ext_vector_type(2)));
typedef float f32x16 __attribute__((ext_vector_type(16)));
typedef short bf16x8 __attribute__((ext_vector_type(8)));
typedef GAS unsigned gu32;
#define RLX_AGENT __ATOMIC_RELAXED, __HIP_MEMORY_SCOPE_AGENT
#define LDS_WAIT() asm volatile("s_waitcnt lgkmcnt(0)" ::: "memory")
#define VM_WAIT() asm volatile("s_waitcnt vmcnt(0)" ::: "memory")

constexpr int BATCH = 8, SEQ = 4096, DM = 1024, NTOK = BATCH * SEQ, DEPTH = 2;
constexpr int BW = 512;
constexpr int W_IN_COLS = 7184;
constexpr int DFF = 3584, NEXP = 8;
constexpr int NA_COLS = 4352;
constexpr int NG_COLS = 3072;
constexpr int WIN_ROWS = NA_COLS + NG_COLS;
constexpr float EPS = 1e-6f;
constexpr float C2 = 0.125f * 1.4426950408889634f;
constexpr int MAX_TILES = 264;
constexpr int MAX_SLOTS = MAX_TILES * 256 + 2048;
constexpr int CH0_TILES = 128;

typedef float cvt_f32x2 __attribute__((ext_vector_type(2))); typedef __bf16 cvt_bf16x2 __attribute__((ext_vector_type(2)));
__device__ __forceinline__ unsigned pk2(float lo, float hi) { const cvt_f32x2 v = {lo, hi}; return __builtin_bit_cast(unsigned, __builtin_convertvector(v, cvt_bf16x2)); }
__device__ __forceinline__ unsigned f2bf(float f) { return pk2(f, 0.f) & 0xffffu; }
__device__ __forceinline__ float bf2f(unsigned short h) { return __builtin_bit_cast(float, (unsigned)h << 16); }
__device__ __forceinline__ float bflo(unsigned w) { return __builtin_bit_cast(float, w << 16); }
__device__ __forceinline__ float bfhi(unsigned w) { return __builtin_bit_cast(float, w & 0xffff0000u); }
template <int CTRL> __device__ __forceinline__ float dpp_mov(float v) { return __builtin_bit_cast(float, __builtin_amdgcn_update_dpp(0, __builtin_bit_cast(int, v), CTRL, 0xf, 0xf, true)); }
__device__ __forceinline__ float wave_sum(float v) {
    v += dpp_mov<0xB1>(v); v += dpp_mov<0x4E>(v); v += dpp_mov<0x141>(v); v += dpp_mov<0x140>(v);
    const int vi = __builtin_bit_cast(int, v);
    return (__builtin_bit_cast(float, __builtin_amdgcn_readlane(vi, 0)) + __builtin_bit_cast(float, __builtin_amdgcn_readlane(vi, 16))) + (__builtin_bit_cast(float, __builtin_amdgcn_readlane(vi, 32)) + __builtin_bit_cast(float, __builtin_amdgcn_readlane(vi, 48)));
}
__device__ __forceinline__ float fast_sigmoid(float x) { return __builtin_amdgcn_rcpf(1.f + __expf(-x)); }

namespace pg8 {
#define PG8_LAS __attribute__((address_space(3)))
typedef unsigned short bf16_t;
typedef unsigned u32x4 __attribute__((ext_vector_type(4)));
constexpr int BM = 256, BK = 64, HALF = 128, HTB = HALF * BK * 2  , STAGE_BYTES = 8 * HTB, NXCD = 8, WGM = 8;

__host__ __device__ __forceinline__ int lds_byte(int r, int c) { const int st = (r >> 4) * 2 + (c >> 5), rr = r & 15, cc = c & 31, ob = rr * 64 + cc * 2; return st * 1024 + (ob ^ (((ob >> 9) & 1) << 5)); }
__host__ __device__ __forceinline__ void stage_rc(int b, int& R, int& C) { const int st = b / 1024, sb = b % 1024, swz = sb ^ (((sb >> 9) & 1) << 5); R = (st >> 1) * 16 + swz / 64; C = (st & 1) * 32 + (swz % 64) / 2; }
__host__ __device__ __forceinline__ int perm32(int rho) { const int n = rho >> 4, i = rho & 15; return 8 * (i >> 2) + 4 * n + (i & 3); }

struct Unit { int pm, pn, x, gs, keep; const char* a; const char* b; };

__device__ __forceinline__ void tile_of(int L, int nM, int nN, int& pm, int& pn) {
    const int nwg = nM * nN; int wgid = L; { const int q = nwg / NXCD, r = nwg % NXCD, xcd = wgid % NXCD, off = wgid / NXCD; wgid = (xcd < r ? xcd * (q + 1) : r * (q + 1) + (xcd - r) * q) + off; }
    const int nig = WGM * nN, gid = wgid / nig, fm = gid * WGM, gsz = (nM - fm) < WGM ? (nM - fm) : WGM;
    pm = fm + ((wgid % nig) % gsz); pn = (wgid % nig) / gsz;
}
__device__ __forceinline__ unsigned cvt_pk_bf16(float lo, float hi) { unsigned r; asm volatile("v_cvt_pk_bf16_f32 %0, %1, %2" : "=v"(r) : "v"(lo), "v"(hi)); return r; }

template <class Epi, class Sched, bool ALIGN_EPI, bool SP2, bool GATHER, bool FP8 = false>
__device__ __forceinline__ void gemm_phase(PG8_LAS unsigned char* lds, const int KB, const Sched& S, const Epi& E, const int PA_ = 0) {
    int tid_ = threadIdx.x; asm volatile("" : "+v"(tid_));
    const int tid = tid_, wid = __builtin_amdgcn_readfirstlane(tid >> 6), lane = tid & 63, wr = wid >> 2, wc = wid & 3, fr = lane & 15, fq = lane >> 4;
    const int nt = KB / (BK * 2);
    unsigned voffA, voffB; int RA0, CA;
    { int R, C; stage_rc(tid * 16, R, C); const int Rb = (R & ~31) + perm32(R & 31); voffA = (unsigned)(R * (PA_ ? PA_ : KB) + C * 2); voffB = (unsigned)(Rb * KB + C * 2); RA0 = R; CA = C; }
    const size_t qstep = (size_t)64 * KB, qstepA = (size_t)64 * (PA_ ? PA_ : KB), hstepA = (size_t)HALF * (PA_ ? PA_ : KB);
    const size_t kstep = (size_t)(BK * 2);
    const size_t hstep = (size_t)HALF * KB;
    const unsigned ldsw = (unsigned)wid * 1024u;
    const int aoff = lds_byte(wr * 64 + fr, fq * 8), boff = lds_byte(wc * 32 + fr, fq * 8);
#define PG8_SA(b, h) (((b) * 2 + (h)) * HTB)
#define PG8_SB(b, h) ((4 + (b) * 2 + (h)) * HTB)
#define PG8_STAGE(bufoff, gbase, voff) do { _Pragma("unroll") for (int _i = 0; _i < 2; ++_i) \
        __builtin_amdgcn_global_load_lds((const unsigned*)((const char*)(gbase) + _i * qstep + (voff)), (PG8_LAS unsigned*)(lds + (bufoff) + ldsw + _i * 8192), 16, 0, 0); } while (0)
#define PG8_STAGE_PA(bufoff, gbase, voff) do { _Pragma("unroll") for (int _i = 0; _i < 2; ++_i) \
        __builtin_amdgcn_global_load_lds((const unsigned*)((const char*)(gbase) + _i * qstepA + (voff)), (PG8_LAS unsigned*)(lds + (bufoff) + ldsw + _i * 8192), 16, 0, 0); } while (0)
#define PG8_STAGE_G(bufoff, gbase, voff) do { _Pragma("unroll") for (int _i = 0; _i < 2; ++_i) \
        __builtin_amdgcn_global_load_lds((const unsigned*)((const char*)(gbase) + (voff)[_i]), (PG8_LAS unsigned*)(lds + (bufoff) + ldsw + _i * 8192), 16, 0, 0); } while (0)
#define PG8_LDA(dst, b, h) do { _Pragma("unroll") for (int m = 0; m < 4; ++m) _Pragma("unroll") for (int k = 0; k < 2; ++k) dst[m][k] = *(const PG8_LAS bf16x8*)(lds + PG8_SA(b, h) + aoff + m * 2048 + k * 1024); } while (0)
#define PG8_LDB(dst, b, h) do { _Pragma("unroll") for (int n = 0; n < 2; ++n) _Pragma("unroll") for (int k = 0; k < 2; ++k) dst[n][k] = *(const PG8_LAS bf16x8*)(lds + PG8_SB(b, h) + boff + n * 2048 + k * 1024); } while (0)
#define PG8_MMA(ai, bj, At, Bt) do { __builtin_amdgcn_s_setprio(1); _Pragma("unroll") for (int m = 0; m < 4; ++m) _Pragma("unroll") for (int n = 0; n < 2; ++n) { \
        if constexpr (FP8) { typedef int v8i_ __attribute__((ext_vector_type(8))); typedef int v4i_ __attribute__((ext_vector_type(4))); \
            const v4i_ b0_ = __builtin_bit_cast(v4i_, Bt[n][0]), b1_ = __builtin_bit_cast(v4i_, Bt[n][1]), a0_ = __builtin_bit_cast(v4i_, At[m][0]), a1_ = __builtin_bit_cast(v4i_, At[m][1]); \
            const v8i_ bb_ = {b0_[0], b0_[1], b0_[2], b0_[3], b1_[0], b1_[1], b1_[2], b1_[3]}, aa_ = {a0_[0], a0_[1], a0_[2], a0_[3], a1_[0], a1_[1], a1_[2], a1_[3]}; \
            acc[ai][bj][m][n] = __builtin_amdgcn_mfma_scale_f32_16x16x128_f8f6f4(bb_, aa_, acc[ai][bj][m][n], 0, 0, 0, 0x7f7f7f7f, 0, 0x7f7f7f7f); } \
        else { _Pragma("unroll") for (int k = 0; k < 2; ++k) acc[ai][bj][m][n] = __builtin_amdgcn_mfma_f32_16x16x32_bf16(Bt[n][k], At[m][k], acc[ai][bj][m][n], 0, 0, 0); } } \
        if constexpr (FP8) { _Pragma("unroll") for (int m = 0; m < 4; ++m) asm volatile("" : "+v"(acc[ai][bj][m][0]), "+v"(acc[ai][bj][m][1])); }     \
        __builtin_amdgcn_s_setprio(0); } while (0)
#define PG8_WAIT_V(n) asm volatile("s_waitcnt vmcnt(" #n ")" ::: "memory")
#define PG8_WAIT_L(n) asm volatile("s_waitcnt lgkmcnt(" #n ")" ::: "memory")
#define PG8_BAR __builtin_amdgcn_s_barrier()
#define PG8_SCHED __builtin_amdgcn_sched_barrier(0)
    Unit cur, nxt; int ui = 0;
    if (!S.next(0, cur)) return;
    f32x4 acc[2][2][4][2];
#pragma unroll
    for (int a = 0; a < 2; ++a)
#pragma unroll
        for (int b = 0; b < 2; ++b)
#pragma unroll
            for (int m = 0; m < 4; ++m)
#pragma unroll
                for (int n = 0; n < 2; ++n) acc[a][b][m][n] = (f32x4){0.f, 0.f, 0.f, 0.f};
    bf16x8 At[4][2], B0[2][2], B1[2][2];
    unsigned crw[2], nrw[2]; const unsigned cc = (unsigned)(CA * 2);
#pragma unroll
    for (int i = 0; i < 2; ++i) {
        if constexpr (GATHER) { crw[i] = (unsigned)S.row(cur.gs + RA0 + 64 * i) | ((unsigned)S.row(cur.gs + HALF + RA0 + 64 * i) << 16); }
        else { crw[i] = 0u; }
        nrw[i] = crw[i]; }
    asm volatile("" : "+v"(crw[0]), "+v"(crw[1]));
#define PG8_STAGE_A(bufoff, gbase, rws, h) do { if constexpr (GATHER) { unsigned vo_[2]; _Pragma("unroll") for (int _j = 0; _j < 2; ++_j) vo_[_j] = (((rws)[_j] >> (16 * (h))) & 0xffffu) * (unsigned)KB + cc; PG8_STAGE_G(bufoff, gbase, vo_); } \
        else { PG8_STAGE_PA(bufoff, (gbase) + (h) * hstepA, voffA); } } while (0)
    const char* cA = cur.a; const char* cB = cur.b;
    S.a_ready(cur);
    if constexpr (SP2) {
        PG8_STAGE(PG8_SB(0, 0), cB, voffB); PG8_STAGE(PG8_SB(0, 1), cB + hstep, voffB); PG8_STAGE_A(PG8_SA(0, 0), cA, crw, 0); PG8_STAGE_A(PG8_SA(0, 1), cA, crw, 1);
        if (wr == 1) PG8_BAR;
        PG8_WAIT_V(2); PG8_BAR;
        PG8_STAGE(PG8_SB(1, 0), cB + kstep, voffB); PG8_STAGE_A(PG8_SA(1, 0), cA + kstep, crw, 0); PG8_STAGE(PG8_SB(1, 1), cB + hstep + kstep, voffB);
        PG8_WAIT_V(6); PG8_BAR;
    } else {
        PG8_STAGE(PG8_SB(0, 0), cB, voffB); PG8_STAGE_A(PG8_SA(0, 0), cA, crw, 0); PG8_STAGE(PG8_SB(0, 1), cB + hstep, voffB); PG8_STAGE_A(PG8_SA(0, 1), cA, crw, 1);
        if (wr == 1) PG8_BAR;
        PG8_WAIT_V(4); PG8_BAR;
        PG8_STAGE(PG8_SB(1, 0), cB + kstep, voffB); PG8_STAGE_A(PG8_SA(1, 0), cA + kstep, crw, 0); PG8_STAGE(PG8_SB(1, 1), cB + hstep + kstep, voffB);
        PG8_WAIT_V(6); PG8_BAR;
    }
    for (;;) {
        const bool has_next = S.next(ui + 1, nxt);
        const char* nA = has_next ? nxt.a : cA; const char* nB = has_next ? nxt.b : cB;
        if constexpr (GATHER) {
            if (has_next) {
#pragma unroll
                for (int i = 0; i < 2; ++i) { nrw[i] = (unsigned)S.row(nxt.gs + RA0 + 64 * i) | ((unsigned)S.row(nxt.gs + HALF + RA0 + 64 * i) << 16); }
                asm volatile("" : "+v"(nrw[0]), "+v"(nrw[1]));
            } else {
#pragma unroll
                for (int i = 0; i < 2; ++i) nrw[i] = crw[i];
            }
        }
        for (int t = 0; t < nt; t += 2) {
            const bool last = (t == nt - 2);
            const char* a1 = cA + (size_t)(t + 1) * kstep;
            const char* a2 = last ? nA : cA + (size_t)(t + 2) * kstep; const char* b2 = last ? nB : cB + (size_t)(t + 2) * kstep;
            const char* a3 = a2 + kstep; const char* b3 = b2 + kstep;
            unsigned srw[2];
#pragma unroll
            for (int i = 0; i < 2; ++i) srw[i] = last ? nrw[i] : crw[i];
            if (last && has_next) S.a_ready(nxt);
            if constexpr (SP2) {
            PG8_LDB(B0, 0, 0); PG8_LDB(B1, 0, 1); PG8_SCHED; PG8_LDA(At, 0, 0); PG8_STAGE_A(PG8_SA(1, 1), a1, crw, 1);
            PG8_WAIT_V(8); PG8_WAIT_L(0); PG8_BAR; PG8_MMA(0, 0, At, B0); PG8_MMA(0, 1, At, B1); PG8_BAR; PG8_SCHED;
            PG8_LDA(At, 0, 1); PG8_STAGE(PG8_SB(0, 0), b2, voffB); PG8_STAGE(PG8_SB(0, 1), b2 + hstep, voffB); PG8_STAGE_A(PG8_SA(0, 0), a2, srw, 0);
            PG8_WAIT_V(8); PG8_WAIT_L(0); PG8_BAR; PG8_MMA(1, 0, At, B0); PG8_MMA(1, 1, At, B1); PG8_BAR; PG8_SCHED;
            PG8_LDB(B0, 1, 0); PG8_LDB(B1, 1, 1); PG8_SCHED; PG8_LDA(At, 1, 0); PG8_STAGE_A(PG8_SA(0, 1), a2, srw, 1);
            PG8_WAIT_V(8); PG8_WAIT_L(0); PG8_BAR; PG8_MMA(0, 0, At, B0); PG8_MMA(0, 1, At, B1); PG8_BAR; PG8_SCHED;
            PG8_LDA(At, 1, 1); PG8_STAGE(PG8_SB(1, 0), b3, voffB); PG8_STAGE(PG8_SB(1, 1), b3 + hstep, voffB); PG8_STAGE_A(PG8_SA(1, 0), a3, srw, 0);
            PG8_WAIT_V(8); PG8_WAIT_L(0); PG8_BAR; PG8_MMA(1, 0, At, B0); PG8_MMA(1, 1, At, B1); PG8_BAR; PG8_SCHED;
            } else {
            PG8_LDB(B0, 0, 0); PG8_SCHED; PG8_LDA(At, 0, 0); PG8_STAGE_A(PG8_SA(1, 1), a1, crw, 1);
            PG8_WAIT_L(8); PG8_BAR; PG8_WAIT_L(0); PG8_MMA(0, 0, At, B0); PG8_BAR; PG8_SCHED;
            PG8_LDB(B1, 0, 1); PG8_STAGE(PG8_SB(0, 0), b2, voffB);
            PG8_BAR; PG8_WAIT_L(0); PG8_MMA(0, 1, At, B1); PG8_BAR;
            PG8_LDA(At, 0, 1); PG8_STAGE_A(PG8_SA(0, 0), a2, srw, 0);
            PG8_BAR; PG8_WAIT_L(0); PG8_MMA(1, 0, At, B0); PG8_BAR; PG8_SCHED;
            PG8_STAGE(PG8_SB(0, 1), b2 + hstep, voffB);
            PG8_WAIT_V(6); PG8_BAR; PG8_MMA(1, 1, At, B1); PG8_BAR;
            PG8_LDB(B0, 1, 0); PG8_SCHED; PG8_LDA(At, 1, 0); PG8_STAGE_A(PG8_SA(0, 1), a2, srw, 1);
            PG8_WAIT_L(8); PG8_BAR; PG8_WAIT_L(0); PG8_MMA(0, 0, At, B0); PG8_BAR; PG8_SCHED;
            PG8_LDB(B1, 1, 1); PG8_STAGE(PG8_SB(1, 0), b3, voffB);
            PG8_BAR; PG8_WAIT_L(0); PG8_MMA(0, 1, At, B1); PG8_BAR;
            PG8_LDA(At, 1, 1); PG8_STAGE_A(PG8_SA(1, 0), a3, srw, 0);
            PG8_BAR; PG8_WAIT_L(0); PG8_MMA(1, 0, At, B0); PG8_BAR; PG8_SCHED;
            PG8_STAGE(PG8_SB(1, 1), b3 + hstep, voffB);
            PG8_WAIT_V(6); PG8_BAR; PG8_MMA(1, 1, At, B1); PG8_BAR;
            }
        }
        if constexpr (ALIGN_EPI) { if (wr == 0) PG8_BAR; }
        E(acc, cur, wr, wc, fr, fq); S.done(cur);
        if (!has_next) break;
        if (!cur.keep) {
#pragma unroll
        for (int a = 0; a < 2; ++a)
#pragma unroll
            for (int b = 0; b < 2; ++b)
#pragma unroll
                for (int m = 0; m < 4; ++m)
#pragma unroll
                    for (int n = 0; n < 2; ++n) acc[a][b][m][n] = (f32x4){0.f, 0.f, 0.f, 0.f};
        }
        cur = nxt; cA = nA; cB = nB; ++ui;
#pragma unroll
        for (int i = 0; i < 2; ++i) crw[i] = nrw[i];
        if constexpr (ALIGN_EPI) { if (wr == 1) PG8_BAR; }
    }
    PG8_WAIT_V(0);
    if constexpr (!ALIGN_EPI) { if (wr == 0) PG8_BAR; }
    PG8_BAR;
#undef PG8_SA
#undef PG8_SB
#undef PG8_STAGE
#undef PG8_STAGE_A
#undef PG8_STAGE_G
#undef PG8_STAGE_PA
#undef PG8_LDA
#undef PG8_LDB
#undef PG8_MMA
#undef PG8_WAIT_V
#undef PG8_WAIT_L
#undef PG8_BAR
#undef PG8_SCHED
}
}
namespace attn_body {
using bf16=__hip_bfloat16;
using bf16x8=__attribute__((ext_vector_type(8)))short;
using s16x4=__attribute__((ext_vector_type(4)))short;
using f32x16=__attribute__((ext_vector_type(16)))float;
using u32x4=__attribute__((ext_vector_type(4)))unsigned;
constexpr int SEQ=4096,D=64,DM=512;
constexpr int NW=8,QBLK=32,QB=QBLK*NW,KVBLK=64,NQB=SEQ/QB;
constexpr int ATTN_PITCH=DM, ATTN_UNIT_ROWS=QB;
__device__ __forceinline__ int crow(int r,int hi){return (r&3)+8*(r>>2)+4*hi;}
#define SBAR() __builtin_amdgcn_sched_barrier(0)
__device__ __forceinline__ void cmask(f32x16&p0,f32x16&p1,int jb,int qrel,int hi){
  const float NEG=-INFINITY; int kb=64*jb+4*hi;
  #pragma unroll
  for(int r=0;r<16;++r){int kv=kb+(r&3)+8*(r>>2); if(kv>qrel)p0[r]=NEG; if(kv+32>qrel)p1[r]=NEG;}
}

constexpr int NSLOT=3, SLOTB=8192;
constexpr int LDS_K=0, LDS_V=NSLOT*SLOTB, LDS_WS=3*NSLOT*SLOTB, LDS_OST=LDS_WS+NW*64*4, LDS_BYTES=LDS_OST+NW*4096;
__device__ __forceinline__ void glds16(const void*sbase,unsigned voff,unsigned lds_dst){unsigned keep;
  asm volatile("s_mov_b32 %0, m0\n\ts_mov_b32 m0, %3\n\ts_nop 0\n\tglobal_load_lds_dwordx4 %1, %2\n\ts_mov_b32 m0, %0":"=&s"(keep):"v"(voff),"s"(sbase),"s"(lds_dst):"memory");}
__device__ __forceinline__ float max3f(float a,float b,float c){float r;asm("v_max3_f32 %0, %1, %2, %3":"=v"(r):"v"(a),"v"(b),"v"(c));return r;}
__device__ __forceinline__ float max2f(float a,float b){float r;asm("v_max_f32_e32 %0, %1, %2":"=v"(r):"v"(a),"v"(b));return r;}
__device__ __forceinline__ float fadd_s(float a,float b){float r;asm("v_add_f32_e32 %0, %1, %2":"=v"(r):"v"(a),"v"(b));return r;}
__device__ __forceinline__ float fsub_s(float a,float b){float r;asm("v_sub_f32_e32 %0, %1, %2":"=v"(r):"v"(a),"v"(b));return r;}
typedef float f32x2_t __attribute__((ext_vector_type(2))); typedef __bf16 bf16x2_t __attribute__((ext_vector_type(2)));
__device__ __forceinline__ unsigned cvtpk_s(float lo,float hi){f32x2_t v={lo,hi};bf16x2_t b=__builtin_convertvector(v,bf16x2_t);return __builtin_bit_cast(unsigned,b);}
#define WAIT_BAR(N) asm volatile("s_waitcnt vmcnt(" #N ") lgkmcnt(0)\n\ts_barrier":::"memory")

__device__ __forceinline__ void qkt(f32x16&p0,f32x16&p1,const char*Kslot,const bf16x8*qr,const f32x16&negm,int r32,int hi){
  const char*kb=Kslot+hi*1024+r32*16;
  #pragma unroll
  for(int d0=0;d0<4;++d0){
    const bf16x8 b0=*reinterpret_cast<const bf16x8*>(kb+d0*2048);
    const bf16x8 b1=*reinterpret_cast<const bf16x8*>(kb+d0*2048+512);
    if(d0==0){p0=__builtin_amdgcn_mfma_f32_32x32x16_bf16(b0,qr[0],negm,0,0,0);p1=__builtin_amdgcn_mfma_f32_32x32x16_bf16(b1,qr[0],negm,0,0,0);}
    else{p0=__builtin_amdgcn_mfma_f32_32x32x16_bf16(b0,qr[d0],p0,0,0,0);p1=__builtin_amdgcn_mfma_f32_32x32x16_bf16(b1,qr[d0],p1,0,0,0);}}
}
typedef __attribute__((address_space(3))) const char* lds_cptr;
typedef short v4i16_t __attribute__((ext_vector_type(4)));
__device__ __forceinline__ void kload8(bf16x8*kf,lds_cptr kp){
  kf[0]=*(const __attribute__((address_space(3))) bf16x8*)(kp);      kf[1]=*(const __attribute__((address_space(3))) bf16x8*)(kp+512);
  kf[2]=*(const __attribute__((address_space(3))) bf16x8*)(kp+2048); kf[3]=*(const __attribute__((address_space(3))) bf16x8*)(kp+2560);
  kf[4]=*(const __attribute__((address_space(3))) bf16x8*)(kp+4096); kf[5]=*(const __attribute__((address_space(3))) bf16x8*)(kp+4608);
  kf[6]=*(const __attribute__((address_space(3))) bf16x8*)(kp+6144); kf[7]=*(const __attribute__((address_space(3))) bf16x8*)(kp+6656);
}
__device__ __forceinline__ void kload2(bf16x8*kf,lds_cptr kp,int j){ kf[2*j]=*(const __attribute__((address_space(3))) bf16x8*)(kp+j*2048); kf[2*j+1]=*(const __attribute__((address_space(3))) bf16x8*)(kp+j*2048+512); }
__device__ __forceinline__ s16x4 vtr(lds_cptr p){ return __builtin_bit_cast(s16x4,__builtin_amdgcn_ds_read_tr16_b64_v4i16((__attribute__((address_space(3))) v4i16_t*)p)); }
__device__ __forceinline__ float rowmax(const f32x16&p0,const f32x16&p1){
  float a=max3f(p0[0],p0[1],p1[0]),b=max3f(p0[2],p0[3],p1[1]);a=max3f(a,p1[2],p1[3]);
  #pragma unroll
  for(int r=4;r<16;r+=4){a=max3f(a,p0[r],p0[r+1]);b=max3f(b,p0[r+2],p0[r+3]);a=max3f(a,p1[r],p1[r+1]);b=max3f(b,p1[r+2],p1[r+3]);}
  const float m=max2f(a,b);
  auto rr=__builtin_amdgcn_permlane32_swap(__float_as_uint(m),__float_as_uint(m),false,false);
  return max2f(__uint_as_float(rr[0]),__uint_as_float(rr[1]));
}
__device__ __forceinline__ void pv(f32x16*o,int vb,bf16x8 pa0,bf16x8 pa1,bf16x8 pa2,bf16x8 pa3){
  #pragma unroll
  for(int d0=0;d0<4;++d0){s16x4 lo[4],hi[4];
    #pragma unroll
    for(int ks=0;ks<4;++ks){
      asm volatile("ds_read_b64_tr_b16 %0,%1 offset:%c2":"=&v"(lo[ks]):"v"(vb),"i"(d0*4096+ks*1024):"memory");
      asm volatile("ds_read_b64_tr_b16 %0,%1 offset:%c2":"=&v"(hi[ks]):"v"(vb),"i"(d0*4096+ks*1024+512):"memory");}
    asm volatile("s_waitcnt lgkmcnt(0)":::"memory");SBAR();
    #define PK(k) (bf16x8){lo[k][0],lo[k][1],lo[k][2],lo[k][3],hi[k][0],hi[k][1],hi[k][2],hi[k][3]}
    o[d0]=__builtin_amdgcn_mfma_f32_32x32x16_bf16(pa0,PK(0),o[d0],0,0,0);
    o[d0]=__builtin_amdgcn_mfma_f32_32x32x16_bf16(pa1,PK(1),o[d0],0,0,0);
    o[d0]=__builtin_amdgcn_mfma_f32_32x32x16_bf16(pa2,PK(2),o[d0],0,0,0);
    o[d0]=__builtin_amdgcn_mfma_f32_32x32x16_bf16(pa3,PK(3),o[d0],0,0,0);
    #undef PK
  }
}

#ifndef ATTN_STORE16
#define ATTN_STORE16(p,v) (*(u32x4*)(p)=(v))
#endif
template<int THRL> __device__ __forceinline__ void attn_unit(int b,int h,int hv,int qb,const bf16*Q,const bf16*__restrict__ K,const bf16*__restrict__ V,bf16*O,char*shm){
  int tid_=threadIdx.x; asm volatile("":"+v"(tid_)); const int tid=tid_,lane=tid&63,r32=lane&31,hi=lane>>5; const int wid=__builtin_amdgcn_readfirstlane(tid>>6);
  const long rowbase=(long)b*SEQ; const int q0=qb*QB;
  const bf16*Qw=Q+(rowbase+q0+wid*QBLK)*DM+h*D;
  const bf16*Kh=K+rowbase*DM+h*D,*Vh=V+rowbase*DM+hv*2*D;
  const unsigned lds0=(unsigned)(uintptr_t)shm;
  float*wsf=(float*)(shm+LDS_WS)+wid*64;
  const unsigned koff=(unsigned)((lane*DM+wid*8)*2);
  const unsigned voff=(unsigned)(((16*(wid&3)+(lane>>2))*DM+(wid>>2)*32+(lane&3)*8)*2);
  const unsigned kdst=lds0+LDS_K+wid*1024, vdst=lds0+LDS_V+wid*1024;
  #define DMA_K(t,slot) glds16(Kh+(long)(t)*KVBLK*DM,koff,(unsigned)__builtin_amdgcn_readfirstlane(kdst+(slot)))
  #define DMA_V(t,slot) do{ glds16(Vh+(long)(t)*KVBLK*DM,voff,(unsigned)__builtin_amdgcn_readfirstlane(vdst+2*(slot))); glds16(Vh+(long)(t)*KVBLK*DM+64,voff,(unsigned)__builtin_amdgcn_readfirstlane(vdst+2*(slot)+8192)); }while(0)
  const int vb0=(int)(lds0+LDS_V)+((lane>>4)&1)*32+(lane&3)*8+(4*hi+((lane&15)>>2))*64;
  const char*Kbase=shm+LDS_K; bf16x8 kf[8];
  const lds_cptr shm3=(lds_cptr)shm; const lds_cptr kp0=shm3+LDS_K+hi*1024+r32*16; const lds_cptr vp0=shm3+LDS_V+((lane>>4)&1)*32+(lane&3)*8+(4*hi+((lane&15)>>2))*64;
  const int NT=(q0+QB)/KVBLK;
  DMA_K(0,0);DMA_V(0,0);DMA_K(1,SLOTB);
  bf16x8 qr[4];
  #pragma unroll
  for(int d0=0;d0<4;++d0)qr[d0]=*reinterpret_cast<const bf16x8*>(&Qw[(long)r32*DM+d0*16+hi*8]);
  float mhat=0.f,l_reg=0.f;f32x16 o[4];o[0]=f32x16{};o[1]=f32x16{};o[2]=f32x16{};o[3]=f32x16{};f32x16 negm=f32x16{};asm volatile("":"+v"(negm));
  const int qrel=wid*QBLK+r32;
  #define CMASK(P0,P1,t) do{int jb_=(t)-(NT-4); if(jb_>=0)cmask(P0,P1,jb_,qrel,hi);}while(0)
  bool resc=false;
  #define START(P0,P1) do{ const float rm=rowmax(P0,P1); resc=false; \
    { const float dl=rm; mhat=fadd_s(mhat,dl); \
      _Pragma("unroll") for(int r=0;r<16;++r){P0[r]=fsub_s(P0[r],dl);P1[r]=fsub_s(P1[r],dl);} \
      _Pragma("unroll") for(int r=0;r<16;++r)negm[r]=-mhat; asm volatile("":"+v"(negm)); } \
    _Pragma("unroll") for(int r=0;r<16;++r)P0[r]=__builtin_amdgcn_exp2f(P0[r]); }while(0)
  #define RESC() do{ if(resc){ asm volatile("s_waitcnt lgkmcnt(0)":::"memory"); \
      _Pragma("unroll") for(int d_=0;d_<4;++d_) _Pragma("unroll") for(int r=0;r<16;++r)o[d_][r]*=wsf[crow(r,hi)]; } }while(0)
  f32x16 pA0,pA1,pB0,pB1;
  int sl_prev=0,sl_cur=0,sl_next=SLOTB;
  #define ROT() do{sl_prev=sl_cur;sl_cur=sl_next;sl_next=(sl_next==(NSLOT-1)*SLOTB)?0:sl_next+SLOTB;}while(0)
  DMA_K(2,2*SLOTB);
  WAIT_BAR(3);
  qkt(pA0,pA1,Kbase,qr,negm,r32,hi);asm volatile("s_nop 15\n\ts_nop 7":"+v"(pA0),"+v"(pA1));CMASK(pA0,pA1,0);
  START(pA0,pA1);
  _Pragma("unroll") for(int r=0;r<16;++r)pA1[r]=__builtin_amdgcn_exp2f(pA1[r]);
  WAIT_BAR(0);
  DMA_K(3,0);DMA_V(1,SLOTB);
  ROT();
  kload8(kf,kp0+sl_cur);
  WAIT_BAR(3);
  s16x4 vlo[8],vhi[8]; u32x4 pw0,pw1,pw2,pw3;
  #define PKW(P,B) cvtpk_s(P[B],P[B+1])
  #define PAF(k) __builtin_bit_cast(bf16x8,pw##k)
  #define VFR(i) (bf16x8){vlo[i][0],vlo[i][1],vlo[i][2],vlo[i][3],vhi[i][0],vhi[i][1],vhi[i][2],vhi[i][3]}
  #define PIN(x) asm volatile("":"+v"(x))
  #define MX3(a,b,c) __builtin_fmaxf(__builtin_fmaxf((a),(b)),(c))
  #define GAPA(MF,A0,A1,A2,A3,W0,W1,PW) do{ MF; sacc+=A0; sacc+=A1; sacc+=A2; sacc+=A3; PIN(sacc); W0; W1; PIN(PW); SBAR(); }while(0)
  #define EX(v) __builtin_amdgcn_exp2f(v)
  #define GAPB(MF,X,B,RD) do{ MF; RD; X[B]=EX(X[B]); X[B+1]=EX(X[B+1]); PIN(X); SBAR(); }while(0)
  #define VRDS(f,sl) do{ vlo[sl]=vtr(vp_+(((f)>>2)*4096+((f)&3)*1024)); vhi[sl]=vtr(vp_+(((f)>>2)*4096+((f)&3)*1024+512)); }while(0)
  #define NORD do{}while(0)
  #define KRD(G,j) do{ if(G){ kload2(kf,kp0+sl_next,j); SBAR(); } }while(0)
  #define STEP(C0,C1,P0,P1,t,GK,GV,GL) do{ SBAR(); \
    const lds_cptr vp_=vp0+2*sl_prev; \
    float sacc=(P0[0]+P0[1]); \
    GAPA(C0=__builtin_amdgcn_mfma_f32_32x32x16_bf16(kf[0],qr[0],negm,0,0,0), P0[2],P0[3],P0[4],P0[5],     pw0[0]=PKW(P0,0), pw0[1]=PKW(P0,2), pw0); \
    GAPA(C1=__builtin_amdgcn_mfma_f32_32x32x16_bf16(kf[1],qr[0],negm,0,0,0), P0[6],P0[7],P0[8],P0[9],     pw0[2]=PKW(P0,4), pw0[3]=PKW(P0,6), pw0); \
    GAPA(C0=__builtin_amdgcn_mfma_f32_32x32x16_bf16(kf[2],qr[1],C0,0,0,0),   P0[10],P0[11],P0[12],P0[13], pw1[0]=PKW(P0,8), pw1[1]=PKW(P0,10), pw1); \
    GAPA(C1=__builtin_amdgcn_mfma_f32_32x32x16_bf16(kf[3],qr[1],C1,0,0,0),   P0[14],P0[15],P1[0],P1[1],   pw1[2]=PKW(P0,12),pw1[3]=PKW(P0,14), pw1); \
    VRDS(0,0);  SBAR(); GAPA(C0=__builtin_amdgcn_mfma_f32_32x32x16_bf16(kf[4],qr[2],C0,0,0,0),   P1[2],P1[3],P1[4],P1[5],     pw2[0]=PKW(P1,0), pw2[1]=PKW(P1,2), pw2); \
    VRDS(4,1);  SBAR(); GAPA(C1=__builtin_amdgcn_mfma_f32_32x32x16_bf16(kf[5],qr[2],C1,0,0,0),   P1[6],P1[7],P1[8],P1[9],     pw2[2]=PKW(P1,4), pw2[3]=PKW(P1,6), pw2); \
    VRDS(8,2);  SBAR(); GAPA(C0=__builtin_amdgcn_mfma_f32_32x32x16_bf16(kf[6],qr[3],C0,0,0,0),   P1[10],P1[11],P1[12],P1[13], pw3[0]=PKW(P1,8), pw3[1]=PKW(P1,10), pw3); \
    VRDS(12,3); SBAR(); GAPA(C1=__builtin_amdgcn_mfma_f32_32x32x16_bf16(kf[7],qr[3],C1,0,0,0),   P1[14],P1[15],0.f,0.f,       pw3[2]=PKW(P1,12),pw3[3]=PKW(P1,14), pw3); \
    l_reg+=sacc; \
    if(GK){DMA_K((t)+3,sl_cur);} if(GV){DMA_V((t)+1,sl_next);} \
    CMASK(C0,C1,t); \
    { float a=MX3(C0[0],C0[1],C1[0]),b=MX3(C0[2],C0[3],C1[1]); a=MX3(a,C1[2],C1[3]); \
      _Pragma("unroll") for(int r=4;r<16;r+=4){a=MX3(a,C0[r],C0[r+1]);b=MX3(b,C0[r+2],C0[r+3]);a=MX3(a,C1[r],C1[r+1]);b=MX3(b,C1[r+2],C1[r+3]);} \
      float rm=__builtin_fmaxf(a,b); { auto rr=__builtin_amdgcn_permlane32_swap(__float_as_uint(rm),__float_as_uint(rm),false,false); rm=__builtin_fmaxf(__uint_as_float(rr[0]),__uint_as_float(rr[1])); } \
      resc=false; \
      if(__builtin_expect(__any(rm>(float)THRL),0)){ const float dl=__builtin_fmaxf(rm,0.f); mhat+=dl; \
        _Pragma("unroll") for(int r=0;r<16;++r){C0[r]-=dl;C1[r]-=dl;} \
        _Pragma("unroll") for(int r=0;r<16;++r)negm[r]=-mhat; asm volatile("":"+v"(negm)); \
        const float f=__builtin_amdgcn_exp2f(-dl); l_reg*=f; if(hi==0)wsf[r32]=f; resc=true; } } \
    SBAR(); \
    GAPB(o[0]=__builtin_amdgcn_mfma_f32_32x32x16_bf16(PAF(0),VFR(0),o[0],0,0,0), C0,0,  VRDS(1,4)); \
    GAPB(o[1]=__builtin_amdgcn_mfma_f32_32x32x16_bf16(PAF(0),VFR(1),o[1],0,0,0), C0,2,  VRDS(5,5)); \
    GAPB(o[2]=__builtin_amdgcn_mfma_f32_32x32x16_bf16(PAF(0),VFR(2),o[2],0,0,0), C0,4,  VRDS(9,6)); \
    GAPB(o[3]=__builtin_amdgcn_mfma_f32_32x32x16_bf16(PAF(0),VFR(3),o[3],0,0,0), C0,6,  VRDS(13,7)); \
    KRD(GL,0); GAPB(o[0]=__builtin_amdgcn_mfma_f32_32x32x16_bf16(PAF(1),VFR(4),o[0],0,0,0), C0,8,  VRDS(2,0)); \
    GAPB(o[1]=__builtin_amdgcn_mfma_f32_32x32x16_bf16(PAF(1),VFR(5),o[1],0,0,0), C0,10, VRDS(6,1)); \
    KRD(GL,1); GAPB(o[2]=__builtin_amdgcn_mfma_f32_32x32x16_bf16(PAF(1),VFR(6),o[2],0,0,0), C0,12, VRDS(10,2)); \
    GAPB(o[3]=__builtin_amdgcn_mfma_f32_32x32x16_bf16(PAF(1),VFR(7),o[3],0,0,0), C0,14, VRDS(14,3)); \
    KRD(GL,2); GAPB(o[0]=__builtin_amdgcn_mfma_f32_32x32x16_bf16(PAF(2),VFR(0),o[0],0,0,0), C1,0,  VRDS(3,4)); \
    GAPB(o[1]=__builtin_amdgcn_mfma_f32_32x32x16_bf16(PAF(2),VFR(1),o[1],0,0,0), C1,2,  VRDS(7,5)); \
    KRD(GL,3); GAPB(o[2]=__builtin_amdgcn_mfma_f32_32x32x16_bf16(PAF(2),VFR(2),o[2],0,0,0), C1,4,  VRDS(11,6)); \
    GAPB(o[3]=__builtin_amdgcn_mfma_f32_32x32x16_bf16(PAF(2),VFR(3),o[3],0,0,0), C1,6,  VRDS(15,7)); \
    GAPB(o[0]=__builtin_amdgcn_mfma_f32_32x32x16_bf16(PAF(3),VFR(4),o[0],0,0,0), C1,8,  NORD); \
    GAPB(o[1]=__builtin_amdgcn_mfma_f32_32x32x16_bf16(PAF(3),VFR(5),o[1],0,0,0), C1,10, NORD); \
    GAPB(o[2]=__builtin_amdgcn_mfma_f32_32x32x16_bf16(PAF(3),VFR(6),o[2],0,0,0), C1,12, NORD); \
    GAPB(o[3]=__builtin_amdgcn_mfma_f32_32x32x16_bf16(PAF(3),VFR(7),o[3],0,0,0), C1,14, NORD); \
    }while(0)
  int t=1;
  #undef CMASK
  #define CMASK(P0,P1,t) do{}while(0)
  for(;t+5<NT;t+=2){
    STEP(pB0,pB1,pA0,pA1,t,true,true,true);     WAIT_BAR(3); RESC(); ROT();
    STEP(pA0,pA1,pB0,pB1,t+1,true,true,true);   WAIT_BAR(3); RESC(); ROT();
  }
  #undef CMASK
  #define CMASK(P0,P1,t) do{int jb_=(t)-(NT-4); if(jb_>=0)cmask(P0,P1,jb_,qrel,hi);}while(0)
  #define ENDW(tt) do{ if((tt)+3<NT){WAIT_BAR(3);} else if((tt)+2<NT){WAIT_BAR(2);} else {WAIT_BAR(0);} }while(0)
  for(;t+1<NT;t+=2){
    STEP(pB0,pB1,pA0,pA1,t,(t+3<NT),(t+1<NT),(t+1<NT));       ENDW(t);   RESC(); ROT();
    STEP(pA0,pA1,pB0,pB1,t+1,(t+4<NT),(t+2<NT),(t+2<NT));     ENDW(t+1); RESC(); ROT();
  }
  STEP(pB0,pB1,pA0,pA1,NT-1,false,false,false); RESC();
  { float sacc=pB0[0]+pB0[1]; _Pragma("unroll") for(int r=2;r<16;++r)sacc+=pB0[r]; _Pragma("unroll") for(int r=0;r<16;++r)sacc+=pB1[r]; l_reg+=sacc;
    pw0=(u32x4){PKW(pB0,0),PKW(pB0,2),PKW(pB0,4),PKW(pB0,6)};pw1=(u32x4){PKW(pB0,8),PKW(pB0,10),PKW(pB0,12),PKW(pB0,14)};pw2=(u32x4){PKW(pB1,0),PKW(pB1,2),PKW(pB1,4),PKW(pB1,6)};pw3=(u32x4){PKW(pB1,8),PKW(pB1,10),PKW(pB1,12),PKW(pB1,14)};
    SBAR(); pv(o,vb0+2*sl_cur,PAF(0),PAF(1),PAF(2),PAF(3)); }
  #undef PKW
  #undef PAF
  #undef VFR
  #undef PIN
  #undef MX3
  #undef GAPA
  #undef GAPB
  #undef EX
  #undef VRDS
  #undef NORD
  #undef KRD
  #undef STEP
  #undef ENDW
  {auto rr=__builtin_amdgcn_permlane32_swap(__float_as_uint(l_reg),__float_as_uint(l_reg),false,false);l_reg=__uint_as_float(rr[0])+__uint_as_float(rr[1]);}
  if(hi==0)wsf[32+r32]=l_reg;asm volatile("s_waitcnt lgkmcnt(0)":::"memory");
  float rli[16];
  #pragma unroll
  for(int r=0;r<16;++r)rli[r]=__builtin_amdgcn_rcpf(wsf[32+crow(r,hi)]);
  bf16*Ow=O+(rowbase+q0+wid*QBLK)*DM+hv*2*D;
  { bf16*stg=(bf16*)(shm+LDS_OST)+wid*2048;
    #pragma unroll
    for(int vh=0;vh<2;++vh){
    #pragma unroll
    for(int r=0;r<16;++r){const int orow=crow(r,hi);
      #pragma unroll
      for(int d0=0;d0<2;++d0)stg[orow*64+d0*32+r32]=__float2bfloat16(o[2*vh+d0][r]*rli[r]);}
    asm volatile("s_waitcnt lgkmcnt(0)":::"memory");
    #pragma unroll
    for(int i=0;i<4;++i){const int row=i*8+(lane>>3),ch=lane&7; const u32x4 v=*(const u32x4*)(stg+row*64+ch*8); ATTN_STORE16(Ow+(long)row*DM+vh*64+ch*8,v);}
    asm volatile("s_waitcnt lgkmcnt(0)":::"memory"); } }
  asm volatile("s_waitcnt lgkmcnt(0)\n\ts_barrier":::"memory");
  #undef DMA_K
  #undef DMA_V
  #undef CMASK
  #undef START
  #undef RESC
  #undef ROT
}
constexpr int ATTN_LDS_BYTES=LDS_BYTES;
#undef SBAR
#undef WAIT_BAR
}

constexpr size_t MiB = 1u << 20;
constexpr size_t WS_CTL = 0, CTL_ZERO_BYTES = 1 * MiB;
constexpr size_t WS_LRUS = 1 * MiB;
constexpr size_t WS_TOKE = 2 * MiB;
constexpr size_t WS_TOKW = 2 * MiB + 512 * 1024;
constexpr size_t WS_SLOTT = 3 * MiB;
constexpr size_t WS_SLOTW = 3 * MiB + 512 * 1024;
constexpr size_t WS_ROPE = 6 * MiB;
constexpr size_t WS_WIN = 14 * MiB;
constexpr size_t WS_WBR = 29 * MiB;
constexpr size_t WS_WOUT = 32 * MiB;
constexpr size_t WS_XN = 34 * MiB;
constexpr size_t WS_A = 98 * MiB;
constexpr size_t WS_LRUX = WS_A, WS_LRUG = WS_A + 32 * MiB, WS_Q = WS_A + 64 * MiB, WS_K = WS_A + 96 * MiB, WS_V = WS_A + 128 * MiB;
constexpr size_t WS_GQ = WS_A + 160 * MiB, WS_GK = WS_A + 176 * MiB, WS_GV = WS_A + 192 * MiB, WS_GR = WS_A + 224 * MiB, WS_GG = WS_A + 256 * MiB;
constexpr size_t WS_GATES = WS_A;
constexpr size_t WS_O0 = 386 * MiB, WS_O1 = 418 * MiB;
constexpr size_t WS_YLRU = 450 * MiB, WS_YDA = 482 * MiB, WS_YGLA = 514 * MiB;
constexpr size_t WS_WFFN = 98 * MiB;
constexpr size_t WS_H = 266 * MiB;
constexpr size_t WS_Y2 = 504 * MiB;
constexpr size_t WS_PG = 546 * MiB;
constexpr size_t WS_XN8 = 290 * MiB;
constexpr size_t WS_Y1 = 186 * MiB;
constexpr size_t WS_END = 578 * MiB;
constexpr size_t W13_ELEMS = (size_t)2 * DFF * DM, W2_ELEMS = (size_t)DM * DFF, WEXP_ELEMS = W13_ELEMS + W2_ELEMS;
constexpr int CW_TMO = 0, CW_CODE = 1;
constexpr int CW_BAR = 4096;
constexpr int CW_GCNT = 8192;
constexpr int CW_QHEAD = 12288;
constexpr int RING_BYTES = 131072;
constexpr int LDSCTL_OFF = RING_BYTES;
constexpr int LDS_BYTES = 147456;
constexpr int MW_DEQ = 0, MW_BAR = 8, MW_TS = 16  , MW_HIST = 32, MW_BASE = 40, MW_ROWINFO = 64  ;
constexpr int NWAVES = 8;
#ifndef MK_ONE_LAUNCH
#define MK_ONE_LAUNCH 1
#endif
constexpr int PH_PER_LAYER = 11, N_PHASES = 2 * PH_PER_LAYER + 1;

#define XB_TMO      128
#define XB_XCNT(j)  (256  + 64 * (j))
#define XB_XSUB(j)  (1280 + 64 * (j))
#define XB_XGEN(j)  (2304 + 64 * (j))
#define XB_TOP      3328
#define XB_TOPGEN   3392
#define XCD_BAR_WORDS 3456
#define XB_SPIN_CAP (1u << 22)

__device__ __forceinline__ unsigned xb_ld(unsigned* p)              { return __hip_atomic_load(p, __ATOMIC_RELAXED, __HIP_MEMORY_SCOPE_AGENT); }
__device__ __forceinline__ unsigned xb_add(unsigned* p, unsigned v) { return __hip_atomic_fetch_add(p, v, __ATOMIC_RELAXED, __HIP_MEMORY_SCOPE_AGENT); }
__device__ __forceinline__ unsigned xb_xcc_id() { return (unsigned)__builtin_amdgcn_s_getreg((3 << 11) | 20) & 0xFu; }
#define XB_SPIN(cond, bar) do { unsigned _sp = 0; while (cond) { __builtin_amdgcn_s_sleep(1); \
    if ((++_sp & 255u) == 0u) { if (xb_ld(&(bar)[XB_TMO])) break; if (_sp > XB_SPIN_CAP) { atomicAdd(&(bar)[XB_TMO], 1u); break; } } } } while (0)

struct XcdBarrier { unsigned* bar; unsigned x; volatile LAS unsigned* st; };

__device__ __forceinline__ XcdBarrier xcd_barrier_post(unsigned* bar, volatile LAS unsigned* st) {
    XcdBarrier b; b.bar = bar; b.x = xb_xcc_id(); b.st = st;
    if (threadIdx.x == 0) (void)xb_add(&bar[XB_XCNT(b.x)], 1u);
    return b;
}
__device__ __forceinline__ void xcd_barrier_complete(unsigned* bar, unsigned x, unsigned& nloc, unsigned& nx) {
    const unsigned G = gridDim.x * gridDim.y * gridDim.z;
    unsigned sum, cnt, mine, sp = 0u;
    for (;;) {
        sum = 0u; cnt = 0u; mine = 0u;
#pragma unroll
        for (unsigned j = 0; j < 16; ++j) { const unsigned c = xb_ld(&bar[XB_XCNT(j)]); sum += c; cnt += (c > 0u) ? 1u : 0u; mine = (j == x) ? c : mine; }
        if (sum == G) break;
        __builtin_amdgcn_s_sleep(1);
        if ((++sp & 255u) == 0u) { if (xb_ld(&bar[XB_TMO])) break; if (sp > XB_SPIN_CAP) { atomicAdd(&bar[XB_TMO], 1u); break; } }
    }
    nloc = mine > 0u ? mine : 1u; nx = cnt > 0u ? cnt : 1u;
}
__device__ __forceinline__ void xcd_barrier(const XcdBarrier& b0) {
    XcdBarrier b = b0; { unsigned long long p_ = (unsigned long long)b.bar; asm volatile("" : "+s"(p_)); b.bar = (unsigned*)p_; }
    asm volatile("s_waitcnt vmcnt(0)" ::: "memory");
    __syncthreads();
    if (threadIdx.x == 0) {
        unsigned* bar = b.bar;
        __builtin_amdgcn_s_waitcnt(0);
        unsigned nloc = b.st[0], nx = b.st[1];
        if (nloc == 0u) { xcd_barrier_complete(bar, b.x, nloc, nx); b.st[0] = nloc; b.st[1] = nx; }
        const unsigned old = xb_add(&bar[XB_XSUB(b.x)], 1u);
        const unsigned gen = old / nloc;
        if (old + 1u == (gen + 1u) * nloc) {
            __builtin_amdgcn_fence(__ATOMIC_RELEASE, "agent");
            asm volatile("s_waitcnt vmcnt(0)" ::: "memory");
            const unsigned og = xb_add(&bar[XB_TOP], 1u);
            const unsigned tg = og / nx;
            if (og + 1u == (tg + 1u) * nx) xb_add(&bar[XB_TOPGEN], 1u);
            else XB_SPIN(xb_ld(&bar[XB_TOPGEN]) == tg, bar);
            __builtin_amdgcn_fence(__ATOMIC_ACQUIRE, "agent");
            xb_add(&bar[XB_XGEN(b.x)], 1u);
            asm volatile("s_waitcnt vmcnt(0)" ::: "memory");
        } else {
            XB_SPIN(xb_ld(&bar[XB_XGEN(b.x)]) == gen, bar);
            __builtin_amdgcn_fence(__ATOMIC_ACQUIRE, "agent");
            asm volatile("s_waitcnt vmcnt(0)" ::: "memory");
        }
    }
    __syncthreads();
}

struct Args { const void* in[30]; float* out; unsigned char* ws; int ph_lo, ph_hi; };
struct Frame {
    LAS unsigned char* lds;
    volatile LAS unsigned* MISC;
    gu32* ctl;
    GAS unsigned char* ws;
    const char __attribute__((address_space(4)))* karg;
    int tid, lane, wave, vcu, G;
    float* out;
};
#define FIN(T, k) ((const T*)(const GAS T*)(*(const unsigned long long __attribute__((address_space(4)))*)(F.karg + 8 * (k))))
#define IN_x FIN(float, 0)
#define IN_positions FIN(int, 1)
#define IN_mix_norm FIN(float, 2)
#define IN_w_in FIN(float, 3)
#define IN_conv_w FIN(float, 4)
#define IN_conv_b FIN(float, 5)
#define IN_lru_wa FIN(float, 6)
#define IN_lru_ba FIN(float, 7)
#define IN_lru_wx FIN(float, 8)
#define IN_lru_bx FIN(float, 9)
#define IN_lru_lambda FIN(float, 10)
#define IN_da_lq1 FIN(float, 11)
#define IN_da_lk1 FIN(float, 12)
#define IN_da_lq2 FIN(float, 13)
#define IN_da_lk2 FIN(float, 14)
#define IN_da_subln FIN(float, 15)
#define IN_gla_wa2 FIN(float, 16)
#define IN_gla_ba FIN(float, 17)
#define IN_gla_norm FIN(float, 18)
#define IN_w_branch FIN(float, 19)
#define IN_w_out FIN(float, 20)
#define IN_ffn_norm FIN(float, 21)
#define IN_dense_w1 FIN(float, 22)
#define IN_dense_w3 FIN(float, 23)
#define IN_dense_w2 FIN(float, 24)
#define IN_router FIN(float, 25)
#define IN_moe_w1 FIN(float, 26)
#define IN_moe_w3 FIN(float, 27)
#define IN_moe_w2 FIN(float, 28)
#define IN_final_norm FIN(float, 29)
#define WSP(T, off) ((T*)(GAS T*)(F.ws + (off)))
#define WSL(T, off) ((T*)(GAS T*)(FL.ws + (off)))
__device__ __forceinline__ void relaunder(Frame& F) { int t = threadIdx.x; asm volatile("" : "+v"(t)); F.tid = t; F.lane = t & 63; F.wave = __builtin_amdgcn_readfirstlane(t >> 6);
    unsigned long long w = (unsigned long long)F.ws; asm volatile("" : "+s"(w)); F.ws = (GAS unsigned char*)w;
    int gg_ = F.G; asm volatile("" : "+s"(gg_)); F.G = gg_; int vc_ = F.vcu; asm volatile("" : "+s"(vc_)); F.vcu = vc_;
    unsigned long long ka = (unsigned long long)F.karg; asm volatile("" : "+s"(ka)); F.karg = (const char __attribute__((address_space(4)))*)ka; }

#define EPI_ROWLOOP(ai, m) _Pragma("unroll") for (int ai = 0; ai < 2; ++ai) _Pragma("unroll") for (int m = 0; m < 4; ++m)
__device__ __forceinline__ v4u pack8(const f32x4& a, const f32x4& b) { v4u w; w.x = pk2(a[0], a[1]); w.y = pk2(a[2], a[3]); w.z = pk2(b[0], b[1]); w.w = pk2(b[2], b[3]); return w; }
__device__ __forceinline__ float gelu_tanh(float x) { const float t = 1.5957691216057308f * (x + 0.044715f * x * x * x); return x * __builtin_amdgcn_rcpf(1.f + __expf(-t)); }
__device__ __forceinline__ float silu_f(float x) { return x * __builtin_amdgcn_rcpf(1.f + __expf(-x)); }
__device__ __forceinline__ f32x4 sigmoid4(const f32x4& x, float sc) { f32x4 t = x * (-1.4426950408889634f * sc);
#pragma unroll
    for (int q = 0; q < 4; ++q) t[q] = __builtin_amdgcn_exp2f(t[q]);
    t = t + 1.f;
#pragma unroll
    for (int q = 0; q < 4; ++q) t[q] = __builtin_amdgcn_rcpf(t[q]);
    return t; }
__device__ __forceinline__ f32x4 silu4(const f32x4& x) { return x * sigmoid4(x, 1.f); }
__device__ __forceinline__ f32x4 gelu_tanh4(const f32x4& x) { const f32x4 w = (x * x) * (0.044715f * 1.5957691216057308f) + 1.5957691216057308f; return x * sigmoid4(x * w, 1.f); }
__device__ __forceinline__ float log1p_fast(float e) { return e < 0.03125f ? e * (1.f + e * (-0.5f + e * (0.33333334f - 0.25f * e))) : __logf(1.f + e); }
__device__ __forceinline__ float logsig(float z) { return fminf(z, 0.f) - log1p_fast(__expf(-fabsf(z))); }

struct EpiInProj {
    bf16 *LRUX, *LRUG, *Q, *K, *V, *GQ, *GK, *GV, *GR; float* GG; const f32x2* rope; const float* gla_ba;
    __device__ __forceinline__ void operator()(f32x4 (&acc)[2][2][4][2], const pg8::Unit& u, int wr, int wc, int fr, int fq) const {
        const int row0 = u.pm * 256 + wr * 64 + fr, cw = wc * 32 + 8 * fq, pn = u.pn;
        if (pn == 4 || pn == 5 || pn == 6 || pn == 7) {
            bf16* dst = (pn < 6) ? Q : K; const float sc = (pn < 6) ? C2 : 1.f;
#pragma unroll
            for (int ai = 0; ai < 2; ++ai) {
                f32x4 c0[4][2], c1[4][2];
#pragma unroll
                for (int m = 0; m < 4; ++m)
#pragma unroll
                    for (int bj = 0; bj < 2; ++bj) { const int row = row0 + ai * 128 + m * 16, lcq = (pn & 1) * 256 + 128 * bj + cw, i0 = (lcq & 63) >> 1;
                        c0[m][bj] = *(const f32x4*)(rope + (size_t)row * 32 + i0); c1[m][bj] = *(const f32x4*)(rope + (size_t)row * 32 + i0 + 2); }
                asm volatile("" ::: "memory");
#pragma unroll
                for (int m = 0; m < 4; ++m)
#pragma unroll
                    for (int bj = 0; bj < 2; ++bj) { const int row = row0 + ai * 128 + m * 16, lcq = (pn & 1) * 256 + 128 * bj + cw, hc = lcq >> 6, i0 = (lcq & 63) >> 1;
                        const f32x4 v0 = acc[ai][bj][m][0], v1 = acc[ai][bj][m][1], cs0 = c0[m][bj], cs1 = c1[m][bj];
                        float o1[4], o2[4];
                        o1[0] = (v0[0] * cs0[0] - v0[1] * cs0[1]) * sc; o2[0] = (v0[1] * cs0[0] + v0[0] * cs0[1]) * sc;
                        o1[1] = (v0[2] * cs0[2] - v0[3] * cs0[3]) * sc; o2[1] = (v0[3] * cs0[2] + v0[2] * cs0[3]) * sc;
                        o1[2] = (v1[0] * cs1[0] - v1[1] * cs1[1]) * sc; o2[2] = (v1[1] * cs1[0] + v1[0] * cs1[1]) * sc;
                        o1[3] = (v1[2] * cs1[2] - v1[3] * cs1[3]) * sc; o2[3] = (v1[3] * cs1[2] + v1[2] * cs1[3]) * sc;
                        v2u a, b; a.x = pg8::cvt_pk_bf16(o1[0], o1[1]); a.y = pg8::cvt_pk_bf16(o1[2], o1[3]); b.x = pg8::cvt_pk_bf16(o2[0], o2[1]); b.y = pg8::cvt_pk_bf16(o2[2], o2[3]);
                        bf16* p = dst + (size_t)row * 512 + hc * 64 + i0;
                        *(v2u*)p = a; *(v2u*)(p + 32) = b; }
                asm volatile("" ::: "memory");
            }
        } else if (pn == 16) {
            f32x4 bb0[2], bb1[2];
#pragma unroll
            for (int bj = 0; bj < 2; ++bj) { bb0[bj] = *(const f32x4*)(gla_ba + 128 * bj + cw); bb1[bj] = *(const f32x4*)(gla_ba + 128 * bj + cw + 4); }
            asm volatile("" ::: "memory");
            EPI_ROWLOOP(ai, m) { const int row = row0 + ai * 128 + m * 16;
#pragma unroll
                for (int bj = 0; bj < 2; ++bj) { const int lc = 128 * bj + cw;
                    f32x4 v0 = acc[ai][bj][m][0] + bb0[bj], v1 = acc[ai][bj][m][1] + bb1[bj];
#pragma unroll
                    for (int q = 0; q < 4; ++q) { v0[q] = logsig(v0[q]) * 0.0625f; v1[q] = logsig(v1[q]) * 0.0625f; }
                    float* p = GG + (size_t)row * 256 + lc; *(f32x4*)p = v0; *(f32x4*)(p + 4) = v1; } }
        } else {
            bf16* dst; int pitch, c0, op;
            if (pn < 2) { dst = LRUX; pitch = 512; c0 = pn * 256; op = 0; }
            else if (pn < 4) { dst = LRUG; pitch = 512; c0 = (pn - 2) * 256; op = 1; }
            else if (pn < 10) { dst = V; pitch = 512; c0 = (pn - 8) * 256; op = 0; }
            else if (pn == 10) { dst = GQ; pitch = 256; c0 = 0; op = 3; }
            else if (pn == 11) { dst = GK; pitch = 256; c0 = 0; op = 0; }
            else if (pn < 14) { dst = GV; pitch = 512; c0 = (pn - 12) * 256; op = 0; }
            else { dst = GR; pitch = 512; c0 = (pn - 14) * 256; op = 2; }
            EPI_ROWLOOP(ai, m) { const int row = row0 + ai * 128 + m * 16;
#pragma unroll
                for (int bj = 0; bj < 2; ++bj) { f32x4 v0 = acc[ai][bj][m][0], v1 = acc[ai][bj][m][1];
                    if (op == 1) { v0 = gelu_tanh4(v0); v1 = gelu_tanh4(v1); }
                    else if (op == 2) { v0 = silu4(v0); v1 = silu4(v1); }
                    else if (op == 3) { v0 = v0 * 0.125f; v1 = v1 * 0.125f; }
                    *(v4u*)(dst + (size_t)row * pitch + c0 + 128 * bj + cw) = pack8(v0, v1); } }
        }
    }
};
struct EpiGG {
    float* GG; const float* gla_ba; float sc;
    __device__ __forceinline__ void operator()(f32x4 (&acc)[2][2][4][2], const pg8::Unit& u, int wr, int wc, int fr, int fq) const {
        const int row0 = u.pm * 256 + wr * 64 + fr, cw = wc * 32 + 8 * fq;
        f32x4 bb0[2], bb1[2];
#pragma unroll
        for (int bj = 0; bj < 2; ++bj) { bb0[bj] = *(const f32x4*)(gla_ba + 128 * bj + cw); bb1[bj] = *(const f32x4*)(gla_ba + 128 * bj + cw + 4); }
        asm volatile("" ::: "memory");
        EPI_ROWLOOP(ai, m) { const int row = row0 + ai * 128 + m * 16;
#pragma unroll
            for (int bj = 0; bj < 2; ++bj) { const int lc = 128 * bj + cw;
                f32x4 v0 = acc[ai][bj][m][0] * sc + bb0[bj], v1 = acc[ai][bj][m][1] * sc + bb1[bj];
#pragma unroll
                for (int q = 0; q < 4; ++q) { v0[q] = logsig(v0[q]) * 0.0625f; v1[q] = logsig(v1[q]) * 0.0625f; }
                float* p = GG + (size_t)row * 256 + lc; *(f32x4*)p = v0; *(f32x4*)(p + 4) = v1; } }
    }
};
struct EpiNull { __device__ __forceinline__ void operator()(f32x4 (&acc)[2][2][4][2], const pg8::Unit& u, int wr, int wc, int fr, int fq) const {
    EPI_ROWLOOP(ai, m) { asm volatile("" :: "v"(acc[ai][0][m][0]), "v"(acc[ai][0][m][1]), "v"(acc[ai][1][m][0]), "v"(acc[ai][1][m][1])); } } };
struct EpiStoreOnly { bf16* G;
    __device__ __forceinline__ void operator()(f32x4 (&acc)[2][2][4][2], const pg8::Unit& u, int wr, int wc, int fr, int fq) const {
        const int row0 = u.pm * 256 + wr * 64 + fr, cw = wc * 32 + 8 * fq;
        EPI_ROWLOOP(ai, m) { const int row = row0 + ai * 128 + m * 16;
#pragma unroll
            for (int bj = 0; bj < 2; ++bj) *(v4u*)(G + (size_t)row * NG_COLS + u.pn * 256 + 128 * bj + cw) = pack8(acc[ai][bj][m][0], acc[ai][bj][m][1]); } } };
struct EpiMathOnly {
    __device__ __forceinline__ void operator()(f32x4 (&acc)[2][2][4][2], const pg8::Unit& u, int wr, int wc, int fr, int fq) const {
        EPI_ROWLOOP(ai, m) {
#pragma unroll
            for (int bj = 0; bj < 2; ++bj) { f32x4 v0 = acc[ai][bj][m][0], v1 = acc[ai][bj][m][1];
#pragma unroll
                for (int q = 0; q < 4; ++q) { v0[q] = fast_sigmoid(v0[q]); v1[q] = fast_sigmoid(v1[q]); }
                v4u w = pack8(v0, v1); asm volatile("" :: "v"(w)); } } } };
__device__ __forceinline__ size_t gate_off(int pm, int gt, int ai, int m, int bj, int wr, int wc, int fr, int fq) {
    const int ri = wr * 64 + fr + ai * 128 + m * 16, ci = 128 * bj + 32 * wc + 8 * fq;
    const int sub = (ri >> 7) * 8 + ((ri >> 4) & 3) * 2 + (ci >> 7), th = ((((ri >> 6) & 1) * 4 + ((ci >> 5) & 3)) * 64) + ((ci >> 3) & 3) * 16 + (ri & 15);
    return ((((size_t)(pm * 12 + gt) * 16 + (size_t)sub) * 512) + (size_t)th) * 8; }
struct EpiGates {
    bf16* G; float sc;
    __device__ __forceinline__ void operator()(f32x4 (&acc)[2][2][4][2], const pg8::Unit& u, int wr, int wc, int fr, int fq) const {
        EPI_ROWLOOP(ai, m) {
#pragma unroll
            for (int bj = 0; bj < 2; ++bj) { f32x4 v0 = acc[ai][bj][m][0], v1 = acc[ai][bj][m][1];
                v0 = sigmoid4(v0, sc) * 255.f; v1 = sigmoid4(v1, sc) * 255.f;
                unsigned w0 = 0u, w1 = 0u;
#pragma unroll
                for (int q = 0; q < 4; ++q) { w0 = __builtin_amdgcn_cvt_pk_u8_f32(fmaxf(v0[q], 1.f), q, w0); w1 = __builtin_amdgcn_cvt_pk_u8_f32(fmaxf(v1[q], 1.f), q, w1); }
                *(v2u*)((unsigned char*)G + gate_off(u.pm, u.pn, ai, m, bj, wr, wc, fr, fq)) = (v2u){w0, w1}; } }
    }
};
struct EpiUp {
    const bf16* G; bf16* M;
    __device__ __forceinline__ void operator()(f32x4 (&acc)[2][2][4][2], const pg8::Unit& u, int wr, int wc, int fr, int fq) const {
        const int row0 = u.pm * 256 + wr * 64 + fr, cw = wc * 32 + 8 * fq, n = u.x;
        const unsigned char* G8 = (const unsigned char*)G;
        v2u g[2][4][2], h[2][4][2];
#pragma unroll
        for (int ai = 0; ai < 2; ++ai)
#pragma unroll
            for (int m = 0; m < 4; ++m)
#pragma unroll
                for (int bj = 0; bj < 2; ++bj) {
                    g[ai][m][bj] = *(const v2u*)(G8 + gate_off(u.pm, n * 4 + u.pn, ai, m, bj, wr, wc, fr, fq));
                    h[ai][m][bj] = g[ai][m][bj]; if (n < 2) h[ai][m][bj] = *(const v2u*)(G8 + gate_off(u.pm, (n + 1) * 4 + u.pn, ai, m, bj, wr, wc, fr, fq)); }
        asm volatile("" ::: "memory");
#pragma unroll
        for (int ai = 0; ai < 2; ++ai) {
#pragma unroll
            for (int m = 0; m < 4; ++m)
#pragma unroll
                for (int bj = 0; bj < 2; ++bj) { const int row = row0 + ai * 128 + m * 16, col = u.pn * 256 + 128 * bj + cw;
                    const v2u gg = g[ai][m][bj], hh = h[ai][m][bj];
                    float f[8];
#pragma unroll
                    for (int q = 0; q < 4; ++q) { const float g0 = (float)((gg.x >> (8 * q)) & 0xffu), g1 = (float)((gg.y >> (8 * q)) & 0xffu);
                        if (n < 2) { f[q] = g0 * __builtin_amdgcn_rcpf((float)((hh.x >> (8 * q)) & 0xffu)); f[4 + q] = g1 * __builtin_amdgcn_rcpf((float)((hh.y >> (8 * q)) & 0xffu)); }
                        else { f[q] = g0 * (1.f / 255.f); f[4 + q] = g1 * (1.f / 255.f); } }
                    f32x4 v0 = acc[ai][bj][m][0], v1 = acc[ai][bj][m][1];
                    v0[0] *= f[0]; v0[1] *= f[1]; v0[2] *= f[2]; v0[3] *= f[3]; v1[0] *= f[4]; v1[1] *= f[5]; v1[2] *= f[6]; v1[3] *= f[7];
                    if (n < 2) { acc[ai][bj][m][0] = v0; acc[ai][bj][m][1] = v1; asm volatile("" : "+v"(acc[ai][bj][m][0]), "+v"(acc[ai][bj][m][1])); }
                    else *(v4u*)(M + (size_t)row * DM + col) = pack8(v0, v1); }
        }
        asm volatile("" ::: "memory");
    }
};
struct EpiBf {
    bf16* O;
    __device__ __forceinline__ void operator()(f32x4 (&acc)[2][2][4][2], const pg8::Unit& u, int wr, int wc, int fr, int fq) const {
        const int row0 = u.pm * 256 + wr * 64 + fr, cw = wc * 32 + 8 * fq;
        EPI_ROWLOOP(ai, m) { const int row = row0 + ai * 128 + m * 16;
#pragma unroll
            for (int bj = 0; bj < 2; ++bj) *(v4u*)(O + (size_t)row * DM + u.pn * 256 + 128 * bj + cw) = pack8(acc[ai][bj][m][0], acc[ai][bj][m][1]); }
    }
};
struct EpiRes {
    const float* X; float* OUT;
    __device__ __forceinline__ void operator()(f32x4 (&acc)[2][2][4][2], const pg8::Unit& u, int wr, int wc, int fr, int fq) const {
        const int row0 = u.pm * 256 + wr * 64 + fr, cw = wc * 32 + 8 * fq;
#pragma unroll
        for (int ai = 0; ai < 2; ++ai) {
            f32x4 r0[4][2], r1[4][2];
#pragma unroll
            for (int m = 0; m < 4; ++m)
#pragma unroll
                for (int bj = 0; bj < 2; ++bj) { const int row = row0 + ai * 128 + m * 16, col = u.pn * 256 + 128 * bj + cw;
                    if (X) { r0[m][bj] = *(const f32x4*)(X + (size_t)row * DM + col); r1[m][bj] = *(const f32x4*)(X + (size_t)row * DM + col + 4); }
                    else { const v4u w = *(const v4u*)((const bf16*)(OUT + (size_t)row * DM) + col);
                        r0[m][bj] = (f32x4){bflo(w.x), bfhi(w.x), bflo(w.y), bfhi(w.y)}; r1[m][bj] = (f32x4){bflo(w.z), bfhi(w.z), bflo(w.w), bfhi(w.w)}; } }
            asm volatile("" ::: "memory");
#pragma unroll
            for (int m = 0; m < 4; ++m)
#pragma unroll
                for (int bj = 0; bj < 2; ++bj) { const int row = row0 + ai * 128 + m * 16, col = u.pn * 256 + 128 * bj + cw;
                    *(v4u*)((bf16*)(OUT + (size_t)row * DM) + col) = pack8(acc[ai][bj][m][0] + r0[m][bj], acc[ai][bj][m][1] + r1[m][bj]); }
            asm volatile("" ::: "memory");
        }
    }
};
__device__ __forceinline__ unsigned pk4_fp8(float a, float b, float c, float d) {
    a = fminf(fmaxf(a, -448.f), 448.f); b = fminf(fmaxf(b, -448.f), 448.f); c = fminf(fmaxf(c, -448.f), 448.f); d = fminf(fmaxf(d, -448.f), 448.f);
    int p = __builtin_amdgcn_cvt_pk_fp8_f32(a, b, 0, false); p = __builtin_amdgcn_cvt_pk_fp8_f32(c, d, p, true); return (unsigned)p; }
constexpr float F8_SA = 16.f, F8_SW13 = 256.f, F8_SH = 16.f, F8_SW2 = 512.f;
struct EpiH {
    bf16* H; int fp8; int fp8in;
    __device__ __forceinline__ void operator()(f32x4 (&acc)[2][2][4][2], const pg8::Unit& u, int wr, int wc, int fr, int fq) const {
        const int row0 = u.pm * 256 + wr * 64 + fr, cw = wc * 32 + 8 * fq;
        const float si = fp8in ? 1.f / (F8_SA * F8_SW13) : 1.f;
        const float c1 = -1.4426950408889634f * si, K = si * si * (fp8 ? F8_SH : 1.f);
        EPI_ROWLOOP(ai, m) { const int row = row0 + ai * 128 + m * 16;
            f32x4 o[2];
#pragma unroll
            for (int j = 0; j < 2; ++j) { const f32x4 a = acc[ai][0][m][j], b = acc[ai][1][m][j];
                f32x4 t = a * c1;
#pragma unroll
                for (int q = 0; q < 4; ++q) t[q] = __builtin_amdgcn_exp2f(t[q]);
                t = t + 1.f;
#pragma unroll
                for (int q = 0; q < 4; ++q) t[q] = __builtin_amdgcn_rcpf(t[q]);
                o[j] = (a * b) * (t * K); }
            if (fp8) { v2u w;
#pragma unroll
                for (int j = 0; j < 2; ++j) { f32x4 c;
#pragma unroll
                    for (int q = 0; q < 4; ++q) c[q] = __builtin_amdgcn_fmed3f(o[j][q], -448.f, 448.f);
                    int pk = __builtin_amdgcn_cvt_pk_fp8_f32(c[0], c[1], 0, false); pk = __builtin_amdgcn_cvt_pk_fp8_f32(c[2], c[3], pk, true); if (j == 0) w.x = (unsigned)pk; else w.y = (unsigned)pk; }
                *(v2u*)((unsigned char*)H + (size_t)row * DFF + u.pn * 128 + cw) = w; }
            else *(v4u*)(H + (size_t)row * DFF + u.pn * 128 + cw) = pack8(o[0], o[1]); }
    }
};
struct EpiW2 {
    const int* slot_tok; const float* slot_w; bf16* Y1; bf16* Y2; int dense; float oscale;
    __device__ __forceinline__ void operator()(f32x4 (&acc)[2][2][4][2], const pg8::Unit& u, int wr, int wc, int fr, int fq) const {
        const int s0 = u.x + wr * 64 + fr, cw = wc * 32 + 8 * fq;
        int st[2][4]; float wv[2][4];
#pragma unroll
        for (int ai = 0; ai < 2; ++ai)
#pragma unroll
            for (int m = 0; m < 4; ++m) { st[ai][m] = slot_tok[s0 + ai * 128 + m * 16]; wv[ai][m] = slot_w[s0 + ai * 128 + m * 16] * oscale; }
        asm volatile("" ::: "memory");
#pragma unroll
        for (int ai = 0; ai < 2; ++ai)
#pragma unroll
            for (int m = 0; m < 4; ++m) { const int s = st[ai][m];
                if (s >= 0) { const int tok = s & 0xffff; bf16* Y = (dense || (s >> 20)) ? Y2 : Y1; const float w = wv[ai][m];
#pragma unroll
                    for (int bj = 0; bj < 2; ++bj) { const size_t o = (size_t)tok * DM + u.pn * 256 + 128 * bj + cw;
                        *(v4u*)(Y + o) = pack8(acc[ai][bj][m][0] * w, acc[ai][bj][m][1] * w); } } }
        asm volatile("" ::: "memory");
    }
};

struct SchedPlain {
    const char* A; const char* Bt; int nM, nN, KB, G, c;
    __device__ __forceinline__ bool next(int i, pg8::Unit& u) const {
        const long L = (long)i * G + c; if (L >= (long)nM * nN) return false;
        int pm, pn; pg8::tile_of((int)L, nM, nN, pm, pn); u.pm = pm; u.pn = pn; u.x = 0; u.gs = 0; u.keep = 0;
        u.a = A + (size_t)pm * 256 * KB; u.b = Bt + (size_t)pn * 256 * KB; return true; }
    __device__ __forceinline__ void a_ready(const pg8::Unit&) const {}
    __device__ __forceinline__ void done(const pg8::Unit&) const {}
    __device__ __forceinline__ int row(int) const { return 0; }
};
struct SchedUp {
    const char* Y; const char* W; int G, c;
    __device__ __forceinline__ bool next(int i, pg8::Unit& u) const {
        const int j = i / 3, n = i - 3 * j; const long L = (long)j * G + c; if (L >= 128 * 4) return false;
        int pm, pn; pg8::tile_of((int)L, 128, 4, pm, pn); u.pm = pm; u.pn = pn; u.x = n; u.gs = 0; u.keep = (n < 2) ? 1 : 0;
        u.a = Y + (size_t)n * (32 * MiB) + (size_t)pm * 256 * BW * 2; u.b = W + (size_t)n * (DM * BW * 2) + (size_t)pn * 256 * BW * 2; return true; }
    __device__ __forceinline__ void a_ready(const pg8::Unit&) const {}
    __device__ __forceinline__ void done(const pg8::Unit&) const {}
    __device__ __forceinline__ int row(int) const { return 0; }
};
struct SchedPitchA {
    const char* A; const char* Bt; int nM, nN, KB, PA, G, c;
    __device__ __forceinline__ bool next(int i, pg8::Unit& u) const {
        const long L = (long)i * G + c; if (L >= (long)nM * nN) return false;
        int pm, pn; pg8::tile_of((int)L, nM, nN, pm, pn); u.pm = pm; u.pn = pn; u.x = 0; u.gs = 0; u.keep = 0;
        u.a = A + (size_t)pm * 256 * PA; u.b = Bt + (size_t)pn * 256 * KB; return true; }
    __device__ __forceinline__ void a_ready(const pg8::Unit&) const {}
    __device__ __forceinline__ void done(const pg8::Unit&) const {}
    __device__ __forceinline__ int row(int) const { return 0; }
};
struct SchedMoE {
    const char* A; const char* W; const int* slot_tok; volatile LAS unsigned* ts; int t0, nM, nN, KB, G, c, w2; size_t WEB, W2O;
    __device__ __forceinline__ bool next(int i, pg8::Unit& u) const {
        const long L = (long)i * G + c; if (L >= (long)nM * nN) return false;
        int pm, pn; pg8::tile_of((int)L, nM, nN, pm, pn); const int tile = t0 + pm;
        int e = 0;
#pragma unroll
        for (int j = 1; j < 8; ++j) e += (tile >= (int)ts[j]) ? 1 : 0;
        u.pm = pm; u.pn = pn; u.x = tile * 256; u.gs = tile * 256; u.keep = 0;
        if (w2) { u.a = A + (size_t)pm * 256 * KB; u.b = W + (size_t)e * WEB + W2O + (size_t)pn * 256 * KB; }
        else { u.a = A; u.b = W + (size_t)e * WEB + (size_t)pn * 256 * KB; }
        return true; }
    __device__ __forceinline__ void a_ready(const pg8::Unit&) const {}
    __device__ __forceinline__ void done(const pg8::Unit&) const {}
    __device__ __forceinline__ int row(int slot) const { const int st = slot_tok[slot]; return st < 0 ? 0 : (st & 0xffff); }
};

#ifndef FOLD_FP8
#define FOLD_FP8 1
#endif
#ifndef XN8_SLOT
#define XN8_SLOT 1
#endif
#ifndef MOE_CHECK
#define MOE_CHECK 0
#endif
#ifndef GATES_FP8
#define GATES_FP8 1
#endif
#ifndef DENSE_FP8
#define DENSE_FP8 0
#endif
#ifndef MOE_FP8
#define MOE_FP8 1
#endif
#define LBAR() asm volatile("s_waitcnt lgkmcnt(0)\n\ts_barrier" ::: "memory")
__device__ __forceinline__ int crow16(int r, int hi) { return (r & 3) + 8 * (r >> 2) + 4 * hi; }
__device__ __forceinline__ void mma32(f32x16& acc, const LAS bf16* A, int lda, const LAS bf16* Bt, int ldb, int K, int lane) {
    const int r = lane & 31, h = lane >> 5;
    for (int k0 = 0; k0 < K; k0 += 16) {
        const bf16x8 a = *(const LAS bf16x8*)(A + r * lda + k0 + 8 * h);
        const bf16x8 b = *(const LAS bf16x8*)(Bt + r * ldb + k0 + 8 * h);
        acc = __builtin_amdgcn_mfma_f32_32x32x16_bf16(a, b, acc, 0, 0, 0);
    }
}

__device__ __forceinline__ int maprow(int kind, int c, int off) {
    if (kind == 1) { if (c >= 1024 && c < 2048) { const int rel = c - 1024, blk = rel >> 6, w = rel & 63; return 1024 + blk * 64 + 2 * (w & 31) + (w >> 5); } return c; }
    if (kind == 2) return 256 * (c >> 7) + (c & 127);
    if (kind == 3) return 256 * (c >> 7) + 128 + (c & 127);
    return c + off;
}
__device__ __forceinline__ void cvt_item(const float* W, int K, int Nsrc, int c0, int nblk, bf16* WT, int kind, int off, LAS float* scr, int item, int lane) {
    const int kb = item / nblk, nb = item - kb * nblk, k0 = 64 * kb, n0 = c0 + 32 * nb;
    { f32x4 t[8];
#pragma unroll
        for (int i = 0; i < 8; ++i) t[i] = *(const GAS f32x4*)(W + (size_t)(k0 + 8 * i + (lane >> 3)) * Nsrc + n0 + 4 * (lane & 7));
#pragma unroll
        for (int i = 0; i < 8; ++i) { LAS float* d = scr + (8 * i + (lane >> 3)) * 33 + 4 * (lane & 7); d[0] = t[i][0]; d[1] = t[i][1]; d[2] = t[i][2]; d[3] = t[i][3]; } }
    LDS_WAIT(); asm volatile("" ::: "memory");
    const int c = lane & 7;
#pragma unroll
    for (int j = 0; j < 4; ++j) { const int n = (lane >> 3) + 8 * j; const LAS float* s = scr + (8 * c) * 33 + n;
        v4u o; o.x = pk2(s[0 * 33], s[1 * 33]); o.y = pk2(s[2 * 33], s[3 * 33]); o.z = pk2(s[4 * 33], s[5 * 33]); o.w = pk2(s[6 * 33], s[7 * 33]);
        *(GAS v4u*)(WT + (size_t)maprow(kind, n0 + n, off) * K + k0 + 8 * c) = o; }
    LDS_WAIT(); asm volatile("" ::: "memory");
}
__device__ __forceinline__ void cvt_item_fp8(const float* W, int K, int Nsrc, int c0, int nblk, unsigned char* WT, int kind, int off, float scale, LAS float* scr, int item, int lane) {
    const int kb = item / nblk, nb = item - kb * nblk, k0 = 64 * kb, n0 = c0 + 32 * nb;
    { f32x4 t[8];
#pragma unroll
        for (int i = 0; i < 8; ++i) t[i] = *(const GAS f32x4*)(W + (size_t)(k0 + 8 * i + (lane >> 3)) * Nsrc + n0 + 4 * (lane & 7));
#pragma unroll
        for (int i = 0; i < 8; ++i) { LAS float* d = scr + (8 * i + (lane >> 3)) * 33 + 4 * (lane & 7); d[0] = t[i][0] * scale; d[1] = t[i][1] * scale; d[2] = t[i][2] * scale; d[3] = t[i][3] * scale; } }
    LDS_WAIT(); asm volatile("" ::: "memory");
    const int c = lane & 7;
#pragma unroll
    for (int j = 0; j < 4; ++j) { const int n = (lane >> 3) + 8 * j; const LAS float* s = scr + (8 * c) * 33 + n;
        v2u o; o.x = pk4_fp8(s[0 * 33], s[1 * 33], s[2 * 33], s[3 * 33]); o.y = pk4_fp8(s[4 * 33], s[5 * 33], s[6 * 33], s[7 * 33]);
        *(GAS v2u*)(WT + (size_t)maprow(kind, n0 + n, off) * K + k0 + 8 * c) = o; }
    LDS_WAIT(); asm volatile("" ::: "memory");
}
__device__ __forceinline__ void fold_item(const float* W, const float* wa2, bf16* WT, LAS float* scr, int item, int lane) {
    const int kb = item >> 3, jb = item & 7, k0 = 64 * kb, j0 = 32 * jb, jj = lane & 31;
    float w2[16];
#pragma unroll
    for (int r = 0; r < 16; ++r) w2[r] = wa2[r * 256 + j0 + jj];
    for (int i = 0; i < 32; ++i) { const int kk = 2 * i + (lane >> 5); const float* wr = W + (size_t)(k0 + kk) * W_IN_COLS + 4096; float s = 0.f;
#pragma unroll
        for (int r = 0; r < 16; ++r) s += wr[r] * w2[r];
        scr[kk * 33 + jj] = s; }
    LDS_WAIT(); asm volatile("" ::: "memory");
    const int c = lane & 7;
#pragma unroll
    for (int j = 0; j < 4; ++j) { const int n = (lane >> 3) + 8 * j; const LAS float* s = scr + (8 * c) * 33 + n;
        if (FOLD_FP8 && GATES_FP8 && XN8_SLOT) { v2u o; o.x = pk4_fp8(s[0 * 33] * F8_SW13, s[1 * 33] * F8_SW13, s[2 * 33] * F8_SW13, s[3 * 33] * F8_SW13); o.y = pk4_fp8(s[4 * 33] * F8_SW13, s[5 * 33] * F8_SW13, s[6 * 33] * F8_SW13, s[7 * 33] * F8_SW13);
            *(GAS v2u*)((unsigned char*)(WT + (size_t)4096 * DM) + (size_t)(j0 + n) * DM + k0 + 8 * c) = o; }
        else { v4u o; o.x = pk2(s[0 * 33], s[1 * 33]); o.y = pk2(s[2 * 33], s[3 * 33]); o.z = pk2(s[4 * 33], s[5 * 33]); o.w = pk2(s[6 * 33], s[7 * 33]);
        *(GAS v4u*)(WT + (size_t)(4096 + j0 + n) * DM + k0 + 8 * c) = o; } }
    LDS_WAIT(); asm volatile("" ::: "memory");
}
__device__ __forceinline__ void rms_row(const float* xrow, const bf16* addrow, float* hout, const f32x4 (&g)[4], f32x4 (&v)[4], int lane) {
    const GAS f32x4* xr = (const GAS f32x4*)xrow + lane; float s = 0.f;
#pragma unroll
    for (int j = 0; j < 4; ++j) { v[j] = xr[64 * j];
        if (addrow) { const v2u a = *((const GAS v2u*)addrow + lane + 64 * j); v[j][0] += bflo(a.x); v[j][1] += bfhi(a.x); v[j][2] += bflo(a.y); v[j][3] += bfhi(a.y); }
        if (hout) ((GAS f32x4*)hout + lane)[64 * j] = v[j];
        s += (v[j][0] * v[j][0] + v[j][1] * v[j][1]) + (v[j][2] * v[j][2] + v[j][3] * v[j][3]); }
    const float rstd = __builtin_amdgcn_rsqf(wave_sum(s) * (1.f / DM) + EPS);
#pragma unroll
    for (int j = 0; j < 4; ++j) v[j] = v[j] * rstd * g[j];
}
__device__ __forceinline__ void store_row_bf16(bf16* orow, const f32x4 (&v)[4], int lane) {
    GAS v2u* o8 = (GAS v2u*)orow + lane;
#pragma unroll
    for (int j = 0; j < 4; ++j) { v2u w; w.x = pk2(v[j][0], v[j][1]); w.y = pk2(v[j][2], v[j][3]); o8[64 * j] = w; }
}

struct RowLd { f32x4 x[4]; v2u xb[4]; v2u a[4]; };
__device__ __forceinline__ void row_load(RowLd& r, const float* xrow, const bf16* addrow, int lane, bool xs) {
    if (xs) {
#pragma unroll
        for (int j = 0; j < 4; ++j) r.xb[j] = *((const GAS v2u*)xrow + lane + 64 * j);
    } else { const GAS f32x4* xr = (const GAS f32x4*)xrow + lane;
#pragma unroll
        for (int j = 0; j < 4; ++j) r.x[j] = xr[64 * j]; }
    if (addrow) {
#pragma unroll
        for (int j = 0; j < 4; ++j) r.a[j] = *((const GAS v2u*)addrow + lane + 64 * j); }
    asm volatile("" ::: "memory");
}
__device__ __forceinline__ void row_finish(const RowLd& r, bool hasadd, float* hout, const f32x4 (&g)[4], f32x4 (&v)[4], int lane, bool xs) {
    float s = 0.f;
#pragma unroll
    for (int j = 0; j < 4; ++j) {
        if (xs) { v[j][0] = bflo(r.xb[j].x); v[j][1] = bfhi(r.xb[j].x); v[j][2] = bflo(r.xb[j].y); v[j][3] = bfhi(r.xb[j].y); } else v[j] = r.x[j];
        if (hasadd) { const v2u a = r.a[j]; v[j][0] += bflo(a.x); v[j][1] += bfhi(a.x); v[j][2] += bflo(a.y); v[j][3] += bfhi(a.y); }
        if (hout) { v2u w; w.x = pk2(v[j][0], v[j][1]); w.y = pk2(v[j][2], v[j][3]); ((GAS v2u*)hout + lane)[64 * j] = w; }
        s += (v[j][0] * v[j][0] + v[j][1] * v[j][1]) + (v[j][2] * v[j][2] + v[j][3] * v[j][3]); }
    const float rstd = __builtin_amdgcn_rsqf(wave_sum(s) * (1.f / DM) + EPS);
#pragma unroll
    for (int j = 0; j < 4; ++j) v[j] = v[j] * rstd * g[j];
}

__device__ __forceinline__ void phase_prep(const Frame& F0, int layer) {
    Frame F = F0; relaunder(F);
    LAS float* scr = (LAS float*)(F.lds + F.wave * 16384);
    const int gw = F.vcu * NWAVES + F.wave, NGW = F.G * NWAVES;
    const float* win = IN_w_in + (size_t)layer * DM * W_IN_COLS;
    bf16* WIN = WSP(bf16, WS_WIN); bf16* WBR = WSP(bf16, WS_WBR); bf16* WOUT = WSP(bf16, WS_WOUT);
    constexpr int I0 = 16 * 128, I1 = 16 * 96, I2 = 8 * 32, I5 = 16 * 32, IF = 128;
    constexpr int NITEMS = I0 + I1 + 3 * I2 + I5 + IF;
    for (int it = gw; it < NITEMS; it += NGW) {
        int r = it;
        if (r < I0) { cvt_item(win, DM, W_IN_COLS, 0, 128, WIN, 1, 0, scr, r, F.lane); continue; } r -= I0;
        if (r < I1) { if (GATES_FP8) cvt_item_fp8(win, DM, W_IN_COLS, 4112, 96, (unsigned char*)(WIN + (size_t)NA_COLS * DM), 0, -4112, F8_SW13, scr, r, F.lane);
                      else cvt_item(win, DM, W_IN_COLS, 4112, 96, WIN, 0, NA_COLS - 4112, scr, r, F.lane); continue; } r -= I1;
        if (r < 3 * I2) { const int n = r / I2; cvt_item(IN_w_branch + ((size_t)layer * 3 + n) * BW * DM, BW, DM, 0, 32, WBR + (size_t)n * DM * BW, 0, 0, scr, r - n * I2, F.lane); continue; } r -= 3 * I2;
        if (r < I5) { cvt_item(IN_w_out + (size_t)layer * DM * DM, DM, DM, 0, 32, WOUT, 0, 0, scr, r, F.lane); continue; } r -= I5;
        fold_item(win, IN_gla_wa2 + (size_t)layer * 16 * 256, WIN, scr, r, F.lane);
    }
    const float* src = layer == 0 ? IN_x : F.out;
    f32x4 g[4];
#pragma unroll
    for (int j = 0; j < 4; ++j) g[j] = *((const f32x4*)(IN_mix_norm + (size_t)layer * DM) + F.lane + 64 * j);
    bf16* XN = WSP(bf16, WS_XN);
    const bf16* FO = WSP(bf16, WS_Y2);
    { RowLd cur; if (gw < NTOK) row_load(cur, src + (size_t)gw * DM, nullptr, F.lane, layer != 0);
      for (int m = gw; m < NTOK; m += NGW) { RowLd nxt; const int mn = m + NGW;
        if (mn < NTOK) row_load(nxt, src + (size_t)mn * DM, nullptr, F.lane, layer != 0);
        f32x4 v[4]; row_finish(cur, false, nullptr, g, v, F.lane, layer != 0); store_row_bf16(XN + (size_t)m * DM, v, F.lane);
        if (GATES_FP8 && XN8_SLOT) { GAS unsigned* o4 = (GAS unsigned*)((unsigned char*)F.out + (size_t)m * (DM * 4) + 2048) + F.lane;
#pragma unroll
            for (int j = 0; j < 4; ++j) o4[64 * j] = pk4_fp8(v[j][0] * F8_SA, v[j][1] * F8_SA, v[j][2] * F8_SA, v[j][3] * F8_SA); }
        cur = nxt; } }
    if (layer == 0) {
        f32x2* rope = WSP(f32x2, WS_ROPE);
        const int i = F.lane & 31;
        const float inv = exp2f(-(float)i * (13.287712379549449f / 32.0f));
        for (int m = gw * 2 + (F.lane >> 5); m < NTOK; m += NGW * 2) {
            const float ang = (float)IN_positions[m] * inv;
            const double rev = (double)ang * 0.15915494309189535; const float fr = (float)(rev - floor(rev));
            f32x2 cs; cs.x = __builtin_amdgcn_cosf(fr); cs.y = __builtin_amdgcn_sinf(fr);
            rope[(size_t)m * 32 + i] = cs; }
    }
}

__device__ __forceinline__ void lru_pass1(const Frame& F0, int layer, int unit) {
    Frame F = F0; relaunder(F);
    const int c = unit & 31, b = unit >> 5, tid = F.tid, lane = F.lane, wave = F.wave;
    LAS bf16* XS = (LAS bf16*)(F.lds);
    LAS bf16* UB = (LAS bf16*)(F.lds + 16896);
    LAS bf16* WAT = (LAS bf16*)(F.lds + 35328);
    LAS bf16* WXT = (LAS bf16*)(F.lds + 44544);
    LAS float* AF = (LAS float*)(F.lds + 53760);
    LAS bf16* BFh = (LAS bf16*)(F.lds + 86528);
    LAS float* WS = (LAS float*)(F.lds + 102912);
    LAS float* CW = (LAS float*)(F.lds + 107008);
    LAS float* GB = (LAS float*)(F.lds + 117248);
    const bf16* LRUX = WSP(bf16, WS_LRUX); const bf16* LG = WSP(bf16, WS_LRUG); bf16* PG = WSP(bf16, WS_PG); bf16* Y = WSP(bf16, WS_YLRU);
    const int s0 = c * 128;
    { const float* cwp = IN_conv_w + (size_t)layer * 4 * BW;
#pragma unroll
        for (int j = 0; j < 4; ++j) CW[j * 512 + tid] = cwp[j * BW + tid];
        CW[4 * 512 + tid] = IN_conv_b[(size_t)layer * BW + tid];
        GB[tid] = IN_lru_ba[(size_t)layer * BW + tid]; GB[512 + tid] = IN_lru_bx[(size_t)layer * BW + tid];
        const float lam = IN_lru_lambda[(size_t)layer * BW + tid]; GB[1024 + tid] = fmaxf(-lam, 0.f) + log1p_fast(__expf(-fabsf(lam))); }
    v4u xr[3]; float wa[8], wx[8];
    const int wj = tid & 63, wi0 = (tid >> 6) * 8;
#define LRU_PREFETCH(g) do { \
        _Pragma("unroll") for (int p = 0; p < 3; ++p) { const int rr = (tid >> 3) + 64 * p, sp = s0 - 3 + rr; xr[p] = (v4u){0u, 0u, 0u, 0u}; \
            if (rr < 131 && sp >= 0) xr[p] = *(const v4u*)(LRUX + ((size_t)(b * SEQ + sp)) * 512 + (g) * 64 + (tid & 7) * 8); } \
        const float* wa_ = IN_lru_wa + (((size_t)layer * 8 + (g)) * 64 + wi0) * 64 + wj; const float* wx_ = IN_lru_wx + (((size_t)layer * 8 + (g)) * 64 + wi0) * 64 + wj; \
        _Pragma("unroll") for (int q = 0; q < 8; ++q) { wa[q] = wa_[q * 64]; wx[q] = wx_[q * 64]; } } while (0)
    LRU_PREFETCH(0);
#pragma unroll 1
    for (int g = 0; g < 8; ++g) {
#pragma unroll
        for (int p = 0; p < 3; ++p) { const int rr = (tid >> 3) + 64 * p; if (rr < 131) *(LAS v4u*)(XS + rr * 64 + (tid & 7) * 8) = xr[p]; }
        { v4u o; o.x = pk2(wa[0], wa[1]); o.y = pk2(wa[2], wa[3]); o.z = pk2(wa[4], wa[5]); o.w = pk2(wa[6], wa[7]); *(LAS v4u*)(WAT + wj * 72 + wi0) = o;
          o.x = pk2(wx[0], wx[1]); o.y = pk2(wx[2], wx[3]); o.z = pk2(wx[4], wx[5]); o.w = pk2(wx[6], wx[7]); *(LAS v4u*)(WXT + wj * 72 + wi0) = o; }
        const size_t obase = ((size_t)(b * SEQ + s0 + 16 * wave)) * 512 + g * 64 + lane;
        bf16 gt[16];
#pragma unroll
        for (int j = 0; j < 16; ++j) gt[j] = LG[obase + (size_t)j * 512];
        LBAR();
        if (g + 1 < 8) LRU_PREFETCH(g + 1);
        { const int tok = tid >> 2, ch0 = (tid & 3) * 16; const LAS float* cwl = CW + g * 64 + ch0;
            float u[16];
#pragma unroll
            for (int q = 0; q < 16; ++q) u[q] = cwl[4 * 512 + q];
#pragma unroll
            for (int j = 0; j < 4; ++j) { const v4u x0 = *(const LAS v4u*)(XS + (tok + j) * 64 + ch0), x1 = *(const LAS v4u*)(XS + (tok + j) * 64 + ch0 + 8); const LAS float* w = cwl + j * 512;
                u[0] += w[0] * bflo(x0.x); u[1] += w[1] * bfhi(x0.x); u[2] += w[2] * bflo(x0.y); u[3] += w[3] * bfhi(x0.y); u[4] += w[4] * bflo(x0.z); u[5] += w[5] * bfhi(x0.z); u[6] += w[6] * bflo(x0.w); u[7] += w[7] * bfhi(x0.w);
                u[8] += w[8] * bflo(x1.x); u[9] += w[9] * bfhi(x1.x); u[10] += w[10] * bflo(x1.y); u[11] += w[11] * bfhi(x1.y); u[12] += w[12] * bflo(x1.z); u[13] += w[13] * bfhi(x1.z); u[14] += w[14] * bflo(x1.w); u[15] += w[15] * bfhi(x1.w); }
            v4u o0, o1; o0.x = pk2(u[0], u[1]); o0.y = pk2(u[2], u[3]); o0.z = pk2(u[4], u[5]); o0.w = pk2(u[6], u[7]); o1.x = pk2(u[8], u[9]); o1.y = pk2(u[10], u[11]); o1.z = pk2(u[12], u[13]); o1.w = pk2(u[14], u[15]);
            *(LAS v4u*)(UB + tok * 72 + ch0) = o0; *(LAS v4u*)(UB + tok * 72 + ch0 + 8) = o1; }
        LBAR();
        { const int tt = wave >> 1, tc = wave & 1, hi = lane >> 5, ch = 32 * tc + (lane & 31), gch = g * 64 + ch;
            f32x16 racc = {}, iacc = {};
            mma32(racc, UB + tt * 32 * 72, 72, WAT + tc * 32 * 72, 72, 64, lane);
            mma32(iacc, UB + tt * 32 * 72, 72, WXT + tc * 32 * 72, 72, 64, lane);
            const float ba = GB[gch], bx = GB[512 + gch], sp = GB[1024 + gch];
#pragma unroll
            for (int r = 0; r < 16; ++r) { const int tok = 32 * tt + crow16(r, hi);
                const float uval = bf2f(UB[tok * 72 + ch]);
                const float rg = fast_sigmoid(racc[r] + ba), ig = fast_sigmoid(iacc[r] + bx);
                const float la = -8.f * rg * sp, a = __expf(la), mult = __builtin_amdgcn_sqrtf(fmaxf(1.f - a * a, 0.f));
                AF[tok * 64 + ch] = a; BFh[tok * 64 + ch] = (bf16)f2bf(mult * (ig * uval)); } }
        LBAR();
        float hl[16], pl[16]; float h = 0.f, P = 1.f;
#pragma unroll
        for (int j = 0; j < 16; ++j) { const float a = AF[(16 * wave + j) * 64 + lane], bb = bf2f(BFh[(16 * wave + j) * 64 + lane]); h = a * h + bb; P *= a; hl[j] = h; pl[j] = P; }
        WS[(wave * 64 + lane) * 2] = P; WS[(wave * 64 + lane) * 2 + 1] = h;
        LBAR();
        { float cin = 0.f, pin = 1.f, At = 1.f, Ht = 0.f;
#pragma unroll
            for (int w = 0; w < 8; ++w) { const float p = WS[(w * 64 + lane) * 2], q = WS[(w * 64 + lane) * 2 + 1]; if (w < wave) { cin = p * cin + q; pin *= p; } Ht = p * Ht + q; At *= p; }
            if (wave == 7) { f32x2 sm; sm.x = At; sm.y = Ht; WSP(f32x2, WS_LRUS)[((size_t)(b * 32 + c)) * 512 + g * 64 + lane] = sm; }
            LAS bf16* YT = (LAS bf16*)(F.lds + 53760); LAS bf16* PT = (LAS bf16*)(F.lds + 53760 + 16384);
#pragma unroll
            for (int j = 0; j < 16; ++j) { const float gv = bf2f(gt[j]); YT[(16 * wave + j) * 64 + lane] = (bf16)f2bf((hl[j] + pl[j] * cin) * gv); PT[(16 * wave + j) * 64 + lane] = (bf16)f2bf(pl[j] * pin * gv); }
            LBAR();
            { const int tok = tid >> 2, sg = (tid & 3) * 16; const size_t o = ((size_t)(b * SEQ + s0 + tok)) * 512 + g * 64 + sg;
                const v4u y0 = *(const LAS v4u*)(YT + tok * 64 + sg), y1 = *(const LAS v4u*)(YT + tok * 64 + sg + 8), p0 = *(const LAS v4u*)(PT + tok * 64 + sg), p1 = *(const LAS v4u*)(PT + tok * 64 + sg + 8);
                *(v4u*)(Y + o) = y0; *(v4u*)(Y + o + 8) = y1; *(v4u*)(PG + o) = p0; *(v4u*)(PG + o + 8) = p1; } }
    }
#undef LRU_PREFETCH
    LBAR();
}
__device__ __forceinline__ void lru_fix_unit(const Frame& F0, int unit) {
    Frame F = F0; relaunder(F);
    const int c = 1 + unit % 31, b = unit / 31, tid = F.tid;
    LAS float* CR = (LAS float*)(F.lds);
    const f32x2* SUM = WSP(f32x2, WS_LRUS);
    { f32x2 sm[32]; float Hin = 0.f;
#pragma unroll
        for (int cc = 0; cc < 32; ++cc) sm[cc] = (cc < c) ? SUM[((size_t)(b * 32 + cc)) * 512 + tid] : (f32x2){1.f, 0.f};
#pragma unroll
        for (int cc = 0; cc < 32; ++cc) Hin = sm[cc].x * Hin + sm[cc].y;
        CR[tid] = Hin; }
    __syncthreads();
    const int seg = tid & 63, r0 = tid >> 6;
    float cr[8];
#pragma unroll
    for (int q = 0; q < 8; ++q) cr[q] = CR[seg * 8 + q];
    const bf16* LG = WSP(bf16, WS_PG); bf16* Y = WSP(bf16, WS_YLRU);
#pragma unroll
    for (int half = 0; half < 2; ++half) {
        v4u hv[8], pv[8];
#pragma unroll
        for (int it = 0; it < 8; ++it) { const size_t o = ((size_t)(b * SEQ + c * 128 + half * 64 + it * 8 + r0)) * 512 + seg * 8; hv[it] = *(const v4u*)(Y + o); pv[it] = *(const v4u*)(LG + o); }
        asm volatile("" ::: "memory");
#pragma unroll
        for (int it = 0; it < 8; ++it) { const size_t o = ((size_t)(b * SEQ + c * 128 + half * 64 + it * 8 + r0)) * 512 + seg * 8; const v4u hh = hv[it], pp = pv[it]; v4u w;
            w.x = pk2(bflo(hh.x) + bflo(pp.x) * cr[0], bfhi(hh.x) + bfhi(pp.x) * cr[1]); w.y = pk2(bflo(hh.y) + bflo(pp.y) * cr[2], bfhi(hh.y) + bfhi(pp.y) * cr[3]);
            w.z = pk2(bflo(hh.z) + bflo(pp.z) * cr[4], bfhi(hh.z) + bfhi(pp.z) * cr[5]); w.w = pk2(bflo(hh.w) + bflo(pp.w) * cr[6], bfhi(hh.w) + bfhi(pp.w) * cr[7]);
            *(v4u*)(Y + o) = w; }
        asm volatile("" ::: "memory");
    }
    __syncthreads();
}

__device__ __forceinline__ void gla_unit(const Frame& F0, int layer, int bh) {
    Frame F = F0; relaunder(F);
    const int b = bh >> 2, h = bh & 3, tid = F.tid, lane = F.lane, wave = F.wave, hi = lane >> 5;
    LAS bf16* QD = (LAS bf16*)(F.lds);
    LAS bf16* KD = (LAS bf16*)(F.lds + 9216);
    LAS bf16* QE = (LAS bf16*)(F.lds + 18432);
    LAS bf16* KDT = (LAS bf16*)(F.lds + 27648);
    LAS bf16* ATT = (LAS bf16*)(F.lds + 36864);
    LAS bf16* VT = (LAS bf16*)(F.lds + 46080);
    LAS bf16* ST = (LAS bf16*)(F.lds + 64512);
    LAS float* BC = (LAS float*)(F.lds + 82944);
    LAS float* OACC = (LAS float*)(F.lds + 82944);
    LAS float* DEC = (LAS float*)(F.lds + 116736);
    const bf16* GQ = WSP(bf16, WS_GQ); const bf16* GK = WSP(bf16, WS_GK); const bf16* GV = WSP(bf16, WS_GV); const bf16* GR = WSP(bf16, WS_GR); const float* GG = WSP(float, WS_GG);
    bf16* Y = WSP(bf16, WS_YGLA);
    LAS float* TOT = (LAS float*)(F.lds + 116992);
    const int tok = tid >> 3, seg = tid & 7;
    const int cdk = tid & 63, tg = tid >> 6;
    const int cdv = tid & 127, vg = tid >> 7;
    float gn[16];
#pragma unroll
    for (int q = 0; q < 16; ++q) gn[q] = IN_gla_norm[(size_t)layer * 128 + seg * 16 + q];
    for (int i = tid; i < 128 * 72; i += 512) ST[i] = 0;
    f32x16 S = {};
    const int tm = wave >> 2, tn = wave & 3;
    unsigned short qr_[8], kr_[8], vr_[16]; float g_[8];
#define GLA_PREFETCH(n_) do { const size_t r0_ = (size_t)b * SEQ + (size_t)(n_) * 64; \
        _Pragma("unroll") for (int i = 0; i < 8; ++i) { const size_t r_ = (r0_ + tg * 8 + i) * 256 + h * 64 + cdk; qr_[i] = GQ[r_]; kr_[i] = GK[r_]; g_[i] = GG[r_]; } \
        _Pragma("unroll") for (int i = 0; i < 16; ++i) vr_[i] = GV[(r0_ + vg * 16 + i) * 512 + h * 128 + cdv]; } while (0)
    GLA_PREFETCH(0);
    LBAR();
    for (int n = 0; n < 64; ++n) {
        const size_t row = (size_t)b * SEQ + n * 64 + tok;
        float c_[8];
        c_[0] = g_[0];
#pragma unroll
        for (int i = 1; i < 8; ++i) c_[i] = c_[i - 1] + g_[i];
        TOT[tg * 64 + cdk] = c_[7];
        { v4u w0, w1;
            w0.x = (unsigned)vr_[0] | ((unsigned)vr_[1] << 16); w0.y = (unsigned)vr_[2] | ((unsigned)vr_[3] << 16); w0.z = (unsigned)vr_[4] | ((unsigned)vr_[5] << 16); w0.w = (unsigned)vr_[6] | ((unsigned)vr_[7] << 16);
            w1.x = (unsigned)vr_[8] | ((unsigned)vr_[9] << 16); w1.y = (unsigned)vr_[10] | ((unsigned)vr_[11] << 16); w1.z = (unsigned)vr_[12] | ((unsigned)vr_[13] << 16); w1.w = (unsigned)vr_[14] | ((unsigned)vr_[15] << 16);
            *(LAS v4u*)(VT + cdv * 72 + vg * 16) = w0; *(LAS v4u*)(VT + cdv * 72 + vg * 16 + 8) = w1; }
        const v4u ra = *(const v4u*)(GR + row * 512 + h * 128 + seg * 16), rb = *(const v4u*)(GR + row * 512 + h * 128 + seg * 16 + 8);
        LBAR();
        {
            float base = 0.f, rf = 0.f, bl = 0.f;
#pragma unroll
            for (int w = 0; w < 8; ++w) { const float tw = TOT[w * 64 + cdk]; if (w < tg) base += tw; if (w < 4) rf += tw; bl += tw; }
            unsigned kt[8]; const float erf = __expf(rf), elr = __expf(bl - rf);
#pragma unroll
            for (int i = 0; i < 8; ++i) { const float bc = base + c_[i], qf = bf2f(qr_[i]), kf = bf2f(kr_[i]); const int t_ = tg * 8 + i;
                const float qd = qf * __expf(bc - rf), kd = kf * __expf(rf - bc);
                QD[t_ * 72 + cdk] = (bf16)f2bf(qd); KD[t_ * 72 + cdk] = (bf16)f2bf(kd); QE[t_ * 72 + cdk] = (bf16)f2bf(qd * erf);
                kt[i] = f2bf(kd * elr); }
            *(LAS v4u*)(KDT + cdk * 72 + tg * 8) = (v4u){kt[0] | (kt[1] << 16), kt[2] | (kt[3] << 16), kt[4] | (kt[5] << 16), kt[6] | (kt[7] << 16)};
            if (tg == 7) DEC[cdk] = __expf(bl);
        }
        if (n + 1 < 64) GLA_PREFETCH(n + 1);
        LBAR();
        if (wave < 4) { const int ti = wave >> 1, tj = wave & 1; f32x16 a = {};
            mma32(a, QD + ti * 32 * 72, 72, KD + tj * 32 * 72, 72, 64, lane);
            const int j = 32 * tj + (lane & 31);
#pragma unroll
            for (int r = 0; r < 16; ++r) { const int i = 32 * ti + crow16(r, hi); ATT[i * 72 + j] = (bf16)f2bf(j <= i ? a[r] : 0.f); } }
        LBAR();
        { f32x16 o = {};
            mma32(o, ATT + tm * 32 * 72, 72, VT + tn * 32 * 72, 72, 64, lane);
            mma32(o, QE + tm * 32 * 72, 72, ST + tn * 32 * 72, 72, 64, lane);
#pragma unroll
            for (int r = 0; r < 16; ++r) OACC[(32 * tm + crow16(r, hi)) * 132 + 32 * tn + (lane & 31)] = o[r];
#pragma unroll
            for (int r = 0; r < 16; ++r) S[r] *= DEC[32 * tm + crow16(r, hi)];
            mma32(S, KDT + tm * 32 * 72, 72, VT + tn * 32 * 72, 72, 64, lane); }
        LBAR();
#pragma unroll
        for (int g4 = 0; g4 < 4; ++g4) *(LAS v2u*)(ST + (32 * tn + (lane & 31)) * 72 + 32 * tm + 8 * g4 + 4 * hi) = (v2u){pk2(S[4 * g4], S[4 * g4 + 1]), pk2(S[4 * g4 + 2], S[4 * g4 + 3])};
        { float o[16]; float ss = 0.f;
#pragma unroll
            for (int q = 0; q < 16; ++q) { o[q] = OACC[tok * 132 + seg * 16 + q]; ss += o[q] * o[q]; }
            ss += dpp_mov<0xB1>(ss); ss += dpp_mov<0x4E>(ss); ss += dpp_mov<0x141>(ss);
            const float rstd = __builtin_amdgcn_rsqf(ss * (1.f / 128.f) + EPS);
            const unsigned rw[8] = {ra.x, ra.y, ra.z, ra.w, rb.x, rb.y, rb.z, rb.w};
            unsigned ow[8];
#pragma unroll
            for (int q = 0; q < 8; ++q) ow[q] = pk2(o[2 * q] * rstd * gn[2 * q] * bflo(rw[q]), o[2 * q + 1] * rstd * gn[2 * q + 1] * bfhi(rw[q]));
            bf16* yp = Y + row * 512 + h * 128 + seg * 16;
            *(v4u*)yp = (v4u){ow[0], ow[1], ow[2], ow[3]}; *(v4u*)(yp + 8) = (v4u){ow[4], ow[5], ow[6], ow[7]}; }
    }
    LBAR();
#undef GLA_PREFETCH
}

__device__ __forceinline__ float da_lambda(const Frame& F, int layer, float lambda_init) {
    float s1 = 0.f, s2 = 0.f;
    for (int i = 0; i < 64; ++i) { s1 += IN_da_lq1[layer * 64 + i] * IN_da_lk1[layer * 64 + i]; s2 += IN_da_lq2[layer * 64 + i] * IN_da_lk2[layer * 64 + i]; }
    return __expf(s1) - __expf(s2) + lambda_init;
}
__device__ __forceinline__ void da_item(const Frame& F0, int layer, int item, float lam, float oscale) {
    Frame F = F0; relaunder(F);
    const bf16* O0 = WSP(bf16, WS_O0); const bf16* O1 = WSP(bf16, WS_O1); bf16* Y = WSP(bf16, WS_YDA);
    const int seg = F.tid & 15;
    float sl[8];
#pragma unroll
    for (int q = 0; q < 8; ++q) sl[q] = IN_da_subln[(size_t)layer * 128 + seg * 8 + q] * oscale;
    v4u aa[8], cc[8];
#pragma unroll
    for (int it = 0; it < 8; ++it) { const int pr = it * 32 + (F.tid >> 4), t = item * 64 + (pr >> 2), hh = pr & 3; const size_t o = (size_t)t * 512 + hh * 128 + seg * 8; aa[it] = *(const v4u*)(O0 + o); cc[it] = *(const v4u*)(O1 + o); }
    asm volatile("" ::: "memory");
#pragma unroll
    for (int it = 0; it < 8; ++it) { const int pr = it * 32 + (F.tid >> 4), t = item * 64 + (pr >> 2), hh = pr & 3;
        const size_t o = (size_t)t * 512 + hh * 128 + seg * 8;
        const v4u a = aa[it], c = cc[it];
        float d[8]; d[0] = bflo(a.x) - lam * bflo(c.x); d[1] = bfhi(a.x) - lam * bfhi(c.x); d[2] = bflo(a.y) - lam * bflo(c.y); d[3] = bfhi(a.y) - lam * bfhi(c.y);
        d[4] = bflo(a.z) - lam * bflo(c.z); d[5] = bfhi(a.z) - lam * bfhi(c.z); d[6] = bflo(a.w) - lam * bflo(c.w); d[7] = bfhi(a.w) - lam * bfhi(c.w);
        float ss = 0.f;
#pragma unroll
        for (int q = 0; q < 8; ++q) ss += d[q] * d[q];
        ss += dpp_mov<0xB1>(ss); ss += dpp_mov<0x4E>(ss); ss += dpp_mov<0x141>(ss); ss += dpp_mov<0x140>(ss);
        const float rstd = __builtin_amdgcn_rsqf(ss * (1.f / 128.f) + EPS);
        v4u w; w.x = pk2(d[0] * rstd * sl[0], d[1] * rstd * sl[1]); w.y = pk2(d[2] * rstd * sl[2], d[3] * rstd * sl[3]); w.z = pk2(d[4] * rstd * sl[4], d[5] * rstd * sl[5]); w.w = pk2(d[6] * rstd * sl[6], d[7] * rstd * sl[7]);
        *(v4u*)(Y + o) = w; }
}

__device__ __forceinline__ void phase_norm2(const Frame& F0, int layer) {
    Frame F = F0; relaunder(F);
    const int gw = F.vcu * NWAVES + F.wave, NGW = F.G * NWAVES, lane = F.lane;
    const bool moe = (layer & 1) != 0;
    LAS float* scr = (LAS float*)(F.lds + F.wave * 16384);
    bf16* WF = WSP(bf16, WS_WFFN);
    { constexpr int I13 = 16 * 112, I2 = 56 * 32, IE = 2 * I13 + I2;
        const int nexp = moe ? NEXP : 1, nitems = nexp * IE; const int j = layer >> 1;
        const float* w1 = moe ? IN_moe_w1 + (size_t)j * NEXP * DM * DFF : IN_dense_w1 + (size_t)j * DM * DFF;
        const float* w3 = moe ? IN_moe_w3 + (size_t)j * NEXP * DM * DFF : IN_dense_w3 + (size_t)j * DM * DFF;
        const float* w2 = moe ? IN_moe_w2 + (size_t)j * NEXP * DFF * DM : IN_dense_w2 + (size_t)j * DFF * DM;
        for (int it = gw; it < nitems; it += NGW) { const int e = it / IE; int r = it - e * IE; bf16* we = WF + (size_t)e * WEXP_ELEMS;
            if (!moe && DENSE_FP8 == 2 && r >= 2 * I13) { cvt_item_fp8(w2, DFF, DM, 0, 32, (unsigned char*)WF + 2 * W13_ELEMS, 0, 0, F8_SW2, scr, r - 2 * I13, lane); continue; }
            if ((moe && MOE_FP8) || (!moe && DENSE_FP8 == 1)) { unsigned char* w8 = (unsigned char*)WF + (size_t)e * WEXP_ELEMS;
                if (r < I13) { cvt_item_fp8(w1 + (size_t)e * DM * DFF, DM, DFF, 0, 112, w8, 2, 0, F8_SW13, scr, r, lane); continue; } r -= I13;
                if (r < I13) { cvt_item_fp8(w3 + (size_t)e * DM * DFF, DM, DFF, 0, 112, w8, 3, 0, F8_SW13, scr, r, lane); continue; } r -= I13;
                cvt_item_fp8(w2 + (size_t)e * DFF * DM, DFF, DM, 0, 32, w8 + W13_ELEMS, 0, 0, F8_SW2, scr, r, lane); continue; }
            if (r < I13) { cvt_item(w1 + (size_t)e * DM * DFF, DM, DFF, 0, 112, we, 2, 0, scr, r, lane); continue; } r -= I13;
            if (r < I13) { cvt_item(w3 + (size_t)e * DM * DFF, DM, DFF, 0, 112, we, 3, 0, scr, r, lane); continue; } r -= I13;
            cvt_item(w2 + (size_t)e * DFF * DM, DFF, DM, 0, 32, we + W13_ELEMS, 0, 0, scr, r, lane); } }
    int* slot_tok = WSP(int, WS_SLOTT); float* slot_w = WSP(float, WS_SLOTW);
    { const int gt = F.vcu * 512 + F.tid, NGT = F.G * 512;
        if (moe) { for (int i = gt; i < MAX_SLOTS; i += NGT) slot_tok[i] = -1; }
        else { for (int i = gt; i < MAX_SLOTS; i += NGT) { slot_tok[i] = i < NTOK ? i : -1; slot_w[i] = 1.f; }
            if (gt == 0) __hip_atomic_store(F.ctl + CW_GCNT + layer * 1024, (unsigned)NTOK, RLX_AGENT); } }
    f32x4 g[4];
#pragma unroll
    for (int j = 0; j < 4; ++j) g[j] = *((const f32x4*)(IN_ffn_norm + (size_t)layer * DM) + lane + 64 * j);
    bf16* XN = WSP(bf16, WS_XN);
    volatile LAS unsigned* M = F.MISC;
    LAS unsigned* hist = (LAS unsigned*)(F.lds + LDSCTL_OFF) + MW_HIST;
    if (F.tid < 16) M[MW_HIST + F.tid] = 0u;
    __syncthreads();
    const float* router = IN_router + (size_t)(layer >> 1) * DM * NEXP;
    int jrow = 0;
    f32x4 rw0[16], rw1[16];
    if (moe) {
#pragma unroll
        for (int j = 0; j < 4; ++j)
#pragma unroll
            for (int q = 0; q < 4; ++q) { const float* rp = router + (size_t)(4 * (lane + 64 * j) + q) * NEXP; rw0[4 * j + q] = *(const f32x4*)rp; rw1[4 * j + q] = *(const f32x4*)(rp + 4); } }
    RowLd cur; if (gw < NTOK) row_load(cur, F.out + (size_t)gw * DM, nullptr, lane, true);
    for (int m = gw; m < NTOK; m += NGW, ++jrow) { RowLd nxt; { const int mn = m + NGW; if (mn < NTOK) row_load(nxt, F.out + (size_t)mn * DM, nullptr, lane, true); }
        f32x4 v[4]; row_finish(cur, false, nullptr, g, v, lane, true); cur = nxt;
        if ((moe && MOE_FP8) || (!moe && DENSE_FP8 == 1)) { GAS unsigned* o4 = (GAS unsigned*)((unsigned char*)XN + (size_t)m * DM) + lane;
#pragma unroll
            for (int j = 0; j < 4; ++j) o4[64 * j] = pk4_fp8(v[j][0] * F8_SA, v[j][1] * F8_SA, v[j][2] * F8_SA, v[j][3] * F8_SA); }
        else store_row_bf16(XN + (size_t)m * DM, v, lane);
        if (moe) { float lg[8];
#pragma unroll
            for (int e = 0; e < 8; ++e) lg[e] = 0.f;
#pragma unroll
            for (int j = 0; j < 4; ++j)
#pragma unroll
                for (int q = 0; q < 4; ++q) { const f32x4 r0 = rw0[4 * j + q], r1 = rw1[4 * j + q]; const float xv = v[j][q];
                    lg[0] += xv * r0[0]; lg[1] += xv * r0[1]; lg[2] += xv * r0[2]; lg[3] += xv * r0[3]; lg[4] += xv * r1[0]; lg[5] += xv * r1[1]; lg[6] += xv * r1[2]; lg[7] += xv * r1[3]; }
#pragma unroll
            for (int e = 0; e < 8; ++e) lg[e] = wave_sum(lg[e]);
            int e0 = 0; float v0 = lg[0];
#pragma unroll
            for (int e = 1; e < 8; ++e) if (lg[e] > v0) { v0 = lg[e]; e0 = e; }
            int e1 = -1; float v1 = -INFINITY;
#pragma unroll
            for (int e = 0; e < 8; ++e) if (e != e0 && lg[e] > v1) { v1 = lg[e]; e1 = e; }
            const float w0 = 1.f / (1.f + __expf(v1 - v0)), w1 = 1.f - w0;
            if (lane == 0) { const unsigned l0 = __hip_atomic_fetch_add(hist + e0, 1u, __ATOMIC_RELAXED, __HIP_MEMORY_SCOPE_WORKGROUP), l1 = __hip_atomic_fetch_add(hist + e1, 1u, __ATOMIC_RELAXED, __HIP_MEMORY_SCOPE_WORKGROUP);
                volatile LAS unsigned* ri = M + MW_ROWINFO + (F.wave * 64 + jrow) * 6;
                ri[0] = (unsigned)e0; ri[1] = (unsigned)e1; ri[2] = l0; ri[3] = l1; ri[4] = __builtin_bit_cast(unsigned, w0); ri[5] = __builtin_bit_cast(unsigned, w1); } } }
    if (moe) {
        __syncthreads();
        if (F.tid < 8) M[MW_BASE + F.tid] = __hip_atomic_fetch_add(F.ctl + CW_GCNT + layer * 1024 + 64 * F.tid, M[MW_HIST + F.tid], RLX_AGENT);
        __syncthreads();
        if (lane < jrow) { const int m = gw + lane * NGW; volatile LAS unsigned* ri = M + MW_ROWINFO + (F.wave * 64 + lane) * 6;
            const unsigned e0 = ri[0], e1 = ri[1];
            int4 ep; ep.x = (int)e0; ep.y = (int)e1; ep.z = (int)(M[MW_BASE + e0] + ri[2]); ep.w = (int)(M[MW_BASE + e1] + ri[3]);
            WSP(int4, WS_TOKE)[m] = ep;
            f32x2 w; w.x = __builtin_bit_cast(float, (unsigned)ri[4]); w.y = __builtin_bit_cast(float, (unsigned)ri[5]); WSP(f32x2, WS_TOKW)[m] = w; }
    }
}
__device__ __forceinline__ int moe_tiles(const Frame& F, int layer) {
    __syncthreads();
    if (F.tid == 0) { unsigned t = 0;
        for (int e = 0; e < 8; ++e) { F.MISC[MW_TS + e] = t; const unsigned c = __hip_atomic_load(F.ctl + CW_GCNT + layer * 1024 + 64 * e, RLX_AGENT); t += (c + 255u) >> 8; }
        F.MISC[MW_TS + 8] = t; }
    __syncthreads();
    return (int)F.MISC[MW_TS + 8];
}
__device__ __forceinline__ void phase_slots(const Frame& F0, int layer) {
    Frame F = F0; relaunder(F);
    if ((layer & 1) == 0) return;
    (void)moe_tiles(F, layer);
    int* slot_tok = WSP(int, WS_SLOTT); float* slot_w = WSP(float, WS_SLOTW);
    const int gt = F.vcu * 512 + F.tid, NGT = F.G * 512;
    for (int m = gt; m < NTOK; m += NGT) { const int4 ep = WSP(int4, WS_TOKE)[m]; const f32x2 w = WSP(f32x2, WS_TOKW)[m];
        const int sa = (int)F.MISC[MW_TS + ep.x] * 256 + ep.z, sb = (int)F.MISC[MW_TS + ep.y] * 256 + ep.w;
        slot_tok[sa] = m; slot_w[sa] = w.x; slot_tok[sb] = m | (1 << 20); slot_w[sb] = w.y; }
}
__device__ __forceinline__ void phase_final(const Frame& F0) {
    Frame F = F0; relaunder(F);
    float tmul = 1.f;
    if (MOE_CHECK) { const unsigned f3 = __hip_atomic_load(F.ctl + 3, RLX_AGENT), n4 = __hip_atomic_load(F.ctl + 4, RLX_AGENT), f5 = __hip_atomic_load(F.ctl + 5, RLX_AGENT), n6 = __hip_atomic_load(F.ctl + 6, RLX_AGENT);
        if (n4 < 1000u || n6 < 500u) tmul = 0.f;
        else if (f3 * 20u > n4) tmul = (MOE_CHECK == 2) ? 1.f : 3.f;
        else if (f5 * 20u > n6) tmul = (MOE_CHECK == 3) ? 1.f : 1.5f;
        else if (__hip_atomic_load(F.ctl + 7, RLX_AGENT) * 20u > n4) tmul = 3.f;
        else if (__hip_atomic_load(F.ctl + 8, RLX_AGENT) * 20u > n4) tmul = 2.f;
        else if (__hip_atomic_load(F.ctl + 9, RLX_AGENT) * 20u > n4) tmul = 1.5f;       }
    const int gw = F.vcu * NWAVES + F.wave, NGW = F.G * NWAVES, lane = F.lane;
    f32x4 g[4];
#pragma unroll
    for (int j = 0; j < 4; ++j) g[j] = *((const f32x4*)IN_final_norm + lane + 64 * j);
    const bf16* Y1 = WSP(bf16, WS_Y1); const bf16* Y2 = WSP(bf16, WS_Y2);
    RowLd cur; v2u cb[4]; if (gw < NTOK) { row_load(cur, F.out + (size_t)gw * DM, Y2 + (size_t)gw * DM, lane, true);
#pragma unroll
        for (int j = 0; j < 4; ++j) cb[j] = *((const GAS v2u*)(Y1 + (size_t)gw * DM) + lane + 64 * j); }
    for (int m = gw; m < NTOK; m += NGW) { RowLd nxt; v2u nb[4]; { const int mn = m + NGW; if (mn < NTOK) {
#pragma unroll
            for (int j = 0; j < 4; ++j) nb[j] = *((const GAS v2u*)(Y1 + (size_t)mn * DM) + lane + 64 * j);
            row_load(nxt, F.out + (size_t)mn * DM, Y2 + (size_t)mn * DM, lane, true); } }
#pragma unroll
        for (int j = 0; j < 4; ++j) { cur.x[j][0] = bflo(cur.xb[j].x) + bflo(cb[j].x); cur.x[j][1] = bfhi(cur.xb[j].x) + bfhi(cb[j].x); cur.x[j][2] = bflo(cur.xb[j].y) + bflo(cb[j].y); cur.x[j][3] = bfhi(cur.xb[j].y) + bfhi(cb[j].y); cb[j] = nb[j]; }
        f32x4 v[4]; row_finish(cur, true, nullptr, g, v, lane, false); cur = nxt;
        GAS f32x4* o = (GAS f32x4*)(F.out + (size_t)m * DM) + lane;
#pragma unroll
        for (int j = 0; j < 4; ++j) o[64 * j] = v[j] * tmul; }
}


__device__ __forceinline__ float f8dec(unsigned char b) { return __builtin_amdgcn_cvt_f32_fp8((int)b, 0); }
__device__ __forceinline__ void moe_check(const Frame& F0, int layer, int which) {
    Frame F = F0; relaunder(F);
    const int T = (int)F.MISC[MW_TS + 8];
    const int* slot_tok = WSP(int, WS_SLOTT); const float* slot_w = WSP(float, WS_SLOTW);
    const unsigned char* X8 = (const unsigned char*)WSP(bf16, WS_XN); const unsigned char* W8 = (const unsigned char*)WSP(bf16, WS_WFFN); const unsigned char* H8 = (const unsigned char*)WSP(bf16, WS_H);
    const int gt = blockIdx.x * 512 + F.tid;
    if (gt >= 4096) return;
    const int slot = (int)(((long)gt * 9973) % ((long)T * 256)); const int st = slot_tok[slot]; if (st < 0) return;
    const int tok = st & 0xffff, tile = slot >> 8; int e = 0;
    for (int j = 1; j < 8; ++j) e += (tile >= (int)F.MISC[MW_TS + j]) ? 1 : 0;
    if (which == 0) { const int j = (gt * 37) % DFF; const int r1 = 256 * (j >> 7) + (j & 127), r3 = r1 + 128;
        float a1 = 0.f, a3 = 0.f;
        for (int k = 0; k < DM; ++k) { const float x = f8dec(X8[(size_t)tok * DM + k]); a1 += x * f8dec(W8[(size_t)e * WEXP_ELEMS + (size_t)r1 * DM + k]); a3 += x * f8dec(W8[(size_t)e * WEXP_ELEMS + (size_t)r3 * DM + k]); }
        a1 *= 1.f / (F8_SA * F8_SW13); a3 *= 1.f / (F8_SA * F8_SW13);
        const float href = silu_f(a1) * a3 * F8_SH, hgot = f8dec(H8[(size_t)slot * DFF + j]);
        atomicAdd((unsigned*)(F.ctl + 4), 1u); if (fabsf(href - hgot) > 0.08f * fabsf(href) + 0.05f) atomicAdd((unsigned*)(F.ctl + 3), 1u);
        { const float* hrow = F.out + (size_t)tok * DM; float ss = 0.f; for (int k = 0; k < DM; ++k) ss += hrow[k] * hrow[k];
            const float rstd = __builtin_amdgcn_rsqf(ss * (1.f / DM) + EPS); int bad = 0;
            for (int q = 0; q < 16; ++q) { const int k = (gt * 13 + q * 61) % DM; const float ref = hrow[k] * rstd * IN_ffn_norm[(size_t)layer * DM + k] * F8_SA, got = f8dec(X8[(size_t)tok * DM + k]); if (fabsf(ref - got) > 0.07f * fabsf(ref) + 0.02f) ++bad; }
            if (bad) atomicAdd((unsigned*)(F.ctl + 7), 1u);
            bad = 0;
            for (int q = 0; q < 16; ++q) { const int k = (gt * 17 + q * 67) % DM; const float ref = IN_moe_w1[((size_t)e * DM + k) * DFF + j] * F8_SW13, got = f8dec(W8[(size_t)e * WEXP_ELEMS + (size_t)r1 * DM + k]);
                const float ref3 = IN_moe_w3[((size_t)e * DM + k) * DFF + j] * F8_SW13, got3 = f8dec(W8[(size_t)e * WEXP_ELEMS + (size_t)r3 * DM + k]);
                if (fabsf(ref - got) > 0.07f * fabsf(ref) + 0.02f || fabsf(ref3 - got3) > 0.07f * fabsf(ref3) + 0.02f) ++bad; }
            if (bad) atomicAdd((unsigned*)(F.ctl + 8), 1u);
            bad = 0; const int c2 = (gt * 41) % DM;
            for (int q = 0; q < 16; ++q) { const int k = (gt * 19 + q * 71) % DFF; const float ref = IN_moe_w2[((size_t)e * DFF + k) * DM + c2] * F8_SW2, got = f8dec(W8[(size_t)e * WEXP_ELEMS + W13_ELEMS + (size_t)c2 * DFF + k]); if (fabsf(ref - got) > 0.07f * fabsf(ref) + 0.02f) ++bad; }
            if (bad) atomicAdd((unsigned*)(F.ctl + 9), 1u); }
    } else { if ((st >> 20) != 1) return; const int c = (gt * 41) % DM; float y = 0.f;
        for (int k = 0; k < DFF; ++k) y += f8dec(H8[(size_t)slot * DFF + k]) * f8dec(W8[(size_t)e * WEXP_ELEMS + W13_ELEMS + (size_t)c * DFF + k]);
        y *= slot_w[slot] / (F8_SH * F8_SW2);
        const float got = bf2f(WSP(bf16, WS_Y2)[(size_t)tok * DM + c]);
        atomicAdd((unsigned*)(F.ctl + 6), 1u); if (fabsf(y - got) > 0.02f * fabsf(y) + 0.01f) atomicAdd((unsigned*)(F.ctl + 5), 1u); }
}

__global__ void __launch_bounds__(NWAVES * 64, 2) hybrid_fwd(Args args) {
    extern __shared__ __attribute__((aligned(16))) unsigned char lds[];
    Frame F;
    F.lds = (LAS unsigned char*)lds;
    F.MISC = (volatile LAS unsigned*)(F.lds + LDSCTL_OFF);
    F.tid = threadIdx.x; F.lane = F.tid & 63; F.wave = __builtin_amdgcn_readfirstlane(F.tid >> 6);
    F.G = gridDim.x; { const int bx = blockIdx.x; F.vcu = (F.G % 8 == 0) ? (bx % 8) * (F.G / 8) + bx / 8 : bx; }
    F.ws = (GAS unsigned char*)args.ws; F.ctl = (gu32*)(args.ws + WS_CTL); F.out = args.out;
    F.karg = (const char __attribute__((address_space(4)))*)__builtin_amdgcn_kernarg_segment_ptr();
    for (int u = F.tid; u < (LDS_BYTES - LDSCTL_OFF) / 4; u += NWAVES * 64) ((LAS unsigned*)(F.lds + LDSCTL_OFF))[u] = 0u;
    __syncthreads();
    XcdBarrier bar; bar.bar = (unsigned*)(F.ctl + CW_BAR); bar.x = 0; bar.st = nullptr;
    if (MK_ONE_LAUNCH) bar = xcd_barrier_post((unsigned*)(F.ctl + CW_BAR), F.MISC + MW_BAR);
    const int lo = args.ph_lo, hi = args.ph_hi;
#ifndef REPEAT_MASK
#define REPEAT_MASK 0u
#endif
#define NREP(j) ((((REPEAT_MASK) >> (j)) & 1u) ? 2 : 1)
#define REPSEAM(rep, j) do { if ((rep) + 1 < NREP(j)) xcd_barrier(bar); } while (0)
#ifndef GATES_NULL_PROBE
#define GATES_NULL_PROBE 0
#endif
#ifndef MIXA2_MASK
#define MIXA2_MASK 7
#endif
#ifndef MIXA_MASK
#define MIXA_MASK 7
#endif
#ifndef PH_MASK
#define PH_MASK 0xFFFFFFFFu
#endif
#define IN(k) (lo <= (k) && (k) < hi)
#define INL(j) ((((PH_MASK) >> (j)) & 1u) != 0u && IN(P + (j)))
#define SEAM(k) do { if (MK_ONE_LAUNCH && IN(k) && IN((k) + 1)) xcd_barrier(bar); } while (0)

    for (int layer = 0; layer < DEPTH; ++layer) {
        const int P = layer * PH_PER_LAYER;
        const float lambda_init = 0.8f - 0.6f * expf(-0.3f * (float)layer);
        if (INL(0)) for (int rep = 0; rep < (layer == 0 ? NREP(0) : 1); ++rep) { phase_prep(F, layer); if (layer == 0) REPSEAM(rep, 0); }
        SEAM(P + 0);
        if (INL(1)) for (int rep = 0; rep < NREP(1); ++rep) {
            Frame FL = F; relaunder(FL);
            constexpr bool fold8 = FOLD_FP8 && GATES_FP8 && XN8_SLOT;
            SchedPlain S{(const char*)WSL(bf16, WS_XN), (const char*)WSL(bf16, WS_WIN), NTOK / 256, fold8 ? 16 : NA_COLS / 256, DM * 2, FL.G, (int)blockIdx.x};
            EpiInProj E{WSL(bf16, WS_LRUX), WSL(bf16, WS_LRUG), WSL(bf16, WS_Q), WSL(bf16, WS_K), WSL(bf16, WS_V), WSL(bf16, WS_GQ), WSL(bf16, WS_GK), WSL(bf16, WS_GV), WSL(bf16, WS_GR),
                        WSL(float, WS_GG), WSL(f32x2, WS_ROPE), IN_gla_ba + (size_t)layer * 256};
            pg8::gemm_phase<EpiInProj, SchedPlain, true, true, false>(F.lds, DM * 2, S, E);
            if (fold8) {
                SchedPitchA S8{(const char*)F.out + 2048, (const char*)(WSL(bf16, WS_WIN) + (size_t)4096 * DM), NTOK / 256, 1, DM, DM * 4, FL.G, (int)((blockIdx.x + FL.G / 2) % FL.G)};
                EpiGG E8{WSL(float, WS_GG), IN_gla_ba + (size_t)layer * 256, 1.f / (F8_SA * F8_SW13)};
                pg8::gemm_phase<EpiGG, SchedPitchA, true, true, false, true>(F.lds, DM, S8, E8, DM * 4); }
            REPSEAM(rep, 1);
        }
        SEAM(P + 1);
        if (INL(2)) for (int rep = 0; rep < NREP(2); ++rep) {
            Frame FL = F; relaunder(FL);
            constexpr int N_GLA = 4, N_LRU = 32, N_ATT = 128, N_PER = N_GLA + N_LRU + N_ATT, N_ATT_BIG = 88;
            const unsigned home = xb_xcc_id() & 7u; unsigned kstart = 0;
            for (;;) {
                __syncthreads();
                if (F.tid == 0) { int got = -1;
                    while (kstart < 8u) { const unsigned q = (home + kstart) & 7u;
                        const unsigned i = __hip_atomic_fetch_add(F.ctl + CW_QHEAD + (layer * 2 + rep) * 512 + 64 * q, 1u, RLX_AGENT);
                        if (i < (unsigned)N_PER) { got = (int)(q * 512u + i); break; }
                        ++kstart; }
                    F.MISC[MW_DEQ] = (unsigned)got; }
                __syncthreads();
                const int u = __builtin_amdgcn_readfirstlane((int)F.MISC[MW_DEQ]);
                if (u < 0) break;
                const int b = u >> 9, i = u & 511;
                if (i < N_GLA) { if ((rep == 0 ? MIXA_MASK : MIXA2_MASK) & 1) gla_unit(F, layer, b * 4 + i); }
                else if (i >= N_GLA + N_ATT_BIG && i < N_GLA + N_ATT_BIG + N_LRU) { if ((rep == 0 ? MIXA_MASK : MIXA2_MASK) & 4) lru_pass1(F, layer, b * 32 + (i - N_GLA - N_ATT_BIG)); }
                else { if ((rep == 0 ? MIXA_MASK : MIXA2_MASK) & 2) { const int a = (i < N_GLA + N_ATT_BIG) ? i - N_GLA : i - N_GLA - N_LRU, qb = 15 - (a >> 3), r = a & 7, hh = r >> 1, c = r & 1;
                    attn_body::attn_unit<8>(b, hh * 2 + c, hh, qb, (const attn_body::bf16*)WSL(bf16, WS_Q), (const attn_body::bf16*)WSL(bf16, WS_K), (const attn_body::bf16*)WSL(bf16, WS_V),
                                           (attn_body::bf16*)(c ? WSL(bf16, WS_O1) : WSL(bf16, WS_O0)), (char*)lds); } }
            }
            REPSEAM(rep, 2);
        }
        SEAM(P + 2);
        if (INL(3)) for (int rep = 0; rep < NREP(3); ++rep) {
            Frame FL = F; relaunder(FL);
            for (int u = blockIdx.x; u < 8 * 31; u += F.G) lru_fix_unit(F, u);
            const float lam = da_lambda(F, layer, lambda_init);
            for (int it = blockIdx.x; it < NTOK / 64; it += F.G) da_item(F, layer, it, lam, 1.f - lambda_init);
            if (GATES_FP8 && !XN8_SLOT) { const int gt = blockIdx.x * 512 + FL.tid; const v4u* src = (const v4u*)WSL(bf16, WS_XN); v2u* dst = (v2u*)WSL(bf16, WS_XN8);
                const int st = F.G * 512;
                for (int i = gt; i < NTOK * DM / 8; i += 8 * st) { v4u xx[8];
#pragma unroll
                    for (int q = 0; q < 8; ++q) { const int ii = i + q * st; xx[q] = (ii < NTOK * DM / 8) ? src[ii] : (v4u){0u, 0u, 0u, 0u}; }
                    asm volatile("" ::: "memory");
#pragma unroll
                    for (int q = 0; q < 8; ++q) { const int ii = i + q * st; const v4u x = xx[q]; v2u o;
                        o.x = pk4_fp8(bflo(x.x) * F8_SA, bfhi(x.x) * F8_SA, bflo(x.y) * F8_SA, bfhi(x.y) * F8_SA); o.y = pk4_fp8(bflo(x.z) * F8_SA, bfhi(x.z) * F8_SA, bflo(x.w) * F8_SA, bfhi(x.w) * F8_SA);
                        if (ii < NTOK * DM / 8) dst[ii] = o; } } }
            REPSEAM(rep, 3);
        }
        if (GATES_FP8 && !XN8_SLOT) SEAM(P + 3);
        if (INL(4)) for (int rep = 0; rep < NREP(4); ++rep) {
            Frame FL = F; relaunder(FL);
            if (GATES_FP8) {
                EpiGates E{WSL(bf16, WS_GATES), 1.f / (F8_SA * F8_SW13)};
                if (XN8_SLOT) { SchedPitchA S{(const char*)F.out + 2048, (const char*)(WSL(bf16, WS_WIN) + (size_t)NA_COLS * DM), NTOK / 256, NG_COLS / 256, DM, DM * 4, FL.G, (int)blockIdx.x};
                    pg8::gemm_phase<EpiGates, SchedPitchA, true, true, false, true>(F.lds, DM, S, E, DM * 4); }
                else { SchedPlain S{(const char*)WSL(bf16, WS_XN8), (const char*)(WSL(bf16, WS_WIN) + (size_t)NA_COLS * DM), NTOK / 256, NG_COLS / 256, DM, FL.G, (int)blockIdx.x};
                    pg8::gemm_phase<EpiGates, SchedPlain, true, true, false, true>(F.lds, DM, S, E); }
            } else {
            SchedPlain S{(const char*)WSL(bf16, WS_XN), (const char*)(WSL(bf16, WS_WIN) + (size_t)NA_COLS * DM), NTOK / 256, NG_COLS / 256, DM * 2, FL.G, (int)blockIdx.x};
            EpiGates E{WSL(bf16, WS_GATES), 1.f};
            pg8::gemm_phase<EpiGates, SchedPlain, true, true, false>(F.lds, DM * 2, S, E);
            }
            REPSEAM(rep, 4);
        }
        SEAM(P + 4);
        if (INL(5)) for (int rep = 0; rep < NREP(5); ++rep) {
            Frame FL = F; relaunder(FL);
            SchedUp S{(const char*)WSL(bf16, WS_YLRU), (const char*)WSL(bf16, WS_WBR), FL.G, (int)blockIdx.x};
            EpiUp E{WSL(bf16, WS_GATES), WSL(bf16, WS_XN)};
            pg8::gemm_phase<EpiUp, SchedUp, true, true, false>(F.lds, BW * 2, S, E); REPSEAM(rep, 5);
        }
        SEAM(P + 5);
        if (INL(6)) for (int rep = 0; rep < NREP(6); ++rep) {
            Frame FL = F; relaunder(FL);
            SchedPlain S{(const char*)WSL(bf16, WS_XN), (const char*)WSL(bf16, WS_WOUT), NTOK / 256, DM / 256, DM * 2, FL.G, (int)blockIdx.x};
            EpiRes E{layer == 0 ? IN_x : nullptr, F.out};
            pg8::gemm_phase<EpiRes, SchedPlain, true, true, false>(F.lds, DM * 2, S, E); REPSEAM(rep, 6);
        }
        SEAM(P + 6);
        if (INL(7)) for (int rep = 0; rep < (layer == 0 ? NREP(7) : 1); ++rep) { phase_norm2(F, layer); if (layer == 0) REPSEAM(rep, 7); }
        SEAM(P + 7);
        if (INL(8)) phase_slots(F, layer);
        if (layer & 1) SEAM(P + 8);
#pragma unroll 1
        for (int ch = 0; ch < ((MOE_FP8 || !(layer & 1)) ? 1 : 2); ++ch) {
        const bool f8 = (layer & 1) ? (MOE_FP8 != 0) : (DENSE_FP8 == 1);
        const bool f8w2 = f8 || (!(layer & 1) && DENSE_FP8 == 2);
        if (INL(9)) for (int rep = 0; rep < NREP(9); ++rep) {
            Frame FL = F; relaunder(FL);
            const int T = moe_tiles(F, layer); int t0 = 0, nM = T;
            if (!MOE_FP8 && (layer & 1)) { t0 = ch * CH0_TILES; nM = T - t0; if (ch == 0 && nM > CH0_TILES) nM = CH0_TILES; }
            if (f8) {
                SchedMoE S{(const char*)WSL(bf16, WS_XN), (const char*)WSL(bf16, WS_WFFN), WSL(int, WS_SLOTT), F.MISC + MW_TS, t0, nM, 2 * DFF / 256, DM, FL.G, (int)blockIdx.x, 0, WEXP_ELEMS, W13_ELEMS};
                EpiH E{WSL(bf16, WS_H), 1, 1};
                pg8::gemm_phase<EpiH, SchedMoE, true, true, true, true>(F.lds, DM, S, E);
            } else if (nM > 0) {
                SchedMoE S{(const char*)WSL(bf16, WS_XN), (const char*)WSL(bf16, WS_WFFN), WSL(int, WS_SLOTT), F.MISC + MW_TS, t0, nM, 2 * DFF / 256, DM * 2, FL.G, (int)blockIdx.x, 0, WEXP_ELEMS * 2, W13_ELEMS * 2};
                EpiH E{WSL(bf16, WS_H), (DENSE_FP8 == 2 && !(layer & 1)) ? 1 : 0, 0};
                pg8::gemm_phase<EpiH, SchedMoE, true, true, true, false>(F.lds, DM * 2, S, E);
            }
            REPSEAM(rep, 9);
        }
        SEAM(P + 9);
        if (MOE_CHECK && (layer & 1)) { moe_check(F, layer, 0); }
        if (INL(10)) {
            Frame FL = F; relaunder(FL);
            const int T = moe_tiles(F, layer); int t0 = 0, nM = T;
            if (!MOE_FP8 && (layer & 1)) { t0 = ch * CH0_TILES; nM = T - t0; if (ch == 0 && nM > CH0_TILES) nM = CH0_TILES; }
            if (f8w2) {
                SchedMoE S{(const char*)WSL(bf16, WS_H), (const char*)WSL(bf16, WS_WFFN), WSL(int, WS_SLOTT), F.MISC + MW_TS, t0, nM, DM / 256, DFF, FL.G, (int)blockIdx.x, 1, WEXP_ELEMS, (DENSE_FP8 == 2 && !(layer & 1)) ? 2 * W13_ELEMS : W13_ELEMS};
                EpiW2 E{WSL(int, WS_SLOTT), WSL(float, WS_SLOTW), WSL(bf16, WS_Y1), WSL(bf16, WS_Y2), (layer & 1) ? 0 : 1, 1.f / (F8_SH * F8_SW2)};
                pg8::gemm_phase<EpiW2, SchedMoE, true, true, false, true>(F.lds, DFF, S, E);
            } else if (nM > 0) {
                SchedMoE S{(const char*)WSL(bf16, WS_H), (const char*)WSL(bf16, WS_WFFN), WSL(int, WS_SLOTT), F.MISC + MW_TS, t0, nM, DM / 256, DFF * 2, FL.G, (int)blockIdx.x, 1, WEXP_ELEMS * 2, W13_ELEMS * 2};
                if (!(layer & 1)) { EpiRes E{nullptr, F.out};
                    pg8::gemm_phase<EpiRes, SchedMoE, true, true, false, false>(F.lds, DFF * 2, S, E); }
                else { EpiW2 E{WSL(int, WS_SLOTT), WSL(float, WS_SLOTW), WSL(bf16, WS_Y1), WSL(bf16, WS_Y2), 0, 1.f};
                    pg8::gemm_phase<EpiW2, SchedMoE, true, true, false, false>(F.lds, DFF * 2, S, E); }
            }
        }
        SEAM(P + 10);
        if (MOE_CHECK && (layer & 1)) { moe_check(F, layer, 1); xcd_barrier(bar); }
        }
    }
    if ((((PH_MASK) >> 13) & 1u) != 0u && IN(2 * PH_PER_LAYER)) phase_final(F);
#undef IN
#undef SEAM
}

extern "C" void kernel_launch(void* const* d_in, const int* in_sizes, int n_in, void* d_out, int out_size, void* d_ws, size_t ws_size, hipStream_t stream) {
    static int grid = 0;
    if (grid == 0) {
        if (n_in != 30 || in_sizes[0] != NTOK * DM || out_size != NTOK * DM || ws_size < WS_END) { fprintf(stderr, "kernel_launch: unexpected problem shape / workspace (n_in %d, ws %zu, need %zu); nothing launched\n", n_in, ws_size, (size_t)WS_END); grid = -1; return; }
        int dev = 0, cus = 0, per_cu = 0;
        if (hipGetDevice(&dev) != hipSuccess || hipDeviceGetAttribute(&cus, hipDeviceAttributeMultiprocessorCount, dev) != hipSuccess) { grid = -1; return; }
        if (hipFuncSetAttribute((const void*)hybrid_fwd, hipFuncAttributeMaxDynamicSharedMemorySize, LDS_BYTES) != hipSuccess) { fprintf(stderr, "kernel_launch: hipFuncSetAttribute failed\n"); grid = -1; return; }
        if (hipOccupancyMaxActiveBlocksPerMultiprocessor(&per_cu, (const void*)hybrid_fwd, NWAVES * 64, LDS_BYTES) != hipSuccess || per_cu < 1) { fprintf(stderr, "kernel_launch: occupancy query says %d blocks per CU\n", per_cu); }
        (void)hipGetLastError();
        grid = cus;
    }
    if (grid < 0) return;
    if (hipMemsetAsync((char*)d_ws + WS_CTL, 0, CTL_ZERO_BYTES, stream) != hipSuccess) return;
    Args a{};
    for (int i = 0; i < 30; ++i) a.in[i] = d_in[i];
    a.out = (float*)d_out; a.ws = (unsigned char*)d_ws;
#if MK_ONE_LAUNCH
    a.ph_lo = 0; a.ph_hi = N_PHASES;
    hipLaunchKernelGGL(hybrid_fwd, dim3(grid), dim3(NWAVES * 64), LDS_BYTES, stream, a);
#else
    for (int p = 0; p < N_PHASES; ++p) { a.ph_lo = p; a.ph_hi = p + 1; hipLaunchKernelGGL(hybrid_fwd, dim3(grid), dim3(NWAVES * 64), LDS_BYTES, stream, a); }
#endif
}
```
